# Optimizing an MI355X kernel written in HIP

```python
import jax, jax.numpy as jnp
from jax import lax
import numpy as np

D_MODEL = 1024
BATCH = 8
SEQ = 2048
DEPTH = 4
DEC_BATCH = 128
DEC_SEQ = 8
PAST_LEN = 16384
PAGE_SIZE = 128

D_MIX = D_MODEL
A_HEADS = 4
A_WIDTH = D_MIX // 4
A_HEAD_DIM = A_WIDTH // A_HEADS
CHUNK = 128
B_WIDTH = D_MIX // 4
CONV_B = 3
C_WIDTH = D_MIX // 2
SSM_HEAD_DIM = 64
SSM_HEADS = C_WIDTH // SSM_HEAD_DIM
SSM_GROUPS = 2
SSM_HPG = SSM_HEADS // SSM_GROUPS
D_STATE = 128
CONV_C = 4
SSD_CHUNK = 128
SSM_CONV_DIM = C_WIDTH + 2 * SSM_GROUPS * D_STATE
D_FF = 4 * D_MODEL
EPS = 1e-5
D_IN = 2 * A_WIDTH + 3 * B_WIDTH + C_WIDTH + SSM_CONV_DIM + SSM_HEADS

kernel_name = "hybrid_chunkmlp_shortconv_ssd_decoder_step"


def rmsnorm(x, g):
    xf = x.astype(jnp.float32)
    y = xf * lax.rsqrt(jnp.mean(xf * xf, axis=-1, keepdims=True) + EPS)
    return (y * g.astype(jnp.float32)).astype(x.dtype)


def causal_dwconv(inp, prev, w, b=None):
    K = w.shape[0]
    T = inp.shape[1]
    full = jnp.concatenate([prev.astype(inp.dtype), inp], axis=1)
    out = full[:, 0:T] * w[0]
    for k in range(1, K):
        out = out + full[:, k:k + T] * w[k]
    if b is not None:
        out = out + b
    return out, full[:, T:]


def chunk_mlp(u, v, w_s, b_s):
    bsz, T, _ = u.shape
    n_c = -(-T // CHUNK)
    pad = n_c * CHUNK - T
    vp = jnp.pad(v, ((0, 0), (0, pad), (0, 0))).reshape(bsz, n_c, CHUNK, A_HEADS, A_HEAD_DIM)
    mask = jnp.tril(jnp.ones((CHUNK, CHUNK), dtype=bool))
    wm = jnp.where(mask[None], w_s, jnp.zeros((), w_s.dtype))
    s = jnp.einsum('hts,bcshe->bcthe', wm, vp) + jnp.transpose(b_s)[None, None, :, :, None]
    s = s.reshape(bsz, n_c * CHUNK, A_WIDTH)[:, :T]
    return u * s


def ssd(x, dt, A, Bm, Cm, h0):
    bsz, T = x.shape[0], x.shape[1]
    L = min(SSD_CHUNK, T)
    n_c = -(-T // L)
    pad = n_c * L - T
    padt = lambda a: jnp.pad(a, [(0, 0), (0, pad)] + [(0, 0)] * (a.ndim - 2))
    xs = padt(x).reshape(bsz, n_c, L, SSM_GROUPS, SSM_HPG, SSM_HEAD_DIM)
    dts = padt(dt).reshape(bsz, n_c, L, SSM_GROUPS, SSM_HPG)
    Bs = padt(Bm).reshape(bsz, n_c, L, SSM_GROUPS, D_STATE)
    Cs = padt(Cm).reshape(bsz, n_c, L, SSM_GROUPS, D_STATE)
    a = dts * A.reshape(SSM_GROUPS, SSM_HPG)
    cum = jnp.cumsum(a, axis=2)
    tril = jnp.tril(jnp.ones((L, L), dtype=bool))[None, None, :, :, None, None]
    seg = cum[:, :, :, None] - cum[:, :, None, :]
    decay = jnp.exp(jnp.where(tril, seg, -jnp.inf))
    cb = jnp.einsum('bctgn,bcsgn->bctsg', Cs, Bs)
    wts = cb[..., None] * decay * dts[:, :, None]
    y_diag = jnp.einsum('bctsgk,bcsgkp->bctgkp', wts, xs)
    decay_end = jnp.exp(cum[:, :, -1:] - cum)
    states = jnp.einsum('bcsgn,bcsgk,bcsgkp->bcgkpn', Bs, decay_end * dts, xs)
    chunk_decay = jnp.exp(cum[:, :, -1])

    def step(h, inp):
        st, dec = inp
        return dec[..., None, None] * h + st, h

    h_init = h0.reshape(bsz, SSM_GROUPS, SSM_HPG, SSM_HEAD_DIM, D_STATE)
    h_final, h_starts = lax.scan(step, h_init,
                                 (jnp.moveaxis(states, 1, 0), jnp.moveaxis(chunk_decay, 1, 0)))
    h_starts = jnp.moveaxis(h_starts, 0, 1)
    y_off = jnp.einsum('bctgn,bcgkpn->bctgkp', Cs, h_starts) * jnp.exp(cum)[..., None]
    y = (y_diag + y_off).reshape(bsz, n_c * L, SSM_HEADS, SSM_HEAD_DIM)[:, :T]
    return y, h_final.reshape(bsz, SSM_HEADS, SSM_HEAD_DIM, D_STATE)


def layer(x, conv_prev, sconv_prev, ssm_prev, g1, w_in, w_s, b_s, conv_w, sconv_w, sconv_b,
          dt_bias, a_log, d_skip, ssm_norm, w_out, g2, w_ff1, w_ff2):
    bsz, T, _ = x.shape
    h = rmsnorm(x, g1)
    proj = h @ w_in
    cuts = np.cumsum([A_WIDTH, A_WIDTH, B_WIDTH, B_WIDTH, B_WIDTH, C_WIDTH, SSM_CONV_DIM])
    u, v, bgate, cgate, hb, z, xbc, dt_raw = jnp.split(proj, cuts, axis=-1)

    u = jax.nn.gelu(u, approximate=False)
    v = jax.nn.gelu(v, approximate=False)
    ya = chunk_mlp(u, v, w_s, b_s)
    v_rows = v[:, ((T - 1) // CHUNK) * CHUNK:]

    conv_out, conv_new = causal_dwconv(cgate * hb, conv_prev, conv_w)
    yb = bgate * conv_out

    xbc_c, sconv_new = causal_dwconv(xbc, sconv_prev, sconv_w, sconv_b)
    xbc_c = jax.nn.silu(xbc_c)
    xs, Bm, Cm = jnp.split(xbc_c, [C_WIDTH, C_WIDTH + SSM_GROUPS * D_STATE], axis=-1)
    xs = xs.reshape(bsz, T, SSM_HEADS, SSM_HEAD_DIM).astype(jnp.float32)
    Bm = Bm.reshape(bsz, T, SSM_GROUPS, D_STATE).astype(jnp.float32)
    Cm = Cm.reshape(bsz, T, SSM_GROUPS, D_STATE).astype(jnp.float32)
    dt = jax.nn.softplus(dt_raw.astype(jnp.float32) + dt_bias.astype(jnp.float32))
    A = -jnp.exp(a_log.astype(jnp.float32))
    y, ssm_new = ssd(xs, dt, A, Bm, Cm, ssm_prev.astype(jnp.float32))
    y = y + d_skip.astype(jnp.float32)[:, None] * xs
    y = y.reshape(bsz, T, C_WIDTH).astype(x.dtype)
    yc = rmsnorm(y * jax.nn.silu(z), ssm_norm)

    x = x + jnp.concatenate([ya, yb, yc], axis=-1) @ w_out
    f = jnp.square(jax.nn.relu(rmsnorm(x, g2) @ w_ff1))
    x = x + f @ w_ff2
    return x, v_rows, conv_new, sconv_new, ssm_new.astype(x.dtype)


def trunk(x, conv0, sconv0, ssm0, norm1, w_in, w_s, b_s, conv_w, ssm_conv_w, ssm_conv_b,
          dt_bias, a_log, d_skip, ssm_norm, w_out, norm2, w_ff1, w_ff2, final_norm):
    vs, cs, scs, ss = [], [], [], []
    for l in range(DEPTH):
        x, v_rows, c_new, sc_new, s_new = layer(
            x, conv0[l], sconv0[l], ssm0[l], norm1[l], w_in[l], w_s[l], b_s[l], conv_w[l],
            ssm_conv_w[l], ssm_conv_b[l], dt_bias[l], a_log[l], d_skip[l], ssm_norm[l],
            w_out[l], norm2[l], w_ff1[l], w_ff2[l])
        vs.append(v_rows); cs.append(c_new); scs.append(sc_new); ss.append(s_new)
    y = rmsnorm(x, final_norm)
    return y, jnp.stack(vs), jnp.stack(cs), jnp.stack(scs), jnp.stack(ss)


def setup_inputs(seed: int = 0) -> dict:
    key = jax.random.key(seed)
    ks = jax.random.split(key, 24)
    nrm = lambda k, shape, s: jax.random.normal(k, shape, jnp.float32) * s
    dt0 = jnp.exp(jax.random.uniform(ks[10], (DEPTH, SSM_HEADS), jnp.float32)
                  * (np.log(0.1) - np.log(0.001)) + np.log(0.001))
    return {
        "x_prompt": nrm(ks[0], (BATCH, SEQ, D_MODEL), 1.0),
        "x_sample": nrm(ks[1], (DEC_BATCH, DEC_SEQ, D_MODEL), 1.0),
        "state_conv": nrm(ks[2], (DEPTH, DEC_BATCH, CONV_B - 1, B_WIDTH), 0.5),
        "state_ssm_conv": nrm(ks[3], (DEPTH, DEC_BATCH, CONV_C - 1, SSM_CONV_DIM), 1.0),
        "state_ssm": nrm(ks[4], (DEPTH, DEC_BATCH, SSM_HEADS, SSM_HEAD_DIM, D_STATE), 0.1),
        "norm1": 1.0 + nrm(ks[5], (DEPTH, D_MODEL), 0.02),
        "w_in": nrm(ks[6], (DEPTH, D_MODEL, D_IN), D_MODEL ** -0.5),
        "w_s": nrm(ks[7], (DEPTH, A_HEADS, CHUNK, CHUNK), CHUNK ** -0.5),
        "b_s": nrm(ks[8], (DEPTH, A_HEADS, CHUNK), 0.1),
        "conv_w": nrm(ks[9], (DEPTH, CONV_B, B_WIDTH), CONV_B ** -0.5),
        "ssm_conv_w": nrm(ks[11], (DEPTH, CONV_C, SSM_CONV_DIM), CONV_C ** -0.5),
        "ssm_conv_b": nrm(ks[12], (DEPTH, SSM_CONV_DIM), 0.02),
        "dt_bias": dt0 + jnp.log(-jnp.expm1(-dt0)),
        "a_log": jnp.log(jax.random.uniform(ks[13], (DEPTH, SSM_HEADS), jnp.float32, 1.0, 16.0)),
        "d_skip": 1.0 + nrm(ks[14], (DEPTH, SSM_HEADS), 0.02),
        "ssm_norm": 1.0 + nrm(ks[15], (DEPTH, C_WIDTH), 0.02),
        "w_out": nrm(ks[16], (DEPTH, D_MIX, D_MODEL), D_MIX ** -0.5),
        "norm2": 1.0 + nrm(ks[17], (DEPTH, D_MODEL), 0.02),
        "w_ff1": nrm(ks[18], (DEPTH, D_MODEL, D_FF), D_MODEL ** -0.5),
        "w_ff2": nrm(ks[19], (DEPTH, D_FF, D_MODEL), D_FF ** -0.5),
        "final_norm": 1.0 + nrm(ks[20], (D_MODEL,), 0.02),
    }


def reference(x_prompt, x_sample, state_conv, state_ssm_conv, state_ssm, norm1, w_in, w_s, b_s,
              conv_w, ssm_conv_w, ssm_conv_b, dt_bias, a_log, d_skip, ssm_norm, w_out, norm2,
              w_ff1, w_ff2, final_norm):
    bp = x_prompt.shape[0]
    dtp = x_prompt.dtype
    conv0 = jnp.zeros((DEPTH, bp, CONV_B - 1, B_WIDTH), dtp)
    sconv0 = jnp.zeros((DEPTH, bp, CONV_C - 1, SSM_CONV_DIM), dtp)
    ssm0 = jnp.zeros((DEPTH, bp, SSM_HEADS, SSM_HEAD_DIM, D_STATE), dtp)
    y_prompt, chunk_v_prompt, conv_prompt, ssm_conv_prompt, ssm_prompt = trunk(
        x_prompt, conv0, sconv0, ssm0, norm1, w_in, w_s, b_s, conv_w, ssm_conv_w, ssm_conv_b,
        dt_bias, a_log, d_skip, ssm_norm, w_out, norm2, w_ff1, w_ff2, final_norm)
    y_sample, chunk_v_sample, conv_sample, ssm_conv_sample, ssm_sample = trunk(
        x_sample, state_conv, state_ssm_conv, state_ssm, norm1, w_in, w_s, b_s, conv_w,
        ssm_conv_w, ssm_conv_b, dt_bias, a_log, d_skip, ssm_norm, w_out, norm2, w_ff1, w_ff2,
        final_norm)
    return (y_prompt, y_sample, chunk_v_prompt, conv_prompt, ssm_conv_prompt, ssm_prompt,
            chunk_v_sample, conv_sample, ssm_conv_sample, ssm_sample)
```

```cpp
#include <hip/hip_runtime.h>
#include <cstdio>
#include <cstdint>

#ifndef MK_ONE_LAUNCH
#define MK_ONE_LAUNCH 0
#endif

namespace pg8 {
#define PG8_LAS __attribute__((address_space(3)))
typedef unsigned short bf16_t;
typedef short bf16x8 __attribute__((ext_vector_type(8)));
typedef float f32x4 __attribute__((ext_vector_type(4)));
typedef float f32x2 __attribute__((ext_vector_type(2)));
typedef unsigned u32x4 __attribute__((ext_vector_type(4)));
constexpr int BM = 256, BK = 64, HALF = 128, HTB = HALF * BK * 2, STAGE_BYTES = 8 * HTB, NXCD = 8, WGM = 8;

__host__ __device__ __forceinline__ int lds_byte(int r, int c) { const int st = (r >> 4) * 2 + (c >> 5), rr = r & 15, cc = c & 31, ob = rr * 64 + cc * 2; return st * 1024 + (ob ^ (((ob >> 9) & 1) << 5)); }
__host__ __device__ __forceinline__ void stage_rc(int b, int& R, int& C) { const int st = b / 1024, sb = b % 1024, swz = sb ^ (((sb >> 9) & 1) << 5); R = (st >> 1) * 16 + swz / 64; C = (st & 1) * 32 + (swz % 64) / 2; }
__host__ __device__ __forceinline__ int perm32(int rho) { const int n = rho >> 4, i = rho & 15; return 8 * (i >> 2) + 4 * n + (i & 3); }

struct Unit { int pm, pn; };
struct Gemm { const bf16_t* A; const bf16_t* Bt; int M, N, K; };

struct StaticOrder {
    int nM, nN, nwg, G, c;
    __host__ __device__ void init(int M, int N, int G_, int c_) { nM = M / BM; nN = N / BM; nwg = nM * nN; G = G_; c = c_; }
    __host__ __device__ bool next(int i, Unit& u) const {
        const long L = (long)i * G + c; if (L >= nwg) return false;
        int wgid = (int)L; { const int q = nwg / NXCD, r = nwg % NXCD, xcd = wgid % NXCD, off = wgid / NXCD; wgid = (xcd < r ? xcd * (q + 1) : r * (q + 1) + (xcd - r) * q) + off; }
        const int nig = WGM * nN, gid = wgid / nig, fm = gid * WGM, gsz = (nM - fm) < WGM ? (nM - fm) : WGM;
        u.pm = fm + ((wgid % nig) % gsz); u.pn = (wgid % nig) / gsz; return true;
    }
    __device__ __forceinline__ void a_ready(const Unit&) const {}
    __device__ __forceinline__ void done(const Unit&) const {}
};

__device__ __forceinline__ unsigned cvt_pk_bf16(float lo, float hi) { unsigned r; asm volatile("v_cvt_pk_bf16_f32 %0, %1, %2" : "=v"(r) : "v"(lo), "v"(hi)); return r; }
__device__ __forceinline__ f32x2 gelu_pk(f32x2 v) {
    const f32x2 av = __builtin_elementwise_abs(v), d = av * 0.2316418882f + 1.0f;
    f32x2 t; t.x = __builtin_amdgcn_rcpf(d.x); t.y = __builtin_amdgcn_rcpf(d.y);
    f32x2 q = t * 0.5307027145f + (-0.7265760135f); q = q * t + 0.7107068705f; q = q * t + (-0.142248368f); q = q * t + 0.127414796f; q = q * t;
    const f32x2 s = (v * v) * (-0.72134752044f);
    f32x2 e; e.x = __builtin_amdgcn_exp2f(s.x); e.y = __builtin_amdgcn_exp2f(s.y);
    const f32x2 m = v * (q * e), r = v - m;
    f32x2 o; o.x = v.x < 0.f ? m.x : r.x; o.y = v.y < 0.f ? m.y : r.y; return o;
}

__device__ __forceinline__ float row_rstd(const float* ss, int row, int fq) {
    const f32x4 v = *(const f32x4*)(ss + (size_t)row * 16 + 4 * fq);
    float s = (v[0] + v[1]) + (v[2] + v[3]);
    s += __shfl_xor(s, 16); s += __shfl_xor(s, 32);
    return __builtin_amdgcn_rsqf(s * (1.0f / 1024.0f) + 1e-5f);
}

template <int ACT> struct EpiScaleAct {
    static constexpr bool PERM = true, AFTER_DRAIN = false;
    bf16_t* O; int ldc; const float* ss; int gelu_tiles;
    __device__ __forceinline__ void operator()(const f32x4 (&acc)[2][2][4][2], const Unit& u, int wr, int wc, int fr, int fq) const {
        const int row0 = u.pm * BM + wr * 64 + fr; const int col0 = u.pn * BM + wc * 32 + 8 * fq;
        const bool gl = (ACT == 0) && (u.pn < gelu_tiles);
        float rsv[2][4];
#pragma unroll
        for (int ai = 0; ai < 2; ++ai)
#pragma unroll
            for (int m = 0; m < 4; ++m) rsv[ai][m] = row_rstd(ss, row0 + ai * HALF + m * 16, fq);
#pragma unroll
        for (int ai = 0; ai < 2; ++ai)
#pragma unroll
            for (int m = 0; m < 4; ++m) { const int r = row0 + ai * HALF + m * 16; const float rs = rsv[ai][m]; bf16_t* rowp = O + (size_t)r * ldc + col0;
#pragma unroll
                for (int bj = 0; bj < 2; ++bj) { f32x4 v0 = acc[ai][bj][m][0] * rs, v1 = acc[ai][bj][m][1] * rs;
                    if (ACT == 0) { if (gl) { f32x2 a = gelu_pk((f32x2){v0[0], v0[1]}), b = gelu_pk((f32x2){v0[2], v0[3]}), c = gelu_pk((f32x2){v1[0], v1[1]}), d = gelu_pk((f32x2){v1[2], v1[3]});
                        v0 = (f32x4){a.x, a.y, b.x, b.y}; v1 = (f32x4){c.x, c.y, d.x, d.y}; } }
                    else { v0 = __builtin_elementwise_max(v0, (f32x4){0.f, 0.f, 0.f, 0.f}); v1 = __builtin_elementwise_max(v1, (f32x4){0.f, 0.f, 0.f, 0.f}); v0 = v0 * v0; v1 = v1 * v1; }
                    u32x4 w; w.x = cvt_pk_bf16(v0[0], v0[1]); w.y = cvt_pk_bf16(v0[2], v0[3]); w.z = cvt_pk_bf16(v1[0], v1[1]); w.w = cvt_pk_bf16(v1[2], v1[3]);
                    *(u32x4*)(rowp + bj * HALF) = w; } }
    }
};
struct EpiRes {
    static constexpr bool PERM = true, AFTER_DRAIN = false;
    const float* baseP; const float* baseS; float* X; bf16_t* XB; float* ssout;
    __device__ __forceinline__ void operator()(const f32x4 (&acc)[2][2][4][2], const Unit& u, int wr, int wc, int fr, int fq) const {
        const int rl0 = wr * 64 + fr; const int col0 = u.pn * BM + wc * 32 + 8 * fq;
        const float* bp = (u.pm < 64) ? baseP + (size_t)u.pm * BM * 1024 : baseS + (size_t)(u.pm - 64) * BM * 1024;
#pragma unroll
        for (int ai = 0; ai < 2; ++ai)
#pragma unroll
            for (int m = 0; m < 4; ++m) { const int rl = rl0 + ai * HALF + m * 16; const size_t r = (size_t)u.pm * BM + rl; float sq = 0.f;
#pragma unroll
                for (int bj = 0; bj < 2; ++bj) { const float* src = bp + (size_t)rl * 1024 + col0 + bj * HALF;
                    const f32x4 x0 = *(const f32x4*)src + acc[ai][bj][m][0], x1 = *(const f32x4*)(src + 4) + acc[ai][bj][m][1];
                    float* dst = X + r * 1024 + col0 + bj * HALF; *(f32x4*)dst = x0; *(f32x4*)(dst + 4) = x1;
                    u32x4 w; w.x = cvt_pk_bf16(x0[0], x0[1]); w.y = cvt_pk_bf16(x0[2], x0[3]); w.z = cvt_pk_bf16(x1[0], x1[1]); w.w = cvt_pk_bf16(x1[2], x1[3]);
                    *(u32x4*)(XB + r * 1024 + col0 + bj * HALF) = w;
                    sq += (x0[0] * x0[0] + x0[1] * x0[1]) + (x0[2] * x0[2] + x0[3] * x0[3]) + (x1[0] * x1[0] + x1[1] * x1[1]) + (x1[2] * x1[2] + x1[3] * x1[3]); }
                sq += __shfl_xor(sq, 16); sq += __shfl_xor(sq, 32);
                if (fq == 0) ssout[r * 16 + u.pn * 4 + wc] = sq;
                if (m & 1) asm volatile("" ::: "memory"); }
    }
};

template <class Epi, class Sched, bool ALIGN_EPI = false, bool SP2 = false>
__device__ __forceinline__ void gemm_phase(PG8_LAS unsigned char* lds, const Gemm g, const Sched& S, const Epi& E, const int tid) {
    const int wid = __builtin_amdgcn_readfirstlane(tid >> 6), lane = tid & 63, wr = wid >> 2, wc = wid & 3, fr = lane & 15, fq = lane >> 4;
    const int K = g.K, nt = K / BK;
    unsigned voffA[2], voffB[2];
#pragma unroll
    for (int i = 0; i < 2; ++i) { int R, C; stage_rc(tid * 16 + i * 8192, R, C); const int Rb = Epi::PERM ? ((R & ~31) + perm32(R & 31)) : R;
        voffA[i] = (unsigned)(R * K + C) * 2u; voffB[i] = (unsigned)(Rb * K + C) * 2u; }
    const size_t kstep = (size_t)(BK * 2);
    const size_t hstep = (size_t)HALF * K * 2;
    const size_t tstep = 2 * hstep;
    const unsigned ldsw = (unsigned)wid * 1024u;
    const int aoff = lds_byte(wr * 64 + fr, fq * 8), boff = lds_byte(wc * 32 + fr, fq * 8);
#define PG8_SA(b, h) (((b) * 2 + (h)) * HTB)
#define PG8_SB(b, h) ((4 + (b) * 2 + (h)) * HTB)
#define PG8_STAGE(bufoff, gbase, voff) do { _Pragma("unroll") for (int _i = 0; _i < 2; ++_i) \
        __builtin_amdgcn_global_load_lds((const unsigned*)((const char*)(gbase) + (voff)[_i]), (PG8_LAS unsigned*)(lds + (bufoff) + ldsw + _i * 8192), 16, 0, 0); } while (0)
#define PG8_LDA(dst, b, h) do { _Pragma("unroll") for (int m = 0; m < 4; ++m) _Pragma("unroll") for (int k = 0; k < 2; ++k) dst[m][k] = *(const PG8_LAS bf16x8*)(lds + PG8_SA(b, h) + aoff + m * 2048 + k * 1024); } while (0)
#define PG8_LDB(dst, b, h) do { _Pragma("unroll") for (int n = 0; n < 2; ++n) _Pragma("unroll") for (int k = 0; k < 2; ++k) dst[n][k] = *(const PG8_LAS bf16x8*)(lds + PG8_SB(b, h) + boff + n * 2048 + k * 1024); } while (0)
#define PG8_MMA(ai, bj, At, Bt) do { __builtin_amdgcn_s_setprio(1); _Pragma("unroll") for (int m = 0; m < 4; ++m) _Pragma("unroll") for (int n = 0; n < 2; ++n) _Pragma("unroll") for (int k = 0; k < 2; ++k) \
        acc[ai][bj][m][n] = __builtin_amdgcn_mfma_f32_16x16x32_bf16(Bt[n][k], At[m][k], acc[ai][bj][m][n], 0, 0, 0); __builtin_amdgcn_s_setprio(0); } while (0)
#define PG8_WAIT_V(n) asm volatile("s_waitcnt vmcnt(" #n ")" ::: "memory")
#define PG8_WAIT_L(n) asm volatile("s_waitcnt lgkmcnt(" #n ")" ::: "memory")
#define PG8_BAR __builtin_amdgcn_s_barrier()
#define PG8_SCHED __builtin_amdgcn_sched_barrier(0)
    Unit cur, nxt; int ui = 0;
    if (!S.next(0, cur)) return;
    f32x4 acc[2][2][4][2];
#pragma unroll
    for (int a = 0; a < 2; ++a)
#pragma unroll
        for (int b = 0; b < 2; ++b)
#pragma unroll
            for (int m = 0; m < 4; ++m)
#pragma unroll
                for (int n = 0; n < 2; ++n) acc[a][b][m][n] = (f32x4){0.f, 0.f, 0.f, 0.f};
    bf16x8 At[4][2], B0[2][2], B1[2][2];
    const char* cA = (const char*)g.A + (size_t)cur.pm * tstep; const char* cB = (const char*)g.Bt + (size_t)cur.pn * tstep;
    S.a_ready(cur);
    if constexpr (SP2) {
        PG8_STAGE(PG8_SB(0, 0), cB, voffB); PG8_STAGE(PG8_SB(0, 1), cB + hstep, voffB); PG8_STAGE(PG8_SA(0, 0), cA, voffA); PG8_STAGE(PG8_SA(0, 1), cA + hstep, voffA);
        if (wr == 1) PG8_BAR;
        PG8_WAIT_V(2); PG8_BAR;
        PG8_STAGE(PG8_SB(1, 0), cB + kstep, voffB); PG8_STAGE(PG8_SA(1, 0), cA + kstep, voffA); PG8_STAGE(PG8_SB(1, 1), cB + hstep + kstep, voffB);
        PG8_WAIT_V(6); PG8_BAR;
    } else {
        PG8_STAGE(PG8_SB(0, 0), cB, voffB); PG8_STAGE(PG8_SA(0, 0), cA, voffA); PG8_STAGE(PG8_SB(0, 1), cB + hstep, voffB); PG8_STAGE(PG8_SA(0, 1), cA + hstep, voffA);
        if (wr == 1) PG8_BAR;
        PG8_WAIT_V(4); PG8_BAR;
        PG8_STAGE(PG8_SB(1, 0), cB + kstep, voffB); PG8_STAGE(PG8_SA(1, 0), cA + kstep, voffA); PG8_STAGE(PG8_SB(1, 1), cB + hstep + kstep, voffB);
        PG8_WAIT_V(6); PG8_BAR;
    }
    for (;;) {
        const bool has_next = S.next(ui + 1, nxt);
        const char* nA = has_next ? (const char*)g.A + (size_t)nxt.pm * tstep : cA; const char* nB = has_next ? (const char*)g.Bt + (size_t)nxt.pn * tstep : cB;
        for (int t = 0; t < nt; t += 2) {
            const bool last = (t == nt - 2);
            const char* a1 = cA + (size_t)(t + 1) * kstep;
            const char* a2 = last ? nA : cA + (size_t)(t + 2) * kstep; const char* b2 = last ? nB : cB + (size_t)(t + 2) * kstep;
            const char* a3 = a2 + kstep; const char* b3 = b2 + kstep;
            if (last && has_next) S.a_ready(nxt);
            if constexpr (SP2) {
            PG8_LDB(B0, 0, 0); PG8_LDB(B1, 0, 1); PG8_SCHED; PG8_LDA(At, 0, 0); PG8_STAGE(PG8_SA(1, 1), a1 + hstep, voffA);
            PG8_WAIT_V(8); PG8_WAIT_L(0); PG8_BAR; PG8_MMA(0, 0, At, B0); PG8_MMA(0, 1, At, B1); PG8_BAR; PG8_SCHED;
            PG8_LDA(At, 0, 1); PG8_STAGE(PG8_SB(0, 0), b2, voffB); PG8_STAGE(PG8_SB(0, 1), b2 + hstep, voffB); PG8_STAGE(PG8_SA(0, 0), a2, voffA);
            PG8_WAIT_V(8); PG8_WAIT_L(0); PG8_BAR; PG8_MMA(1, 0, At, B0); PG8_MMA(1, 1, At, B1); PG8_BAR; PG8_SCHED;
            PG8_LDB(B0, 1, 0); PG8_LDB(B1, 1, 1); PG8_SCHED; PG8_LDA(At, 1, 0); PG8_STAGE(PG8_SA(0, 1), a2 + hstep, voffA);
            PG8_WAIT_V(8); PG8_WAIT_L(0); PG8_BAR; PG8_MMA(0, 0, At, B0); PG8_MMA(0, 1, At, B1); PG8_BAR; PG8_SCHED;
            PG8_LDA(At, 1, 1); PG8_STAGE(PG8_SB(1, 0), b3, voffB); PG8_STAGE(PG8_SB(1, 1), b3 + hstep, voffB); PG8_STAGE(PG8_SA(1, 0), a3, voffA);
            PG8_WAIT_V(8); PG8_WAIT_L(0); PG8_BAR; PG8_MMA(1, 0, At, B0); PG8_MMA(1, 1, At, B1); PG8_BAR; PG8_SCHED;
            } else {
            PG8_LDB(B0, 0, 0); PG8_SCHED; PG8_LDA(At, 0, 0); PG8_STAGE(PG8_SA(1, 1), a1 + hstep, voffA);
            PG8_WAIT_L(8); PG8_BAR; PG8_WAIT_L(0); PG8_MMA(0, 0, At, B0); PG8_BAR; PG8_SCHED;
            PG8_LDB(B1, 0, 1); PG8_STAGE(PG8_SB(0, 0), b2, voffB);
            PG8_BAR; PG8_WAIT_L(0); PG8_MMA(0, 1, At, B1); PG8_BAR;
            PG8_LDA(At, 0, 1); PG8_STAGE(PG8_SA(0, 0), a2, voffA);
            PG8_BAR; PG8_WAIT_L(0); PG8_MMA(1, 0, At, B0); PG8_BAR; PG8_SCHED;
            PG8_STAGE(PG8_SB(0, 1), b2 + hstep, voffB);
            PG8_WAIT_V(6); PG8_BAR; PG8_MMA(1, 1, At, B1); PG8_BAR;
            PG8_LDB(B0, 1, 0); PG8_SCHED; PG8_LDA(At, 1, 0); PG8_STAGE(PG8_SA(0, 1), a2 + hstep, voffA);
            PG8_WAIT_L(8); PG8_BAR; PG8_WAIT_L(0); PG8_MMA(0, 0, At, B0); PG8_BAR; PG8_SCHED;
            PG8_LDB(B1, 1, 1); PG8_STAGE(PG8_SB(1, 0), b3, voffB);
            PG8_BAR; PG8_WAIT_L(0); PG8_MMA(0, 1, At, B1); PG8_BAR;
            PG8_LDA(At, 1, 1); PG8_STAGE(PG8_SA(1, 0), a3, voffA);
            PG8_BAR; PG8_WAIT_L(0); PG8_MMA(1, 0, At, B0); PG8_BAR; PG8_SCHED;
            PG8_STAGE(PG8_SB(1, 1), b3 + hstep, voffB);
            PG8_WAIT_V(6); PG8_BAR; PG8_MMA(1, 1, At, B1); PG8_BAR;
            }
        }
        if constexpr (ALIGN_EPI) { if (wr == 0) PG8_BAR; }
        if constexpr (!Epi::AFTER_DRAIN) { E(acc, cur, wr, wc, fr, fq); S.done(cur); }
        if (!has_next) break;
#pragma unroll
        for (int a = 0; a < 2; ++a)
#pragma unroll
            for (int b = 0; b < 2; ++b)
#pragma unroll
                for (int m = 0; m < 4; ++m)
#pragma unroll
                    for (int n = 0; n < 2; ++n) acc[a][b][m][n] = (f32x4){0.f, 0.f, 0.f, 0.f};
        cur = nxt; cA = nA; cB = nB; ++ui;
        if constexpr (ALIGN_EPI) { if (wr == 1) PG8_BAR; }
    }
    PG8_WAIT_V(0);
    if constexpr (!ALIGN_EPI) { if (wr == 0) PG8_BAR; }
    PG8_BAR;
#undef PG8_SA
#undef PG8_SB
#undef PG8_STAGE
#undef PG8_LDA
#undef PG8_LDB
#undef PG8_MMA
#undef PG8_WAIT_V
#undef PG8_WAIT_L
#undef PG8_BAR
#undef PG8_SCHED
}
}

constexpr int NWAVES = 8;
constexpr int DM = 1024, DEPTH = 4, MP = 16384, MS = 1024, M = MP + MS, SEQ = 2048, DSEQ = 8, NB = 8, NDB = 128;
constexpr int DIN = 2824, DING = 2816, FF = 4096;
constexpr int C_U = 0, C_V = 256, C_BG = 512, C_CG = 768, C_HB = 1024, C_Z = 1280, C_XBC = 1792, C_DT = 2816;
constexpr float EPS = 1e-5f;
constexpr size_t O_YP = 0, O_YS = 16777216, O_CVP = 17825792, O_CP = 18874368, O_SCP = 18890752, O_SP = 18989056, O_CVS = 21086208, O_CS = 22134784, O_SCS = 22396928, O_SS = 23969792, O_END = 57524224;
enum { I_XP = 0, I_XS, I_SC, I_SSC, I_SSM, I_N1, I_WIN, I_WS, I_BS, I_CW, I_SCW, I_SCB, I_DTB, I_ALOG, I_DSK, I_SSN, I_WOUT, I_N2, I_W1, I_W2, I_FN, N_IN };

constexpr size_t al256(size_t x) { return (x + 255) & ~(size_t)255; }
constexpr size_t WS_CTL = 0, CTL_ZERO_BYTES = 1u << 20;
constexpr size_t WS_WIN = CTL_ZERO_BYTES;
constexpr size_t WS_WOUT = WS_WIN + (size_t)DEPTH * DING * DM * 2;
constexpr size_t WS_W1 = WS_WOUT + (size_t)DEPTH * DM * DM * 2;
constexpr size_t WS_W2 = WS_W1 + (size_t)DEPTH * FF * DM * 2;
constexpr size_t WS_WDT = WS_W2 + (size_t)DEPTH * DM * FF * 2;
constexpr size_t WS_XB = WS_WDT + (size_t)DEPTH * DM * 8 * 4;
constexpr size_t WS_SS1 = WS_XB + (size_t)M * DM * 2;
constexpr size_t WS_SS2 = WS_SS1 + (size_t)M * 16 * 4;
constexpr size_t WS_DT = WS_SS2 + (size_t)M * 16 * 4;
constexpr size_t WS_YCAT = WS_DT + (size_t)M * 8 * 4;
constexpr size_t WS_Y = WS_YCAT + (size_t)M * DM * 2;
constexpr size_t WS_PROJ = WS_Y + (size_t)M * 512 * 4;
constexpr size_t WS_XBC = WS_PROJ + (size_t)M * DING * 2;
constexpr size_t WS_HID = WS_PROJ;
constexpr size_t WS_END = WS_XBC + (size_t)M * DM * 4;
static_assert(WS_HID + (size_t)M * FF * 2 <= WS_END, "HID overlay");
static_assert(WS_WIN % 256 == 0 && WS_XB % 256 == 0 && WS_SS1 % 256 == 0 && WS_PROJ % 256 == 0 && WS_XBC % 256 == 0 && WS_Y % 256 == 0, "align");
constexpr int CW_BAR = 4096;

constexpr int RING_BYTES = 131072, LDSCTL_OFF = RING_BYTES, MISC_OFF = LDSCTL_OFF + 320, LDS_BYTES = 147456;

#define GAS __attribute__((address_space(1)))
#define LAS __attribute__((address_space(3)))
typedef unsigned short bf16;
typedef unsigned v4u __attribute__((ext_vector_type(4)));
typedef unsigned v2u __attribute__((ext_vector_type(2)));
typedef float f32x4 __attribute__((ext_vector_type(4)));
typedef GAS unsigned gu32;
#define RLX_AGENT __ATOMIC_RELAXED, __HIP_MEMORY_SCOPE_AGENT
#define LDS_WAIT() asm volatile("s_waitcnt lgkmcnt(0)" ::: "memory")
__device__ __forceinline__ unsigned f2bf(float f) { unsigned u = __builtin_bit_cast(unsigned, f); return (u + 0x7fffu + ((u >> 16) & 1u)) >> 16; }
__device__ __forceinline__ unsigned pk2(float lo, float hi) { return f2bf(lo) | (f2bf(hi) << 16); }
__device__ __forceinline__ float bf2f(unsigned b) { return __builtin_bit_cast(float, b << 16); }
__device__ __forceinline__ float bflo(unsigned w) { return __builtin_bit_cast(float, w << 16); }
__device__ __forceinline__ float bfhi(unsigned w) { return __builtin_bit_cast(float, w & 0xffff0000u); }

#define XB_TMO      128
#define XB_XCNT(j)  (256  + 64 * (j))
#define XB_XSUB(j)  (1280 + 64 * (j))
#define XB_XGEN(j)  (2304 + 64 * (j))
#define XB_TOP      3328
#define XB_TOPGEN   3392
#define XCD_BAR_WORDS 3456
#define XB_SPIN_CAP (1u << 18)
__device__ __forceinline__ unsigned xb_ld(unsigned* p)              { return __hip_atomic_load(p, __ATOMIC_RELAXED, __HIP_MEMORY_SCOPE_AGENT); }
__device__ __forceinline__ unsigned xb_add(unsigned* p, unsigned v) { return __hip_atomic_fetch_add(p, v, __ATOMIC_RELAXED, __HIP_MEMORY_SCOPE_AGENT); }
__device__ __forceinline__ unsigned xb_xcc_id() { return (unsigned)__builtin_amdgcn_s_getreg((3 << 11) | 20) & 0xFu; }
#define XB_SPIN(cond, bar) do { unsigned _sp = 0; while (cond) { __builtin_amdgcn_s_sleep(1); \
    if ((++_sp & 255u) == 0u) { if (xb_ld(&(bar)[XB_TMO])) break; if (_sp > XB_SPIN_CAP) { atomicAdd(&(bar)[XB_TMO], 1u); break; } } } } while (0)
struct XcdBarrier { unsigned* bar; unsigned x; volatile LAS unsigned* st; };
__device__ __forceinline__ XcdBarrier xcd_barrier_post(unsigned* bar, volatile LAS unsigned* st) {
    XcdBarrier b; b.bar = bar; b.x = xb_xcc_id(); b.st = st;
    if (threadIdx.x == 0) (void)xb_add(&bar[XB_XCNT(b.x)], 1u);
    return b;
}
__device__ __forceinline__ void xcd_barrier_complete(unsigned* bar, unsigned x, unsigned& nloc, unsigned& nx) {
    const unsigned G = gridDim.x * gridDim.y * gridDim.z;
    unsigned sum, cnt, mine, sp = 0u;
    for (;;) {
        sum = 0u; cnt = 0u; mine = 0u;
#pragma unroll
        for (unsigned j = 0; j < 16; ++j) { const unsigned c = xb_ld(&bar[XB_XCNT(j)]); sum += c; cnt += (c > 0u) ? 1u : 0u; mine = (j == x) ? c : mine; }
        if (sum == G) break;
        __builtin_amdgcn_s_sleep(1);
        if ((++sp & 255u) == 0u) { if (xb_ld(&bar[XB_TMO])) break; if (sp > XB_SPIN_CAP) { atomicAdd(&bar[XB_TMO], 1u); break; } }
    }
    nloc = mine > 0u ? mine : 1u; nx = cnt > 0u ? cnt : 1u;
}
__device__ __forceinline__ void xcd_barrier(const XcdBarrier& b) {
    asm volatile("s_waitcnt vmcnt(0)" ::: "memory");
    __syncthreads();
    if (threadIdx.x == 0) {
        unsigned* bar = b.bar;
        __builtin_amdgcn_s_waitcnt(0);
        unsigned nloc = b.st[0], nx = b.st[1];
        if (nloc == 0u) { xcd_barrier_complete(bar, b.x, nloc, nx); b.st[0] = nloc; b.st[1] = nx; }
        const unsigned old = xb_add(&bar[XB_XSUB(b.x)], 1u);
        const unsigned gen = old / nloc;
        if (old + 1u == (gen + 1u) * nloc) {
            __builtin_amdgcn_fence(__ATOMIC_RELEASE, "agent");
            asm volatile("s_waitcnt vmcnt(0)" ::: "memory");
            const unsigned og = xb_add(&bar[XB_TOP], 1u);
            const unsigned tg = og / nx;
            if (og + 1u == (tg + 1u) * nx) xb_add(&bar[XB_TOPGEN], 1u);
            else XB_SPIN(xb_ld(&bar[XB_TOPGEN]) == tg, bar);
            __builtin_amdgcn_fence(__ATOMIC_ACQUIRE, "agent");
            xb_add(&bar[XB_XGEN(b.x)], 1u);
            asm volatile("s_waitcnt vmcnt(0)" ::: "memory");
        } else {
            XB_SPIN(xb_ld(&bar[XB_XGEN(b.x)]) == gen, bar);
            __builtin_amdgcn_fence(__ATOMIC_ACQUIRE, "agent");
            asm volatile("s_waitcnt vmcnt(0)" ::: "memory");
        }
    }
    __syncthreads();
}

struct Args { const float* in[N_IN]; float* out; unsigned char* ws; int ph_lo, ph_hi; };
struct Frame {
    LAS unsigned char* lds;
    int tid, lane, wave, vcu, G, bid;
    const __attribute__((address_space(4))) Args* ap; float* out; unsigned char* ws;
    __device__ __forceinline__ const float* inp(int i) const { return ap->in[i]; }
};
__device__ __forceinline__ float wave_sum(float v) {
#pragma unroll
    for (int o = 1; o < 64; o <<= 1) v += __shfl_xor(v, o);
    return v;
}
__device__ __forceinline__ float silu_f(float v) { return v / (1.0f + __expf(-v)); }
__device__ __forceinline__ float softplus_f(float v) { return fmaxf(v, 0.f) + log1pf(expf(-fabsf(v))); }

__device__ __forceinline__ void p0_transpose_item(const float* W, int ldw, int K, int nblk, const float* gain, bf16* WT, LAS float* scr, int item, int lane) {
    const int kb = item / nblk, nb = item % nblk, k0 = 64 * kb, n0 = 32 * nb;
#pragma unroll 8
    for (int i = 0; i < 32; ++i) { const int kk = 2 * i + (lane >> 5); const float g = gain ? gain[k0 + kk] : 1.0f; scr[kk * 33 + (lane & 31)] = W[(size_t)(k0 + kk) * ldw + n0 + (lane & 31)] * g; }
    LDS_WAIT(); asm volatile("" ::: "memory");
    const int c = lane & 7;
#pragma unroll
    for (int j = 0; j < 4; ++j) { const int n = (lane >> 3) + 8 * j; const LAS float* s = scr + (8 * c) * 33 + n;
        v4u o; o.x = pk2(s[0 * 33], s[1 * 33]); o.y = pk2(s[2 * 33], s[3 * 33]); o.z = pk2(s[4 * 33], s[5 * 33]); o.w = pk2(s[6 * 33], s[7 * 33]);
        *(v4u*)(WT + (size_t)(n0 + n) * K + k0 + 8 * c) = o; }
    LDS_WAIT(); asm volatile("" ::: "memory");
}
__device__ __forceinline__ const float* xin_row(const Frame& F, int l, int r) {
    if (l == 0) return r < MP ? F.inp(I_XP) + (size_t)r * DM : F.inp(I_XS) + (size_t)(r - MP) * DM;
    return F.out + (size_t)r * DM;
}
__device__ __forceinline__ void p0_prologue(const Frame& F) {
    LAS float* scr = (LAS float*)(F.lds + F.wave * 16384);
    const int gw = F.vcu * NWAVES + F.wave, NGW = F.G * NWAVES;
    constexpr int I_IN = (DM / 64) * (DING / 32), I_O = (DM / 64) * (DM / 32), I_1 = (DM / 64) * (FF / 32), I_2 = (FF / 64) * (DM / 32), I_L = I_IN + I_O + I_1 + I_2;
    for (int it = gw; it < DEPTH * I_L; it += NGW) {
        const int l = it / I_L; int r = it % I_L;
        if (r < I_IN) { p0_transpose_item(F.inp(I_WIN) + (size_t)l * DM * DIN, DIN, DM, DING / 32, F.inp(I_N1) + l * DM, (bf16*)(F.ws + WS_WIN) + (size_t)l * DING * DM, scr, r, F.lane); continue; } r -= I_IN;
        if (r < I_O) { p0_transpose_item(F.inp(I_WOUT) + (size_t)l * DM * DM, DM, DM, DM / 32, nullptr, (bf16*)(F.ws + WS_WOUT) + (size_t)l * DM * DM, scr, r, F.lane); continue; } r -= I_O;
        if (r < I_1) { p0_transpose_item(F.inp(I_W1) + (size_t)l * DM * FF, FF, DM, FF / 32, F.inp(I_N2) + l * DM, (bf16*)(F.ws + WS_W1) + (size_t)l * FF * DM, scr, r, F.lane); continue; } r -= I_1;
        p0_transpose_item(F.inp(I_W2) + (size_t)l * FF * DM, DM, FF, DM / 32, nullptr, (bf16*)(F.ws + WS_W2) + (size_t)l * DM * FF, scr, r, F.lane);
    }
    for (int i = (F.vcu * NWAVES + F.wave) * 64 + F.lane; i < DEPTH * DM * 8; i += NGW * 64) { const int l = i / (DM * 8), k = (i / 8) % DM, j = i % 8;
        ((float*)(F.ws + WS_WDT))[i] = F.inp(I_N1)[l * DM + k] * F.inp(I_WIN)[((size_t)l * DM + k) * DIN + C_DT + j]; }
    for (int r = gw; r < M; r += NGW) {
        const f32x4* xr = (const f32x4*)xin_row(F, 0, r) + F.lane; float s = 0.f;
        v2u* o8 = (v2u*)((bf16*)(F.ws + WS_XB) + (size_t)r * DM) + F.lane;
#pragma unroll
        for (int j = 0; j < 4; ++j) { const f32x4 v = xr[64 * j]; s += (v.x * v.x + v.y * v.y) + (v.z * v.z + v.w * v.w); v2u w; w.x = pk2(v.x, v.y); w.y = pk2(v.z, v.w); o8[64 * j] = w; }
        s = wave_sum(s);
        if (F.lane < 16) ((float*)(F.ws + WS_SS1))[(size_t)r * 16 + F.lane] = F.lane == 0 ? s : 0.f;
    }
}

__device__ __forceinline__ float rstd_row16(const float* ss, int r) {
    const float* p = ss + (size_t)r * 16; float s = 0.f;
#pragma unroll
    for (int i = 0; i < 16; ++i) s += p[i];
    return 1.0f / sqrtf(s * (1.0f / DM) + EPS);
}
__device__ __forceinline__ void conv_phase(const Frame& F, int l) {
    const int gw = F.vcu * NWAVES + F.wave, NGW = F.G * NWAVES, lane = F.lane;
    const bf16* PROJ = (const bf16*)(F.ws + WS_PROJ); bf16* YCAT = (bf16*)(F.ws + WS_YCAT); float* XBC = (float*)(F.ws + WS_XBC); float* DT = (float*)(F.ws + WS_DT);
    const float* cw = F.inp(I_CW) + l * 3 * 256; const float* scw = F.inp(I_SCW) + l * 4 * 1024; const float* scb = F.inp(I_SCB) + l * 1024;
    const float* wdt = (const float*)(F.ws + WS_WDT) + l * DM * 8;
    for (int r = gw; r < M; r += NGW) {
        const bool samp = r >= MP; const int t = samp ? ((r - MP) & 7) : (r & 2047); const int sidx = samp ? ((r - MP) >> 3) : (r >> 11); const int T = samp ? DSEQ : SEQ;
        {
            const int ch = 4 * lane; float cin[3][4];
#pragma unroll
            for (int k = 0; k < 3; ++k) { const int back = 2 - k;
                if (t - back >= 0) { const v2u cg = *(const v2u*)(PROJ + (size_t)(r - back) * DING + C_CG + ch), hb = *(const v2u*)(PROJ + (size_t)(r - back) * DING + C_HB + ch);
                    cin[k][0] = bflo(cg.x) * bflo(hb.x); cin[k][1] = bfhi(cg.x) * bfhi(hb.x); cin[k][2] = bflo(cg.y) * bflo(hb.y); cin[k][3] = bfhi(cg.y) * bfhi(hb.y); }
                else if (samp) { const f32x4 v = *(const f32x4*)(F.inp(I_SC) + ((size_t)(l * NDB + sidx) * 2 + (2 + t - back)) * 256 + ch); cin[k][0] = v.x; cin[k][1] = v.y; cin[k][2] = v.z; cin[k][3] = v.w; }
                else { cin[k][0] = cin[k][1] = cin[k][2] = cin[k][3] = 0.f; } }
            const v2u bg = *(const v2u*)(PROJ + (size_t)r * DING + C_BG + ch); const float bgf[4] = {bflo(bg.x), bfhi(bg.x), bflo(bg.y), bfhi(bg.y)}; float yb[4];
#pragma unroll
            for (int j = 0; j < 4; ++j) yb[j] = bgf[j] * (cw[ch + j] * cin[0][j] + cw[256 + ch + j] * cin[1][j] + cw[512 + ch + j] * cin[2][j]);
            v2u w; w.x = pk2(yb[0], yb[1]); w.y = pk2(yb[2], yb[3]); *(v2u*)(YCAT + (size_t)r * DM + 256 + ch) = w;
            if (t >= T - 2) { float* dst = samp ? F.out + O_CS + ((size_t)(l * NDB + sidx) * 2 + (t - (T - 2))) * 256 : F.out + O_CP + ((size_t)(l * NB + sidx) * 2 + (t - (T - 2))) * 256;
                *(f32x4*)(dst + ch) = (f32x4){cin[2][0], cin[2][1], cin[2][2], cin[2][3]}; }
        }
#pragma unroll 1
        for (int jg = 0; jg < 4; ++jg) {
            const int ch = jg * 256 + 4 * lane; float xv[4][4];
#pragma unroll
            for (int k = 0; k < 4; ++k) { const int back = 3 - k;
                if (t - back >= 0) { const v2u x = *(const v2u*)(PROJ + (size_t)(r - back) * DING + C_XBC + ch); xv[k][0] = bflo(x.x); xv[k][1] = bfhi(x.x); xv[k][2] = bflo(x.y); xv[k][3] = bfhi(x.y); }
                else if (samp) { const f32x4 v = *(const f32x4*)(F.inp(I_SSC) + ((size_t)(l * NDB + sidx) * 3 + (3 + t - back)) * 1024 + ch); xv[k][0] = v.x; xv[k][1] = v.y; xv[k][2] = v.z; xv[k][3] = v.w; }
                else { xv[k][0] = xv[k][1] = xv[k][2] = xv[k][3] = 0.f; } }
            f32x4 o;
#pragma unroll
            for (int j = 0; j < 4; ++j) { const float v = scb[ch + j] + scw[ch + j] * xv[0][j] + scw[1024 + ch + j] * xv[1][j] + scw[2048 + ch + j] * xv[2][j] + scw[3072 + ch + j] * xv[3][j]; o[j] = silu_f(v); }
            *(f32x4*)(XBC + (size_t)r * 1024 + ch) = o;
            if (t >= T - 3) { float* dst = samp ? F.out + O_SCS + ((size_t)(l * NDB + sidx) * 3 + (t - (T - 3))) * 1024 : F.out + O_SCP + ((size_t)(l * NB + sidx) * 3 + (t - (T - 3))) * 1024;
                *(f32x4*)(dst + ch) = (f32x4){xv[3][0], xv[3][1], xv[3][2], xv[3][3]}; }
        }
        {
            const float* xr = xin_row(F, l, r) + lane * 16; const float* wd = wdt + lane * 16 * 8;
            float a0 = 0.f, a1 = 0.f, a2 = 0.f, a3 = 0.f, a4 = 0.f, a5 = 0.f, a6 = 0.f, a7 = 0.f;
#pragma unroll
            for (int i = 0; i < 16; ++i) { const float xk = xr[i]; const f32x4 w0 = *(const f32x4*)(wd + i * 8), w1 = *(const f32x4*)(wd + i * 8 + 4);
                a0 += xk * w0.x; a1 += xk * w0.y; a2 += xk * w0.z; a3 += xk * w0.w; a4 += xk * w1.x; a5 += xk * w1.y; a6 += xk * w1.z; a7 += xk * w1.w; }
            a0 = wave_sum(a0); a1 = wave_sum(a1); a2 = wave_sum(a2); a3 = wave_sum(a3); a4 = wave_sum(a4); a5 = wave_sum(a5); a6 = wave_sum(a6); a7 = wave_sum(a7);
            const float rs = rstd_row16((const float*)(F.ws + WS_SS1), r);
            float mine = a0; mine = lane == 1 ? a1 : mine; mine = lane == 2 ? a2 : mine; mine = lane == 3 ? a3 : mine; mine = lane == 4 ? a4 : mine; mine = lane == 5 ? a5 : mine; mine = lane == 6 ? a6 : mine; mine = lane == 7 ? a7 : mine;
            if (lane < 8) DT[(size_t)r * 8 + lane] = softplus_f(mine * rs + F.inp(I_DTB)[l * 8 + lane]);
        }
    }
}
__device__ __forceinline__ void mixa_phase(const Frame& F, int l) {
    LAS bf16* Vs = (LAS bf16*)F.lds;
    const bf16* PROJ = (const bf16*)(F.ws + WS_PROJ); bf16* YCAT = (bf16*)(F.ws + WS_YCAT);
    const int tid = F.tid;
    for (int u = F.vcu; u < 256; u += F.G) {
        const int r0 = u < 128 ? u * 128 : MP + (u - 128) * 8, Tn = u < 128 ? 128 : 8;
        __syncthreads();
        for (int i = tid; i < Tn * 32; i += NWAVES * 64) { const int tt = i >> 5, c8 = i & 31; *(LAS v4u*)(Vs + tt * 256 + c8 * 8) = *(const v4u*)(PROJ + (size_t)(r0 + tt) * DING + C_V + c8 * 8); }
        __syncthreads();
        const int col = tid & 255, th = tid >> 8, h = col >> 6;
        const float* ws = F.inp(I_WS) + (size_t)(l * 4 + h) * 128 * 128; const float* bs = F.inp(I_BS) + (l * 4 + h) * 128;
        for (int t = th; t < Tn; t += 2) {
            float acc = bs[t]; const float* wr = ws + t * 128;
            for (int s2 = 0; s2 <= t; ++s2) acc += wr[s2] * bf2f(Vs[s2 * 256 + col]);
            const float uu = bf2f(PROJ[(size_t)(r0 + t) * DING + C_U + col]);
            YCAT[(size_t)(r0 + t) * DM + col] = (bf16)f2bf(uu * acc);
        }
        if (u < 128) { if ((u & 15) == 15) { float* dst = F.out + O_CVP + (size_t)(l * NB + (u >> 4)) * 128 * 256; for (int i = tid; i < 128 * 256; i += NWAVES * 64) dst[i] = bf2f(Vs[i]); } }
        else { float* dst = F.out + O_CVS + (size_t)(l * NDB + (u - 128)) * 8 * 256; for (int i = tid; i < 8 * 256; i += NWAVES * 64) dst[i] = bf2f(Vs[i]); }
    }
}
__device__ __forceinline__ void ssd_naive_phase(const Frame& F, int l) {
    LAS float* Bs = (LAS float*)F.lds; LAS float* Cs = Bs + 32 * 128; LAS float* Xs = Cs + 32 * 128; LAS float* Dts = Xs + 32 * 16;
    const float* XBC = (const float*)(F.ws + WS_XBC); const float* DT = (const float*)(F.ws + WS_DT); float* Y = (float*)(F.ws + WS_Y);
    const int tid = F.tid, pl = tid >> 5, nq = tid & 31;
    for (int u = F.vcu; u < 256 + 4096; u += F.G) {
        int T, r0, h, pq; const float* h0; float* hout;
        if (u < 256) { const int b = u >> 5; h = (u >> 2) & 7; pq = u & 3; T = SEQ; r0 = b * SEQ; h0 = nullptr; hout = F.out + O_SP + ((size_t)(l * NB + b) * 8 + h) * 8192; }
        else { const int v = u - 256, s = v >> 5; h = (v >> 2) & 7; pq = v & 3; T = DSEQ; r0 = MP + s * DSEQ; h0 = F.inp(I_SSM) + ((size_t)(l * NDB + s) * 8 + h) * 8192; hout = F.out + O_SS + ((size_t)(l * NDB + s) * 8 + h) * 8192; }
        const int g = h >> 2, p = pq * 16 + pl;
        const float A = -expf(F.inp(I_ALOG)[l * 8 + h]), dsk = F.inp(I_DSK)[l * 8 + h];
        f32x4 st = (f32x4){0.f, 0.f, 0.f, 0.f};
        if (h0) st = *(const f32x4*)(h0 + p * 128 + 4 * nq);
        for (int t0 = 0; t0 < T; t0 += 32) {
            const int nb = (T - t0) < 32 ? (T - t0) : 32;
            __syncthreads();
            for (int i = tid; i < nb * 128; i += NWAVES * 64) { const int tt = i >> 7, n = i & 127; const float* xr = XBC + (size_t)(r0 + t0 + tt) * 1024; Bs[i] = xr[512 + g * 128 + n]; Cs[i] = xr[768 + g * 128 + n]; }
            for (int i = tid; i < nb * 16; i += NWAVES * 64) { const int tt = i >> 4, pp = i & 15; Xs[i] = XBC[(size_t)(r0 + t0 + tt) * 1024 + h * 64 + pq * 16 + pp]; }
            if (tid < nb) Dts[tid] = DT[(size_t)(r0 + t0 + tid) * 8 + h];
            __syncthreads();
            for (int tt = 0; tt < nb; ++tt) {
                const float dt = Dts[tt], dec = __expf(dt * A), xr = Xs[tt * 16 + pl], xv = xr * dt;
                const f32x4 B4 = *(const LAS f32x4*)(Bs + tt * 128 + 4 * nq), C4 = *(const LAS f32x4*)(Cs + tt * 128 + 4 * nq);
                st = st * dec + B4 * xv;
                float part = (st.x * C4.x + st.y * C4.y) + (st.z * C4.z + st.w * C4.w);
                part += __shfl_xor(part, 1); part += __shfl_xor(part, 2); part += __shfl_xor(part, 4); part += __shfl_xor(part, 8); part += __shfl_xor(part, 16);
                if (nq == 0) Y[(size_t)(r0 + t0 + tt) * 512 + h * 64 + p] = part + dsk * xr;
            }
        }
        *(f32x4*)(hout + p * 128 + 4 * nq) = st;
    }
}
__device__ __forceinline__ void gnorm_phase(const Frame& F, int l) {
    const int gw = F.vcu * NWAVES + F.wave, NGW = F.G * NWAVES, lane = F.lane;
    const bf16* PROJ = (const bf16*)(F.ws + WS_PROJ); bf16* YCAT = (bf16*)(F.ws + WS_YCAT); const float* Y = (const float*)(F.ws + WS_Y);
    const float* gn = F.inp(I_SSN) + l * 512 + 8 * lane;
    for (int r = gw; r < M; r += NGW) {
        const f32x4 y0 = *(const f32x4*)(Y + (size_t)r * 512 + 8 * lane), y1 = *(const f32x4*)(Y + (size_t)r * 512 + 8 * lane + 4);
        const v4u z = *(const v4u*)(PROJ + (size_t)r * DING + C_Z + 8 * lane);
        float gv[8] = {y0.x * silu_f(bflo(z.x)), y0.y * silu_f(bfhi(z.x)), y0.z * silu_f(bflo(z.y)), y0.w * silu_f(bfhi(z.y)), y1.x * silu_f(bflo(z.z)), y1.y * silu_f(bfhi(z.z)), y1.z * silu_f(bflo(z.w)), y1.w * silu_f(bfhi(z.w))};
        float s = 0.f;
#pragma unroll
        for (int j = 0; j < 8; ++j) s += gv[j] * gv[j];
        s = wave_sum(s); const float rs = 1.0f / sqrtf(s * (1.0f / 512.0f) + EPS);
        v4u w; w.x = pk2(gv[0] * rs * gn[0], gv[1] * rs * gn[1]); w.y = pk2(gv[2] * rs * gn[2], gv[3] * rs * gn[3]); w.z = pk2(gv[4] * rs * gn[4], gv[5] * rs * gn[5]); w.w = pk2(gv[6] * rs * gn[6], gv[7] * rs * gn[7]);
        *(v4u*)(YCAT + (size_t)r * DM + 512 + 8 * lane) = w;
    }
}
__device__ __forceinline__ void final_phase(const Frame& F) {
    const int gw = F.vcu * NWAVES + F.wave, NGW = F.G * NWAVES, lane = F.lane;
    const f32x4* gp = (const f32x4*)F.inp(I_FN) + lane;
    for (int r = gw; r < M; r += NGW) {
        f32x4* xr = (f32x4*)(F.out + (size_t)r * DM) + lane; f32x4 v[4]; float s = 0.f;
#pragma unroll
        for (int j = 0; j < 4; ++j) { v[j] = xr[64 * j]; s += (v[j].x * v[j].x + v[j].y * v[j].y) + (v[j].z * v[j].z + v[j].w * v[j].w); }
        s = wave_sum(s); const float rs = 1.0f / sqrtf(s * (1.0f / DM) + EPS);
#pragma unroll
        for (int j = 0; j < 4; ++j) xr[64 * j] = v[j] * rs * gp[64 * j];
    }
}

constexpr int PH_PER_LAYER = 7, N_PHASES = 1 + DEPTH * PH_PER_LAYER + 1;
__global__ void __launch_bounds__(NWAVES * 64, 2) mega(Args args) {
    extern __shared__ __attribute__((aligned(16))) unsigned char lds[];
    Frame F;
    F.lds = (LAS unsigned char*)lds;
    F.tid = threadIdx.x; F.lane = F.tid & 63; F.wave = __builtin_amdgcn_readfirstlane(F.tid >> 6);
    F.G = gridDim.x; { const int bx = blockIdx.x; F.vcu = (F.G % 8 == 0) ? (bx % 8) * (F.G / 8) + bx / 8 : bx; }
    const __attribute__((address_space(4))) Args* ap0 = (const __attribute__((address_space(4))) Args*)__builtin_amdgcn_kernarg_segment_ptr();
    F.ap = ap0; F.out = args.out; F.ws = args.ws;
    volatile LAS unsigned* MISC = (volatile LAS unsigned*)(F.lds + MISC_OFF);
    for (int u = F.tid; u < (LDS_BYTES - LDSCTL_OFF) / 4; u += NWAVES * 64) ((LAS unsigned*)(F.lds + LDSCTL_OFF))[u] = 0u;
    __syncthreads();
    const bool multi = args.ph_hi - args.ph_lo > 1;
    XcdBarrier bar; bar.bar = (unsigned*)(F.ws + WS_CTL) + CW_BAR; bar.x = 0; bar.st = nullptr;
    if (multi) bar = xcd_barrier_post((unsigned*)(F.ws + WS_CTL) + CW_BAR, MISC + 8);

    for (int ph = args.ph_lo; ph < args.ph_hi; ++ph) {
        {
            const __attribute__((address_space(4))) Args* q = ap0; asm volatile("" : "+s"(q)); F.ap = q; F.out = q->out; F.ws = q->ws;
            int t_ = threadIdx.x; asm volatile("" : "+v"(t_)); F.tid = t_; F.lane = t_ & 63; F.wave = __builtin_amdgcn_readfirstlane(t_ >> 6);
            int bx = blockIdx.x; asm volatile("" : "+s"(bx)); F.bid = bx; F.vcu = (F.G % 8 == 0) ? (bx % 8) * (F.G / 8) + bx / 8 : bx;
            bar.bar = (unsigned*)(F.ws + WS_CTL) + CW_BAR;
        }
#ifndef PMASK
#define PMASK 0xFFFF
#endif
        if (ph == 0) { if (PMASK & 1) p0_prologue(F); }
        else if (ph == N_PHASES - 1) { if (PMASK & 2) final_phase(F); }
        else {
            const int l = (ph - 1) / PH_PER_LAYER, s = (ph - 1) % PH_PER_LAYER;
            bf16* XB = (bf16*)(F.ws + WS_XB); float* SS1 = (float*)(F.ws + WS_SS1); float* SS2 = (float*)(F.ws + WS_SS2);
            if (s == 0) { if (PMASK & 4) {
                pg8::Gemm g{XB, (const bf16*)(F.ws + WS_WIN) + (size_t)l * DING * DM, M, DING, DM}; pg8::StaticOrder S; S.init(M, DING, F.G, F.bid);
                pg8::EpiScaleAct<0> E{(bf16*)(F.ws + WS_PROJ), DING, SS1, 2};
                pg8::gemm_phase<pg8::EpiScaleAct<0>, pg8::StaticOrder, true, true>(F.lds, g, S, E, F.tid); }
            } else if (s == 1) { if (PMASK & 8) conv_phase(F, l); if (PMASK & 16) mixa_phase(F, l); }
            else if (s == 2) { if (PMASK & 32) ssd_naive_phase(F, l); }
            else if (s == 3) { if (PMASK & 64) gnorm_phase(F, l); }
            else if (s == 4) { if (PMASK & 128) {
                pg8::Gemm g{(const bf16*)(F.ws + WS_YCAT), (const bf16*)(F.ws + WS_WOUT) + (size_t)l * DM * DM, M, DM, DM}; pg8::StaticOrder S; S.init(M, DM, F.G, F.bid);
                pg8::EpiRes E{l == 0 ? F.inp(I_XP) : F.out, l == 0 ? F.inp(I_XS) : F.out + (size_t)MP * DM, F.out, XB, SS2};
                pg8::gemm_phase<pg8::EpiRes, pg8::StaticOrder, true, true>(F.lds, g, S, E, F.tid); }
            } else if (s == 5) { if (PMASK & 256) {
                pg8::Gemm g{XB, (const bf16*)(F.ws + WS_W1) + (size_t)l * FF * DM, M, FF, DM}; pg8::StaticOrder S; S.init(M, FF, F.G, F.bid);
                pg8::EpiScaleAct<1> E{(bf16*)(F.ws + WS_HID), FF, SS2, 0};
                pg8::gemm_phase<pg8::EpiScaleAct<1>, pg8::StaticOrder, true, true>(F.lds, g, S, E, F.tid); }
            } else { if (PMASK & 512) {
                pg8::Gemm g{(const bf16*)(F.ws + WS_HID), (const bf16*)(F.ws + WS_W2) + (size_t)l * DM * FF, M, DM, FF}; pg8::StaticOrder S; S.init(M, DM, F.G, F.bid);
                pg8::EpiRes E{F.out, F.out + (size_t)MP * DM, F.out, XB, SS1};
                pg8::gemm_phase<pg8::EpiRes, pg8::StaticOrder, true, true>(F.lds, g, S, E, F.tid); }
            }
        }
        if (ph + 1 < args.ph_hi) xcd_barrier(bar);
    }
}

extern "C" void kernel_launch(void* const* d_in, const int* in_sizes, int n_in, void* d_out, int out_size, void* d_ws, size_t ws_size, hipStream_t stream) {
    static int grid = 0;
    if (grid == 0) {
        if (n_in != N_IN || (size_t)out_size != O_END || ws_size < WS_END) { fprintf(stderr, "kernel_launch: unexpected sizes n_in %d out %d ws %zu (need %zu)\n", n_in, out_size, ws_size, (size_t)WS_END); grid = -1; return; }
        int dev = 0, cus = 0;
        if (hipGetDevice(&dev) != hipSuccess || hipDeviceGetAttribute(&cus, hipDeviceAttributeMultiprocessorCount, dev) != hipSuccess) { grid = -1; return; }
        if (hipFuncSetAttribute((const void*)mega, hipFuncAttributeMaxDynamicSharedMemorySize, LDS_BYTES) != hipSuccess) { fprintf(stderr, "kernel_launch: hipFuncSetAttribute failed\n"); grid = -1; return; }
        (void)hipGetLastError();
        grid = cus;
    }
    if (grid < 0) return;
    if (hipMemsetAsync((char*)d_ws + WS_CTL, 0, CTL_ZERO_BYTES, stream) != hipSuccess) return;
    Args a{};
    for (int i = 0; i < N_IN; ++i) a.in[i] = (const float*)d_in[i];
    a.out = (float*)d_out; a.ws = (unsigned char*)d_ws;
#if MK_ONE_LAUNCH
    a.ph_lo = 0; a.ph_hi = N_PHASES;
    hipLaunchKernelGGL(mega, dim3(grid), dim3(NWAVES * 64), LDS_BYTES, stream, a);
#else
    for (int ph = 0; ph < N_PHASES; ++ph) { a.ph_lo = ph; a.ph_hi = ph + 1; hipLaunchKernelGGL(mega, dim3(grid), dim3(NWAVES * 64), LDS_BYTES, stream, a); }
#endif
}
```

```cpp
#include <hip/hip_runtime.h>
#include <cstdio>
#include <cstdint>

#ifndef MK_ONE_LAUNCH
#define MK_ONE_LAUNCH 1
#endif


template <int K> __device__ __forceinline__ float xswz(float v) { return __builtin_bit_cast(float, __builtin_amdgcn_ds_swizzle(__builtin_bit_cast(int, v), (K << 10) | 0x1f)); }
__device__ __forceinline__ float sum_halves(float v) {
    const unsigned b = __builtin_bit_cast(unsigned, v); unsigned b2 = b; asm volatile("" : "+v"(b2));
    auto r = __builtin_amdgcn_permlane32_swap(b, b2, false, false); unsigned r0 = r[0], r1 = r[1]; asm volatile("" : "+v"(r0), "+v"(r1));
    return __builtin_bit_cast(float, r0) + __builtin_bit_cast(float, r1);
}
__device__ __forceinline__ float softplus_f(float v) {
    const float e = __expf(-fabsf(v));
    const float lg = e < 0.03125f ? e * (1.0f - e * (0.5f - e * (0.33333334f - 0.25f * e))) : __logf(1.0f + e);
    return fmaxf(v, 0.f) + lg;
}

namespace pg8 {
#define PG8_LAS __attribute__((address_space(3)))
typedef unsigned short bf16_t;
typedef short bf16x8 __attribute__((ext_vector_type(8)));
typedef float f32x4 __attribute__((ext_vector_type(4)));
typedef float f32x2 __attribute__((ext_vector_type(2)));
typedef unsigned u32x4 __attribute__((ext_vector_type(4)));
constexpr int BM = 256, BK = 64, HALF = 128, HTB = HALF * BK * 2, STAGE_BYTES = 8 * HTB, NXCD = 8, WGM = 8;

__host__ __device__ __forceinline__ int lds_byte(int r, int c) { const int st = (r >> 4) * 2 + (c >> 5), rr = r & 15, cc = c & 31, ob = rr * 64 + cc * 2; return st * 1024 + (ob ^ (((ob >> 9) & 1) << 5)); }
__host__ __device__ __forceinline__ void stage_rc(int b, int& R, int& C) { const int st = b / 1024, sb = b % 1024, swz = sb ^ (((sb >> 9) & 1) << 5); R = (st >> 1) * 16 + swz / 64; C = (st & 1) * 32 + (swz % 64) / 2; }
__host__ __device__ __forceinline__ int perm32(int rho) { const int n = rho >> 4, i = rho & 15; return 8 * (i >> 2) + 4 * n + (i & 3); }

struct Unit { int pm, pn; };
struct Gemm { const bf16_t* A; const bf16_t* Bt; int M, N, K; };

struct StaticOrder {
    int nM, nN, nwg, G, c;
    __host__ __device__ void init(int M, int N, int G_, int c_) { nM = M / BM; nN = N / BM; nwg = nM * nN; G = G_; c = c_; }
    __host__ __device__ bool next(int i, Unit& u) const {
        const long L = (long)i * G + c; if (L >= nwg) return false;
        int wgid = (int)L; { const int q = nwg / NXCD, r = nwg % NXCD, xcd = wgid % NXCD, off = wgid / NXCD; wgid = (xcd < r ? xcd * (q + 1) : r * (q + 1) + (xcd - r) * q) + off; }
        const int nig = WGM * nN, gid = wgid / nig, fm = gid * WGM, gsz = (nM - fm) < WGM ? (nM - fm) : WGM;
        u.pm = fm + ((wgid % nig) % gsz); u.pn = (wgid % nig) / gsz; return true;
    }
    __device__ __forceinline__ void a_ready(const Unit&) const {}
    __device__ __forceinline__ void done(const Unit&) const {}
};

__device__ __forceinline__ unsigned cvt_pk_bf16(float lo, float hi) { unsigned r; asm volatile("v_cvt_pk_bf16_f32 %0, %1, %2" : "=v"(r) : "v"(lo), "v"(hi)); return r; }
__device__ __forceinline__ f32x2 gelu_pk(f32x2 v) {
    const f32x2 av = __builtin_elementwise_abs(v), d = av * 0.2316418882f + 1.0f;
    f32x2 t; t.x = __builtin_amdgcn_rcpf(d.x); t.y = __builtin_amdgcn_rcpf(d.y);
    f32x2 q = t * 0.5307027145f + (-0.7265760135f); q = q * t + 0.7107068705f; q = q * t + (-0.142248368f); q = q * t + 0.127414796f; q = q * t;
    const f32x2 s = (v * v) * (-0.72134752044f);
    f32x2 e; e.x = __builtin_amdgcn_exp2f(s.x); e.y = __builtin_amdgcn_exp2f(s.y);
    const f32x2 m = v * (q * e), r = v - m;
    f32x2 o; o.x = v.x < 0.f ? m.x : r.x; o.y = v.y < 0.f ? m.y : r.y; return o;
}

__device__ __forceinline__ const void* uni_ptr(const void* p) {
    const unsigned long long v = (unsigned long long)p; const unsigned lo = __builtin_amdgcn_readfirstlane((unsigned)v), hi = __builtin_amdgcn_readfirstlane((unsigned)(v >> 32));
    return (const void*)(((unsigned long long)hi << 32) | lo);
}
__device__ __forceinline__ void ld1_b128(f32x4& d, const void* sb, unsigned vo) {
    asm volatile("s_nop 4\n\tglobal_load_dwordx4 %0, %1, %2\n\ts_waitcnt vmcnt(0)" : "=&v"(d) : "v"(vo), "s"(uni_ptr(sb)) : "memory"); }
__device__ __forceinline__ void ld1_b64(f32x2& d, const void* sb, unsigned vo) {
    asm volatile("s_nop 4\n\tglobal_load_dwordx2 %0, %1, %2\n\ts_waitcnt vmcnt(0)" : "=&v"(d) : "v"(vo), "s"(uni_ptr(sb)) : "memory"); }
__device__ __forceinline__ void ld2_b128(f32x4& d0, f32x4& d1, const void* sb, unsigned vo) {
    asm volatile("s_nop 4\n\tglobal_load_dwordx4 %0, %2, %3\n\tglobal_load_dwordx4 %1, %2, %3 offset:16\n\ts_waitcnt vmcnt(0)" : "=&v"(d0), "=&v"(d1) : "v"(vo), "s"(uni_ptr(sb)) : "memory"); }
__device__ __forceinline__ void ld4_b128(f32x4 (&d)[4], const void* sb, const unsigned (&vo)[4]) {
    asm volatile("s_nop 4\n\tglobal_load_dwordx4 %0, %4, %8\n\tglobal_load_dwordx4 %1, %5, %8\n\tglobal_load_dwordx4 %2, %6, %8\n\tglobal_load_dwordx4 %3, %7, %8\n\ts_waitcnt vmcnt(0)"
        : "=&v"(d[0]), "=&v"(d[1]), "=&v"(d[2]), "=&v"(d[3]) : "v"(vo[0]), "v"(vo[1]), "v"(vo[2]), "v"(vo[3]), "s"(uni_ptr(sb)) : "memory"); }
__device__ __forceinline__ void ld8_b128(f32x4 (&d)[8], const void* sb, const unsigned (&vo)[8]) {
    asm volatile("s_nop 4\n\tglobal_load_dwordx4 %0, %8, %16\n\tglobal_load_dwordx4 %1, %9, %16\n\tglobal_load_dwordx4 %2, %10, %16\n\tglobal_load_dwordx4 %3, %11, %16\n\t"
                 "global_load_dwordx4 %4, %12, %16\n\tglobal_load_dwordx4 %5, %13, %16\n\tglobal_load_dwordx4 %6, %14, %16\n\tglobal_load_dwordx4 %7, %15, %16\n\ts_waitcnt vmcnt(0)"
        : "=&v"(d[0]), "=&v"(d[1]), "=&v"(d[2]), "=&v"(d[3]), "=&v"(d[4]), "=&v"(d[5]), "=&v"(d[6]), "=&v"(d[7])
        : "v"(vo[0]), "v"(vo[1]), "v"(vo[2]), "v"(vo[3]), "v"(vo[4]), "v"(vo[5]), "v"(vo[6]), "v"(vo[7]), "s"(uni_ptr(sb)) : "memory"); }
__device__ __forceinline__ void ld8_b64(f32x2 (&d)[8], const void* sb, const unsigned (&vo)[8]) {
    asm volatile("s_nop 4\n\tglobal_load_dwordx2 %0, %8, %16\n\tglobal_load_dwordx2 %1, %9, %16\n\tglobal_load_dwordx2 %2, %10, %16\n\tglobal_load_dwordx2 %3, %11, %16\n\t"
                 "global_load_dwordx2 %4, %12, %16\n\tglobal_load_dwordx2 %5, %13, %16\n\tglobal_load_dwordx2 %6, %14, %16\n\tglobal_load_dwordx2 %7, %15, %16\n\ts_waitcnt vmcnt(0)"
        : "=&v"(d[0]), "=&v"(d[1]), "=&v"(d[2]), "=&v"(d[3]), "=&v"(d[4]), "=&v"(d[5]), "=&v"(d[6]), "=&v"(d[7])
        : "v"(vo[0]), "v"(vo[1]), "v"(vo[2]), "v"(vo[3]), "v"(vo[4]), "v"(vo[5]), "v"(vo[6]), "v"(vo[7]), "s"(uni_ptr(sb)) : "memory"); }
__device__ __forceinline__ void ld16_res(f32x4 (&d)[16], const void* sb, const unsigned (&vo)[4]) {
    asm volatile("s_nop 4\n\t"
        "global_load_dwordx4 %0, %16, %20\n\tglobal_load_dwordx4 %1, %16, %20 offset:16\n\tglobal_load_dwordx4 %2, %16, %20 offset:512\n\tglobal_load_dwordx4 %3, %16, %20 offset:528\n\t"
        "global_load_dwordx4 %4, %17, %20\n\tglobal_load_dwordx4 %5, %17, %20 offset:16\n\tglobal_load_dwordx4 %6, %17, %20 offset:512\n\tglobal_load_dwordx4 %7, %17, %20 offset:528\n\t"
        "global_load_dwordx4 %8, %18, %20\n\tglobal_load_dwordx4 %9, %18, %20 offset:16\n\tglobal_load_dwordx4 %10, %18, %20 offset:512\n\tglobal_load_dwordx4 %11, %18, %20 offset:528\n\t"
        "global_load_dwordx4 %12, %19, %20\n\tglobal_load_dwordx4 %13, %19, %20 offset:16\n\tglobal_load_dwordx4 %14, %19, %20 offset:512\n\tglobal_load_dwordx4 %15, %19, %20 offset:528\n\t"
        "s_waitcnt vmcnt(0)"
        : "=&v"(d[0]), "=&v"(d[1]), "=&v"(d[2]), "=&v"(d[3]), "=&v"(d[4]), "=&v"(d[5]), "=&v"(d[6]), "=&v"(d[7]), "=&v"(d[8]), "=&v"(d[9]), "=&v"(d[10]), "=&v"(d[11]), "=&v"(d[12]), "=&v"(d[13]), "=&v"(d[14]), "=&v"(d[15])
        : "v"(vo[0]), "v"(vo[1]), "v"(vo[2]), "v"(vo[3]), "s"(uni_ptr(sb)) : "memory"); }
__device__ __forceinline__ void ld16_resb(u32x4 (&d)[16], const void* sb, const unsigned (&vo)[8]) {
    asm volatile("s_nop 4\n\t"
        "global_load_dwordx4 %0, %16, %24\n\tglobal_load_dwordx4 %1, %16, %24 offset:256\n\tglobal_load_dwordx4 %2, %17, %24\n\tglobal_load_dwordx4 %3, %17, %24 offset:256\n\t"
        "global_load_dwordx4 %4, %18, %24\n\tglobal_load_dwordx4 %5, %18, %24 offset:256\n\tglobal_load_dwordx4 %6, %19, %24\n\tglobal_load_dwordx4 %7, %19, %24 offset:256\n\t"
        "global_load_dwordx4 %8, %20, %24\n\tglobal_load_dwordx4 %9, %20, %24 offset:256\n\tglobal_load_dwordx4 %10, %21, %24\n\tglobal_load_dwordx4 %11, %21, %24 offset:256\n\t"
        "global_load_dwordx4 %12, %22, %24\n\tglobal_load_dwordx4 %13, %22, %24 offset:256\n\tglobal_load_dwordx4 %14, %23, %24\n\tglobal_load_dwordx4 %15, %23, %24 offset:256\n\t"
        "s_waitcnt vmcnt(0)"
        : "=&v"(d[0]), "=&v"(d[1]), "=&v"(d[2]), "=&v"(d[3]), "=&v"(d[4]), "=&v"(d[5]), "=&v"(d[6]), "=&v"(d[7]), "=&v"(d[8]), "=&v"(d[9]), "=&v"(d[10]), "=&v"(d[11]), "=&v"(d[12]), "=&v"(d[13]), "=&v"(d[14]), "=&v"(d[15])
        : "v"(vo[0]), "v"(vo[1]), "v"(vo[2]), "v"(vo[3]), "v"(vo[4]), "v"(vo[5]), "v"(vo[6]), "v"(vo[7]), "s"(uni_ptr(sb)) : "memory"); }
__device__ __forceinline__ void ld1_u128(u32x4& d, const void* sb, unsigned vo) {
    asm volatile("s_nop 4\n\tglobal_load_dwordx4 %0, %1, %2\n\ts_waitcnt vmcnt(0)" : "=&v"(d) : "v"(vo), "s"(uni_ptr(sb)) : "memory"); }
__device__ __forceinline__ void unpk8(const u32x4 w, f32x4& lo, f32x4& hi) {
    lo = (f32x4){__builtin_bit_cast(float, w.x << 16), __builtin_bit_cast(float, w.x & 0xffff0000u), __builtin_bit_cast(float, w.y << 16), __builtin_bit_cast(float, w.y & 0xffff0000u)};
    hi = (f32x4){__builtin_bit_cast(float, w.z << 16), __builtin_bit_cast(float, w.z & 0xffff0000u), __builtin_bit_cast(float, w.w << 16), __builtin_bit_cast(float, w.w & 0xffff0000u)}; }
__device__ __forceinline__ float rstd_from_slots(const f32x4 v) {
    float s = (v[0] + v[1]) + (v[2] + v[3]);
    s += xswz<16>(s); s = sum_halves(s);
    return __builtin_amdgcn_rsqf(s * (1.0f / 1024.0f) + 1e-5f);
}

__device__ __forceinline__ float rstd_from_slots32(const f32x4 a, const f32x4 b) {
    float s = ((a[0] + a[1]) + (a[2] + a[3])) + ((b[0] + b[1]) + (b[2] + b[3]));
    s += xswz<16>(s); s = sum_halves(s);
    return __builtin_amdgcn_rsqf(s * (1.0f / 1024.0f) + 1e-5f);
}

template <int ACT> struct EpiScaleAct {
    static constexpr bool PERM = true, AFTER_DRAIN = false, RESCALE = false;
    bf16_t* O; int ldc; const float* ss; int gelu_tiles;
    __device__ __forceinline__ void operator()(const f32x4 (&acc)[2][2][4][2], const Unit& u, int wr, int wc, int fr, int fq) const {
        bf16_t* Ot = O + ((size_t)u.pm * BM * ldc + (size_t)u.pn * BM); const float* sst = ss + (size_t)u.pm * BM * 16;
        unsigned rl0 = (unsigned)(wr * 64 + fr), cl0 = (unsigned)(wc * 32 + 8 * fq); const unsigned uld = (unsigned)ldc;
        asm volatile("" : "+v"(rl0), "+v"(cl0));
        const bool gl = (ACT == 0) && (u.pn < gelu_tiles);
        unsigned vo[8]; f32x4 sv[8]; float rsv[8];
#pragma unroll
        for (int i = 0; i < 8; ++i) vo[i] = ((rl0 + (unsigned)((i >> 2) * HALF + (i & 3) * 16)) * 16u + 4u * (unsigned)fq) * 4u;
        ld8_b128(sv, sst, vo);
#pragma unroll
        for (int i = 0; i < 8; ++i) rsv[i] = rstd_from_slots(sv[i]);
#pragma unroll
        for (int ai = 0; ai < 2; ++ai)
#pragma unroll
            for (int m = 0; m < 4; ++m) { const float rs = rsv[ai * 4 + m]; const unsigned off = (rl0 + (unsigned)(ai * HALF + m * 16)) * uld + cl0;
#pragma unroll
                for (int bj = 0; bj < 2; ++bj) { f32x4 v0 = acc[ai][bj][m][0] * rs, v1 = acc[ai][bj][m][1] * rs;
                    if (ACT == 0) { if (gl) { f32x2 a = gelu_pk((f32x2){v0[0], v0[1]}), b = gelu_pk((f32x2){v0[2], v0[3]}), c = gelu_pk((f32x2){v1[0], v1[1]}), d = gelu_pk((f32x2){v1[2], v1[3]});
                        v0 = (f32x4){a.x, a.y, b.x, b.y}; v1 = (f32x4){c.x, c.y, d.x, d.y}; } }
                    else { v0 = __builtin_elementwise_max(v0, (f32x4){0.f, 0.f, 0.f, 0.f}); v1 = __builtin_elementwise_max(v1, (f32x4){0.f, 0.f, 0.f, 0.f}); v0 = v0 * v0; v1 = v1 * v1; }
                    u32x4 w; w.x = cvt_pk_bf16(v0[0], v0[1]); w.y = cvt_pk_bf16(v0[2], v0[3]); w.z = cvt_pk_bf16(v1[0], v1[1]); w.w = cvt_pk_bf16(v1[2], v1[3]);
                    *(u32x4*)(Ot + (off + (unsigned)(bj * HALF))) = w; } }
    }
};
template <bool RS> struct EpiRes {
    static constexpr bool PERM = true, AFTER_DRAIN = false, RESCALE = RS;
    const float* baseP; const float* baseS; float* X; bf16_t* XB; float* ssout; const float* ssg;
    __device__ __forceinline__ void rescale(f32x4 (&acc)[2][2][4][2], const Unit& u, int wr, int fr) const {
        const float* sgt = ssg + (size_t)u.pm * BM * 2; unsigned rl0 = (unsigned)(wr * 64 + fr); asm volatile("" : "+v"(rl0));
        unsigned vo[8]; f32x2 gv[8];
#pragma unroll
        for (int i = 0; i < 8; ++i) vo[i] = (rl0 + (unsigned)((i >> 2) * HALF + (i & 3) * 16)) * 8u;
        ld8_b64(gv, sgt, vo);
#pragma unroll
        for (int ai = 0; ai < 2; ++ai)
#pragma unroll
            for (int m = 0; m < 4; ++m) { const f32x2 v = gv[ai * 4 + m];
                const float rs = __builtin_amdgcn_rsqf((v.x + v.y) * (1.0f / 512.0f) + 1e-5f);
#pragma unroll
                for (int bj = 0; bj < 2; ++bj)
#pragma unroll
                    for (int n = 0; n < 2; ++n) acc[ai][bj][m][n] = acc[ai][bj][m][n] * rs; }
    }
    __device__ __forceinline__ void operator()(const f32x4 (&acc)[2][2][4][2], const Unit& u, int wr, int wc, int fr, int fq) const {
        const size_t tb = (size_t)u.pm * BM * 1024 + (size_t)u.pn * BM;
        const float* bt = baseP + tb;
        float* Xt = X + tb; bf16_t* XBt = XB + tb; float* sot = ssout + ((size_t)u.pm * BM * 16 + (size_t)(u.pn * 4 + wc));
        unsigned rl0 = (unsigned)(wr * 64 + fr), cl0 = (unsigned)(wc * 32 + 8 * fq);
        asm volatile("" : "+v"(rl0), "+v"(cl0));
#pragma unroll
        for (int ai = 0; ai < 2; ++ai) {
            unsigned vo[4]; f32x4 bv[16];
#pragma unroll
            for (int m = 0; m < 4; ++m) vo[m] = ((rl0 + (unsigned)(ai * HALF + m * 16)) * 1024u + cl0) * 4u;
            ld16_res(bv, bt, vo);
#pragma unroll
            for (int m = 0; m < 4; ++m) { const unsigned rl = rl0 + (unsigned)(ai * HALF + m * 16), off = rl * 1024u + cl0; float sq = 0.f;
#pragma unroll
                for (int bj = 0; bj < 2; ++bj) { const unsigned o2 = off + (unsigned)(bj * HALF);
                    const f32x4 x0 = bv[4 * m + 2 * bj] + acc[ai][bj][m][0], x1 = bv[4 * m + 2 * bj + 1] + acc[ai][bj][m][1];
                    *(f32x4*)(Xt + o2) = x0; *(f32x4*)(Xt + (o2 + 4u)) = x1;
                    u32x4 w; w.x = cvt_pk_bf16(x0[0], x0[1]); w.y = cvt_pk_bf16(x0[2], x0[3]); w.z = cvt_pk_bf16(x1[0], x1[1]); w.w = cvt_pk_bf16(x1[2], x1[3]);
                    *(u32x4*)(XBt + o2) = w;
                    sq += (x0[0] * x0[0] + x0[1] * x0[1]) + (x0[2] * x0[2] + x0[3] * x0[3]) + (x1[0] * x1[0] + x1[1] * x1[1]) + (x1[2] * x1[2] + x1[3] * x1[3]); }
                sq += xswz<16>(sq); sq = sum_halves(sq);
                if (fq == 0) sot[rl * 16u] = sq; }
        }
    }
};

template <class Epi, class Sched, bool ALIGN_EPI = false, bool SP2 = false>
__device__ __forceinline__ void gemm_phase(PG8_LAS unsigned char* lds, const Gemm g, const Sched& S, const Epi& E, const int tid) {
    const int wid = __builtin_amdgcn_readfirstlane(tid >> 6), lane = tid & 63, wr = wid >> 2, wc = wid & 3, fr = lane & 15, fq = lane >> 4;
    const int K = g.K, nt = K / BK;
    unsigned voffA[2], voffB[2];
#pragma unroll
    for (int i = 0; i < 2; ++i) { int R, C; stage_rc(tid * 16 + i * 8192, R, C); const int Rb = Epi::PERM ? ((R & ~31) + perm32(R & 31)) : R;
        voffA[i] = (unsigned)(R * K + C) * 2u; voffB[i] = (unsigned)(Rb * K + C) * 2u; }
    const size_t kstep = (size_t)(BK * 2);
    const size_t hstep = (size_t)HALF * K * 2;
    const size_t tstep = 2 * hstep;
    const unsigned ldsw = (unsigned)wid * 1024u;
    const int aoff = lds_byte(wr * 64 + fr, fq * 8), boff = lds_byte(wc * 32 + fr, fq * 8);
#define PG8_SA(b, h) (((b) * 2 + (h)) * HTB)
#define PG8_SB(b, h) ((4 + (b) * 2 + (h)) * HTB)
#define PG8_STAGE(bufoff, gbase, voff) do { _Pragma("unroll") for (int _i = 0; _i < 2; ++_i) \
        __builtin_amdgcn_global_load_lds((const unsigned*)((const char*)(gbase) + (voff)[_i]), (PG8_LAS unsigned*)(lds + (bufoff) + ldsw + _i * 8192), 16, 0, 0); } while (0)
#define PG8_LDA(dst, b, h) do { _Pragma("unroll") for (int m = 0; m < 4; ++m) _Pragma("unroll") for (int k = 0; k < 2; ++k) dst[m][k] = *(const PG8_LAS bf16x8*)(lds + PG8_SA(b, h) + aoff + m * 2048 + k * 1024); } while (0)
#define PG8_LDB(dst, b, h) do { _Pragma("unroll") for (int n = 0; n < 2; ++n) _Pragma("unroll") for (int k = 0; k < 2; ++k) dst[n][k] = *(const PG8_LAS bf16x8*)(lds + PG8_SB(b, h) + boff + n * 2048 + k * 1024); } while (0)
#define PG8_MMA(ai, bj, At, Bt) do { __builtin_amdgcn_s_setprio(1); _Pragma("unroll") for (int m = 0; m < 4; ++m) _Pragma("unroll") for (int n = 0; n < 2; ++n) _Pragma("unroll") for (int k = 0; k < 2; ++k) \
        acc[ai][bj][m][n] = __builtin_amdgcn_mfma_f32_16x16x32_bf16(Bt[n][k], At[m][k], acc[ai][bj][m][n], 0, 0, 0); __builtin_amdgcn_s_setprio(0); } while (0)
#define PG8_WAIT_V(n) asm volatile("s_waitcnt vmcnt(" #n ")" ::: "memory")
#define PG8_WAIT_L(n) asm volatile("s_waitcnt lgkmcnt(" #n ")" ::: "memory")
#define PG8_BAR __builtin_amdgcn_s_barrier()
#define PG8_SCHED __builtin_amdgcn_sched_barrier(0)
    Unit cur, nxt; int ui = 0;
    if (!S.next(0, cur)) return;
    f32x4 acc[2][2][4][2];
#pragma unroll
    for (int a = 0; a < 2; ++a)
#pragma unroll
        for (int b = 0; b < 2; ++b)
#pragma unroll
            for (int m = 0; m < 4; ++m)
#pragma unroll
                for (int n = 0; n < 2; ++n) acc[a][b][m][n] = (f32x4){0.f, 0.f, 0.f, 0.f};
    bf16x8 At[4][2], B0[2][2], B1[2][2];
    const char* cA = (const char*)g.A + (size_t)cur.pm * tstep; const char* cB = (const char*)g.Bt + (size_t)cur.pn * tstep;
    S.a_ready(cur);
    if constexpr (SP2) {
        PG8_STAGE(PG8_SB(0, 0), cB, voffB); PG8_STAGE(PG8_SB(0, 1), cB + hstep, voffB); PG8_STAGE(PG8_SA(0, 0), cA, voffA); PG8_STAGE(PG8_SA(0, 1), cA + hstep, voffA);
        if (wr == 1) PG8_BAR;
        PG8_WAIT_V(2); PG8_BAR;
        PG8_STAGE(PG8_SB(1, 0), cB + kstep, voffB); PG8_STAGE(PG8_SA(1, 0), cA + kstep, voffA); PG8_STAGE(PG8_SB(1, 1), cB + hstep + kstep, voffB);
        PG8_WAIT_V(6); PG8_BAR;
    } else {
        PG8_STAGE(PG8_SB(0, 0), cB, voffB); PG8_STAGE(PG8_SA(0, 0), cA, voffA); PG8_STAGE(PG8_SB(0, 1), cB + hstep, voffB); PG8_STAGE(PG8_SA(0, 1), cA + hstep, voffA);
        if (wr == 1) PG8_BAR;
        PG8_WAIT_V(4); PG8_BAR;
        PG8_STAGE(PG8_SB(1, 0), cB + kstep, voffB); PG8_STAGE(PG8_SA(1, 0), cA + kstep, voffA); PG8_STAGE(PG8_SB(1, 1), cB + hstep + kstep, voffB);
        PG8_WAIT_V(6); PG8_BAR;
    }
    for (;;) {
        const bool has_next = S.next(ui + 1, nxt);
        const char* nA = has_next ? (const char*)g.A + (size_t)nxt.pm * tstep : cA; const char* nB = has_next ? (const char*)g.Bt + (size_t)nxt.pn * tstep : cB;
        for (int t = 0; t < nt; t += 2) {
            const bool last = (t == nt - 2);
            const char* a1 = cA + (size_t)(t + 1) * kstep;
            const char* a2 = last ? nA : cA + (size_t)(t + 2) * kstep; const char* b2 = last ? nB : cB + (size_t)(t + 2) * kstep;
            const char* a3 = a2 + kstep; const char* b3 = b2 + kstep;
            if (last && has_next) S.a_ready(nxt);
            if constexpr (Epi::RESCALE) { if (t == 8) E.rescale(acc, cur, wr, fr); }
            if constexpr (SP2) {
            PG8_LDB(B0, 0, 0); PG8_LDB(B1, 0, 1); PG8_SCHED; PG8_LDA(At, 0, 0); PG8_STAGE(PG8_SA(1, 1), a1 + hstep, voffA);
            PG8_WAIT_V(8); PG8_WAIT_L(0); PG8_BAR; PG8_MMA(0, 0, At, B0); PG8_MMA(0, 1, At, B1); PG8_BAR; PG8_SCHED;
            PG8_LDA(At, 0, 1); PG8_STAGE(PG8_SB(0, 0), b2, voffB); PG8_STAGE(PG8_SB(0, 1), b2 + hstep, voffB); PG8_STAGE(PG8_SA(0, 0), a2, voffA);
            PG8_WAIT_V(8); PG8_WAIT_L(0); PG8_BAR; PG8_MMA(1, 0, At, B0); PG8_MMA(1, 1, At, B1); PG8_BAR; PG8_SCHED;
            PG8_LDB(B0, 1, 0); PG8_LDB(B1, 1, 1); PG8_SCHED; PG8_LDA(At, 1, 0); PG8_STAGE(PG8_SA(0, 1), a2 + hstep, voffA);
            PG8_WAIT_V(8); PG8_WAIT_L(0); PG8_BAR; PG8_MMA(0, 0, At, B0); PG8_MMA(0, 1, At, B1); PG8_BAR; PG8_SCHED;
            PG8_LDA(At, 1, 1); PG8_STAGE(PG8_SB(1, 0), b3, voffB); PG8_STAGE(PG8_SB(1, 1), b3 + hstep, voffB); PG8_STAGE(PG8_SA(1, 0), a3, voffA);
            PG8_WAIT_V(8); PG8_WAIT_L(0); PG8_BAR; PG8_MMA(1, 0, At, B0); PG8_MMA(1, 1, At, B1); PG8_BAR; PG8_SCHED;
            } else {
            PG8_LDB(B0, 0, 0); PG8_SCHED; PG8_LDA(At, 0, 0); PG8_STAGE(PG8_SA(1, 1), a1 + hstep, voffA);
            PG8_WAIT_L(8); PG8_BAR; PG8_WAIT_L(0); PG8_MMA(0, 0, At, B0); PG8_BAR; PG8_SCHED;
            PG8_LDB(B1, 0, 1); PG8_STAGE(PG8_SB(0, 0), b2, voffB);
            PG8_BAR; PG8_WAIT_L(0); PG8_MMA(0, 1, At, B1); PG8_BAR;
            PG8_LDA(At, 0, 1); PG8_STAGE(PG8_SA(0, 0), a2, voffA);
            PG8_BAR; PG8_WAIT_L(0); PG8_MMA(1, 0, At, B0); PG8_BAR; PG8_SCHED;
            PG8_STAGE(PG8_SB(0, 1), b2 + hstep, voffB);
            PG8_WAIT_V(6); PG8_BAR; PG8_MMA(1, 1, At, B1); PG8_BAR;
            PG8_LDB(B0, 1, 0); PG8_SCHED; PG8_LDA(At, 1, 0); PG8_STAGE(PG8_SA(0, 1), a2 + hstep, voffA);
            PG8_WAIT_L(8); PG8_BAR; PG8_WAIT_L(0); PG8_MMA(0, 0, At, B0); PG8_BAR; PG8_SCHED;
            PG8_LDB(B1, 1, 1); PG8_STAGE(PG8_SB(1, 0), b3, voffB);
            PG8_BAR; PG8_WAIT_L(0); PG8_MMA(0, 1, At, B1); PG8_BAR;
            PG8_LDA(At, 1, 1); PG8_STAGE(PG8_SA(1, 0), a3, voffA);
            PG8_BAR; PG8_WAIT_L(0); PG8_MMA(1, 0, At, B0); PG8_BAR; PG8_SCHED;
            PG8_STAGE(PG8_SB(1, 1), b3 + hstep, voffB);
            PG8_WAIT_V(6); PG8_BAR; PG8_MMA(1, 1, At, B1); PG8_BAR;
            }
        }
        if constexpr (ALIGN_EPI) { if (wr == 0) PG8_BAR; }
        if constexpr (!Epi::AFTER_DRAIN) { E(acc, cur, wr, wc, fr, fq); S.done(cur); }
        if (!has_next) break;
#pragma unroll
        for (int a = 0; a < 2; ++a)
#pragma unroll
            for (int b = 0; b < 2; ++b)
#pragma unroll
                for (int m = 0; m < 4; ++m)
#pragma unroll
                    for (int n = 0; n < 2; ++n) acc[a][b][m][n] = (f32x4){0.f, 0.f, 0.f, 0.f};
        cur = nxt; cA = nA; cB = nB; ++ui;
        if constexpr (ALIGN_EPI) { if (wr == 1) PG8_BAR; }
    }
    PG8_WAIT_V(0);
    if constexpr (!ALIGN_EPI) { if (wr == 0) PG8_BAR; }
    PG8_BAR;
#undef PG8_SA
#undef PG8_SB
#undef PG8_STAGE
#undef PG8_LDA
#undef PG8_LDB
#undef PG8_MMA
#undef PG8_WAIT_V
#undef PG8_WAIT_L
#undef PG8_BAR
#undef PG8_SCHED
}

constexpr int EXOFF = 131072;
struct GemmX { const bf16_t* A; const bf16_t* AX; const bf16_t* Bt; int K; };
template <class Epi, class Sched>
__device__ __forceinline__ void gemm_phase_x(PG8_LAS unsigned char* lds, const GemmX g, const Sched& S, const Epi& E, const int tid) {
    const int wid = __builtin_amdgcn_readfirstlane(tid >> 6), lane = tid & 63, wr = wid >> 2, wc = wid & 3, fr = lane & 15, fq = lane >> 4;
    const int K = g.K, nt = K / BK;
    unsigned voffA[2], voffB[2];
#pragma unroll
    for (int i = 0; i < 2; ++i) { int R, C; stage_rc(tid * 16 + i * 8192, R, C); const int Rb = (R & ~31) + perm32(R & 31);
        voffA[i] = (unsigned)(R * K + C) * 2u; voffB[i] = (unsigned)(Rb * K + C) * 2u; }
    const unsigned voffX = (unsigned)((tid >> 5) * K + ((((tid & 31) >> 2) ^ ((tid >> 6) & 3)) * 4 + (tid & 3)) * 2) * 2u;
    const size_t kstep = (size_t)(BK * 2);
    const size_t hstep = (size_t)HALF * K * 2;
    const size_t tstep = 2 * hstep;
    const size_t xstep = (size_t)16 * K * 2;
    const unsigned ldsw = (unsigned)wid * 1024u;
    const int aoff = lds_byte(wr * 64 + fr, fq * 8), boff = lds_byte(wc * 32 + fr, fq * 8);
    const int xoff = EXOFF + fr * 128 + (fq ^ ((fr >> 1) & 3)) * 16;
#define PG8_SA(b, h) (((b) * 2 + (h)) * HTB)
#define PG8_SB(b, h) ((4 + (b) * 2 + (h)) * HTB)
#define PG8_STAGE(bufoff, gbase, voff) do { _Pragma("unroll") for (int _i = 0; _i < 2; ++_i) \
        __builtin_amdgcn_global_load_lds((const unsigned*)((const char*)(gbase) + (voff)[_i]), (PG8_LAS unsigned*)(lds + (bufoff) + ldsw + _i * 8192), 16, 0, 0); } while (0)
#define PG8_STAGEX(b, gbase) __builtin_amdgcn_global_load_lds((const unsigned*)((const char*)(gbase) + voffX), (PG8_LAS unsigned*)(lds + EXOFF + (b) * 2048 + wid * 256), 4, 0, 0)
#define PG8_LDA(dst, b, h) do { _Pragma("unroll") for (int m = 0; m < 4; ++m) _Pragma("unroll") for (int k = 0; k < 2; ++k) dst[m][k] = *(const PG8_LAS bf16x8*)(lds + PG8_SA(b, h) + aoff + m * 2048 + k * 1024); } while (0)
#define PG8_LDB(dst, b, h) do { _Pragma("unroll") for (int n = 0; n < 2; ++n) _Pragma("unroll") for (int k = 0; k < 2; ++k) dst[n][k] = *(const PG8_LAS bf16x8*)(lds + PG8_SB(b, h) + boff + n * 2048 + k * 1024); } while (0)
#define PG8_LDX(dst, b) do { _Pragma("unroll") for (int k = 0; k < 2; ++k) dst[k] = *(const PG8_LAS bf16x8*)(lds + (b) * 2048 + xoff + k * 64); } while (0)
#define PG8_MMA(ai, bj, At, Bt) do { __builtin_amdgcn_s_setprio(1); _Pragma("unroll") for (int m = 0; m < 4; ++m) _Pragma("unroll") for (int n = 0; n < 2; ++n) _Pragma("unroll") for (int k = 0; k < 2; ++k) \
        acc[ai][bj][m][n] = __builtin_amdgcn_mfma_f32_16x16x32_bf16(Bt[n][k], At[m][k], acc[ai][bj][m][n], 0, 0, 0); __builtin_amdgcn_s_setprio(0); } while (0)
#define PG8_MMAX(Bt) do { _Pragma("unroll") for (int n = 0; n < 2; ++n) _Pragma("unroll") for (int k = 0; k < 2; ++k) accx[n] = __builtin_amdgcn_mfma_f32_16x16x32_bf16(Bt[n][k], Ax[k], accx[n], 0, 0, 0); } while (0)
#define PG8_WAIT_V(n) asm volatile("s_waitcnt vmcnt(" #n ")" ::: "memory")
#define PG8_WAIT_L(n) asm volatile("s_waitcnt lgkmcnt(" #n ")" ::: "memory")
#define PG8_BAR __builtin_amdgcn_s_barrier()
#define PG8_SCHED __builtin_amdgcn_sched_barrier(0)
    Unit cur, nxt; int ui = 0;
    if (!S.next(0, cur)) return;
    f32x4 acc[2][2][4][2], accx[2];
#pragma unroll
    for (int a = 0; a < 2; ++a)
#pragma unroll
        for (int b = 0; b < 2; ++b)
#pragma unroll
            for (int m = 0; m < 4; ++m)
#pragma unroll
                for (int n = 0; n < 2; ++n) acc[a][b][m][n] = (f32x4){0.f, 0.f, 0.f, 0.f};
    accx[0] = (f32x4){0.f, 0.f, 0.f, 0.f}; accx[1] = (f32x4){0.f, 0.f, 0.f, 0.f};
    bf16x8 At[4][2], B0[2][2], B1[2][2], Ax[2];
    const char* cA = (const char*)g.A + (size_t)cur.pm * tstep; const char* cB = (const char*)g.Bt + (size_t)cur.pn * tstep; const char* cX = (const char*)g.AX + (size_t)cur.pm * xstep;
    PG8_STAGE(PG8_SB(0, 0), cB, voffB); PG8_STAGE(PG8_SB(0, 1), cB + hstep, voffB); PG8_STAGE(PG8_SA(0, 0), cA, voffA); PG8_STAGEX(0, cX); PG8_STAGE(PG8_SA(0, 1), cA + hstep, voffA);
    if (wr == 1) PG8_BAR;
    PG8_WAIT_V(2); PG8_BAR;
    PG8_STAGE(PG8_SB(1, 0), cB + kstep, voffB); PG8_STAGE(PG8_SA(1, 0), cA + kstep, voffA); PG8_STAGEX(1, cX + kstep); PG8_STAGE(PG8_SB(1, 1), cB + hstep + kstep, voffB);
    PG8_WAIT_V(7); PG8_BAR;
    for (;;) {
        const bool has_next = S.next(ui + 1, nxt);
        const char* nA = has_next ? (const char*)g.A + (size_t)nxt.pm * tstep : cA; const char* nB = has_next ? (const char*)g.Bt + (size_t)nxt.pn * tstep : cB;
        const char* nX = has_next ? (const char*)g.AX + (size_t)nxt.pm * xstep : cX;
        for (int t = 0; t < nt; t += 2) {
            const bool last = (t == nt - 2);
            const char* a1 = cA + (size_t)(t + 1) * kstep;
            const char* a2 = last ? nA : cA + (size_t)(t + 2) * kstep; const char* b2 = last ? nB : cB + (size_t)(t + 2) * kstep; const char* x2 = last ? nX : cX + (size_t)(t + 2) * kstep;
            const char* a3 = a2 + kstep; const char* b3 = b2 + kstep; const char* x3 = x2 + kstep;
            if constexpr (Epi::RESCALE) { if (t == 8) E.rescale(acc, accx, cur, wr, fr); }
            PG8_LDB(B0, 0, 0); PG8_LDB(B1, 0, 1); PG8_SCHED; PG8_LDA(At, 0, 0); PG8_LDX(Ax, 0); PG8_STAGE(PG8_SA(1, 1), a1 + hstep, voffA);
            PG8_WAIT_V(9); PG8_WAIT_L(0); PG8_BAR; PG8_MMA(0, 0, At, B0); PG8_MMA(0, 1, At, B1); if (wr == 0) PG8_MMAX(B0); else PG8_MMAX(B1); PG8_BAR; PG8_SCHED;
            PG8_LDA(At, 0, 1); PG8_STAGE(PG8_SB(0, 0), b2, voffB); PG8_STAGE(PG8_SB(0, 1), b2 + hstep, voffB); PG8_STAGE(PG8_SA(0, 0), a2, voffA); PG8_STAGEX(0, x2);
            PG8_WAIT_V(9); PG8_WAIT_L(0); PG8_BAR; PG8_MMA(1, 0, At, B0); PG8_MMA(1, 1, At, B1); PG8_BAR; PG8_SCHED;
            PG8_LDB(B0, 1, 0); PG8_LDB(B1, 1, 1); PG8_SCHED; PG8_LDA(At, 1, 0); PG8_LDX(Ax, 1); PG8_STAGE(PG8_SA(0, 1), a2 + hstep, voffA);
            PG8_WAIT_V(9); PG8_WAIT_L(0); PG8_BAR; PG8_MMA(0, 0, At, B0); PG8_MMA(0, 1, At, B1); if (wr == 0) PG8_MMAX(B0); else PG8_MMAX(B1); PG8_BAR; PG8_SCHED;
            PG8_LDA(At, 1, 1); PG8_STAGE(PG8_SB(1, 0), b3, voffB); PG8_STAGE(PG8_SB(1, 1), b3 + hstep, voffB); PG8_STAGE(PG8_SA(1, 0), a3, voffA); PG8_STAGEX(1, x3);
            PG8_WAIT_V(9); PG8_WAIT_L(0); PG8_BAR; PG8_MMA(1, 0, At, B0); PG8_MMA(1, 1, At, B1); PG8_BAR; PG8_SCHED;
        }
        if (wr == 0) PG8_BAR;
        E(acc, accx, cur, wr, wc, fr, fq);
        if (!has_next) break;
#pragma unroll
        for (int a = 0; a < 2; ++a)
#pragma unroll
            for (int b = 0; b < 2; ++b)
#pragma unroll
                for (int m = 0; m < 4; ++m)
#pragma unroll
                    for (int n = 0; n < 2; ++n) acc[a][b][m][n] = (f32x4){0.f, 0.f, 0.f, 0.f};
        accx[0] = (f32x4){0.f, 0.f, 0.f, 0.f}; accx[1] = (f32x4){0.f, 0.f, 0.f, 0.f};
        cur = nxt; cA = nA; cB = nB; cX = nX; ++ui;
        if (wr == 1) PG8_BAR;
    }
    PG8_WAIT_V(0);
    PG8_BAR;
#undef PG8_SA
#undef PG8_SB
#undef PG8_STAGE
#undef PG8_STAGEX
#undef PG8_LDA
#undef PG8_LDB
#undef PG8_LDX
#undef PG8_MMA
#undef PG8_MMAX
#undef PG8_WAIT_V
#undef PG8_WAIT_L
#undef PG8_BAR
#undef PG8_SCHED
}
template <int ACT> struct EpiScaleActX {
    static constexpr bool RESCALE = false;
    bf16_t* O; bf16_t* OS; int ldc; const float* ss; const float* ssx; int gelu_tiles;
    __device__ __forceinline__ void act8(f32x4& v0, f32x4& v1, bool gl) const {
        if (ACT == 0) { if (gl) { f32x2 a = gelu_pk((f32x2){v0[0], v0[1]}), b = gelu_pk((f32x2){v0[2], v0[3]}), c = gelu_pk((f32x2){v1[0], v1[1]}), d = gelu_pk((f32x2){v1[2], v1[3]});
            v0 = (f32x4){a.x, a.y, b.x, b.y}; v1 = (f32x4){c.x, c.y, d.x, d.y}; } }
        else { v0 = __builtin_elementwise_max(v0, (f32x4){0.f, 0.f, 0.f, 0.f}); v1 = __builtin_elementwise_max(v1, (f32x4){0.f, 0.f, 0.f, 0.f}); v0 = v0 * v0; v1 = v1 * v1; }
    }
    __device__ __forceinline__ void operator()(const f32x4 (&acc)[2][2][4][2], const f32x4 (&accx)[2], const Unit& u, int wr, int wc, int fr, int fq) const {
        bf16_t* Ot = O + ((size_t)u.pm * BM * ldc + (size_t)u.pn * BM); const float* sst = ss + (size_t)u.pm * BM * 16;
        unsigned rl0 = (unsigned)(wr * 64 + fr), cl0 = (unsigned)(wc * 32 + 8 * fq); const unsigned uld = (unsigned)ldc; unsigned frv = (unsigned)fr;
        asm volatile("" : "+v"(rl0), "+v"(cl0), "+v"(frv));
        const bool gl = (ACT == 0) && (u.pn < gelu_tiles);
        {
            f32x4 s0, s1; ld2_b128(s0, s1, ssx + (size_t)u.pm * 16 * 32, (frv * 32u + 8u * (unsigned)fq) * 4u); const float rs = rstd_from_slots32(s0, s1);
            f32x4 v0 = accx[0] * rs, v1 = accx[1] * rs; act8(v0, v1, gl);
            u32x4 w; w.x = cvt_pk_bf16(v0[0], v0[1]); w.y = cvt_pk_bf16(v0[2], v0[3]); w.z = cvt_pk_bf16(v1[0], v1[1]); w.w = cvt_pk_bf16(v1[2], v1[3]);
            *(u32x4*)(OS + ((size_t)u.pm * 16 * ldc + (size_t)u.pn * BM) + (frv * uld + (unsigned)(wr * HALF) + cl0)) = w; }
        unsigned vo[8]; f32x4 sv[8]; float rsv[8];
#pragma unroll
        for (int i = 0; i < 8; ++i) vo[i] = ((rl0 + (unsigned)((i >> 2) * HALF + (i & 3) * 16)) * 16u + 4u * (unsigned)fq) * 4u;
        ld8_b128(sv, sst, vo);
#pragma unroll
        for (int i = 0; i < 8; ++i) rsv[i] = rstd_from_slots(sv[i]);
#pragma unroll
        for (int ai = 0; ai < 2; ++ai)
#pragma unroll
            for (int m = 0; m < 4; ++m) { const float rs = rsv[ai * 4 + m]; const unsigned off = (rl0 + (unsigned)(ai * HALF + m * 16)) * uld + cl0;
#pragma unroll
                for (int bj = 0; bj < 2; ++bj) { f32x4 v0 = acc[ai][bj][m][0] * rs, v1 = acc[ai][bj][m][1] * rs; act8(v0, v1, gl);
                    u32x4 w; w.x = cvt_pk_bf16(v0[0], v0[1]); w.y = cvt_pk_bf16(v0[2], v0[3]); w.z = cvt_pk_bf16(v1[0], v1[1]); w.w = cvt_pk_bf16(v1[2], v1[3]);
                    *(u32x4*)(Ot + (off + (unsigned)(bj * HALF))) = w; } }
    }
};
template <bool RS> struct EpiResX {
    static constexpr bool RESCALE = RS;
    bf16_t* XB; float* ssout; float* ssxout; const float* ssg;
    __device__ __forceinline__ void rescale(f32x4 (&acc)[2][2][4][2], f32x4 (&accx)[2], const Unit& u, int wr, int fr) const {
        const float* sgt = ssg + (size_t)u.pm * BM * 2; unsigned rl0 = (unsigned)(wr * 64 + fr), frv = (unsigned)fr; asm volatile("" : "+v"(rl0), "+v"(frv));
        unsigned vo[8]; f32x2 gv[8]; f32x2 gx;
#pragma unroll
        for (int i = 0; i < 8; ++i) vo[i] = (rl0 + (unsigned)((i >> 2) * HALF + (i & 3) * 16)) * 8u;
        ld1_b64(gx, ssg + ((size_t)16384 + (size_t)u.pm * 16) * 2, frv * 8u);
        ld8_b64(gv, sgt, vo);
        { const float rs = __builtin_amdgcn_rsqf((gx.x + gx.y) * (1.0f / 512.0f) + 1e-5f); accx[0] = accx[0] * rs; accx[1] = accx[1] * rs; }
#pragma unroll
        for (int ai = 0; ai < 2; ++ai)
#pragma unroll
            for (int m = 0; m < 4; ++m) { const f32x2 v = gv[ai * 4 + m];
                const float rs = __builtin_amdgcn_rsqf((v.x + v.y) * (1.0f / 512.0f) + 1e-5f);
#pragma unroll
                for (int bj = 0; bj < 2; ++bj)
#pragma unroll
                    for (int n = 0; n < 2; ++n) acc[ai][bj][m][n] = acc[ai][bj][m][n] * rs; }
    }
    __device__ __forceinline__ void operator()(const f32x4 (&acc)[2][2][4][2], const f32x4 (&accx)[2], const Unit& u, int wr, int wc, int fr, int fq) const {
        const size_t tb = (size_t)u.pm * BM * 1024 + (size_t)u.pn * BM;
        bf16_t* XBt = XB + tb; float* sot = ssout + ((size_t)u.pm * BM * 16 + (size_t)(u.pn * 4 + wc));
        unsigned rl0 = (unsigned)(wr * 64 + fr), cl0 = (unsigned)(wc * 32 + 8 * fq), frv = (unsigned)fr;
        asm volatile("" : "+v"(rl0), "+v"(cl0), "+v"(frv));
        {
            const size_t sb = (size_t)u.pm * 16 * 1024 + (size_t)u.pn * BM; const unsigned off = frv * 1024u + (unsigned)(wr * HALF) + cl0;
            bf16_t* XBs = XB + ((size_t)16384 * 1024 + sb);
            u32x4 br; ld1_u128(br, XBs, off * 2u); f32x4 b0, b1; unpk8(br, b0, b1);
            const f32x4 x0 = b0 + accx[0], x1 = b1 + accx[1];
            u32x4 w; w.x = cvt_pk_bf16(x0[0], x0[1]); w.y = cvt_pk_bf16(x0[2], x0[3]); w.z = cvt_pk_bf16(x1[0], x1[1]); w.w = cvt_pk_bf16(x1[2], x1[3]);
            *(u32x4*)(XBs + off) = w;
            float sq = (x0[0] * x0[0] + x0[1] * x0[1]) + (x0[2] * x0[2] + x0[3] * x0[3]) + (x1[0] * x1[0] + x1[1] * x1[1]) + (x1[2] * x1[2] + x1[3] * x1[3]);
            sq += xswz<16>(sq); sq = sum_halves(sq);
            if (fq == 0) ssxout[((size_t)u.pm * 16) * 32 + (size_t)(u.pn * 8 + wr * 4 + wc) + frv * 32u] = sq; }
        unsigned vo[8]; u32x4 bv[16];
#pragma unroll
        for (int i = 0; i < 8; ++i) vo[i] = ((rl0 + (unsigned)((i >> 2) * HALF + (i & 3) * 16)) * 1024u + cl0) * 2u;
        ld16_resb(bv, XBt, vo);
#pragma unroll
        for (int ai = 0; ai < 2; ++ai) {
#pragma unroll
            for (int m = 0; m < 4; ++m) { const unsigned rl = rl0 + (unsigned)(ai * HALF + m * 16), off = rl * 1024u + cl0; float sq = 0.f;
#pragma unroll
                for (int bj = 0; bj < 2; ++bj) { const unsigned o2 = off + (unsigned)(bj * HALF);
                    f32x4 b0, b1; unpk8(bv[2 * (4 * ai + m) + bj], b0, b1);
                    const f32x4 x0 = b0 + acc[ai][bj][m][0], x1 = b1 + acc[ai][bj][m][1];
                    u32x4 w; w.x = cvt_pk_bf16(x0[0], x0[1]); w.y = cvt_pk_bf16(x0[2], x0[3]); w.z = cvt_pk_bf16(x1[0], x1[1]); w.w = cvt_pk_bf16(x1[2], x1[3]);
                    *(u32x4*)(XBt + o2) = w;
                    sq += (x0[0] * x0[0] + x0[1] * x0[1]) + (x0[2] * x0[2] + x0[3] * x0[3]) + (x1[0] * x1[0] + x1[1] * x1[1]) + (x1[2] * x1[2] + x1[3] * x1[3]); }
                sq += xswz<16>(sq); sq = sum_halves(sq);
                if (fq == 0) sot[rl * 16u] = sq; }
        }
    }
};

constexpr int SM_STAGE_BYTES = 32768, SM_SQ_OFF = 148480;
template <int TS, class EpiS>
__device__ __forceinline__ void small_gemm_phase(PG8_LAS unsigned char* lds, const bf16_t* A, const bf16_t* Bt, const int K, const int nN, const int n_units, const int first_unit, const int unit_stride, const EpiS& E, const int tid) {
    constexpr int NP = TS / 64, NM = TS == 128 ? 4 : 1, LPS = 2 * NP;
    const int wid = __builtin_amdgcn_readfirstlane(tid >> 6), lane = tid & 63, fr = lane & 15, fq = lane >> 4;
    const int wr = TS == 128 ? (wid >> 2) : 0, wc = TS == 128 ? (wid & 3) : (wid >> 2), mq = wid & 3;
    const int nt = K / BK;
    unsigned voffA[NP], voffB[NP];
#pragma unroll
    for (int i = 0; i < NP; ++i) { int R, C; stage_rc(tid * 16 + i * 8192, R, C); const int Rb = (R & ~31) + perm32(R & 31); voffA[i] = (unsigned)(R * K + C) * 2u; voffB[i] = (unsigned)(Rb * K + C) * 2u; }
    const unsigned ldsw = (unsigned)wid * 1024u;
    const int aoff = TS == 128 ? lds_byte(wr * 64 + fr, fq * 8) : lds_byte(mq * 16 + fr, fq * 8), boff = 16384 + lds_byte(wc * 32 + fr, fq * 8);
#define SM_STAGE(st, kt) do { _Pragma("unroll") for (int _i = 0; _i < NP; ++_i) { \
        __builtin_amdgcn_global_load_lds((const unsigned*)(cA + voffA[_i] + (size_t)(kt) * 128), (PG8_LAS unsigned*)(lds + (st) * SM_STAGE_BYTES + ldsw + _i * 8192), 16, 0, 0); \
        __builtin_amdgcn_global_load_lds((const unsigned*)(cB + voffB[_i] + (size_t)(kt) * 128), (PG8_LAS unsigned*)(lds + (st) * SM_STAGE_BYTES + 16384 + ldsw + _i * 8192), 16, 0, 0); } } while (0)
#define SM_WAIT_V(n) asm volatile("s_waitcnt vmcnt(%0)" :: "n"(n) : "memory")
    for (int u = first_unit; u < n_units; u += unit_stride) {
        const int pm = u / nN, pn = u % nN;
        const char* cA = (const char*)A + (size_t)pm * TS * K * 2; const char* cB = (const char*)Bt + (size_t)pn * TS * K * 2;
        f32x4 acc[NM][2];
#pragma unroll
        for (int m = 0; m < NM; ++m) { acc[m][0] = (f32x4){0.f, 0.f, 0.f, 0.f}; acc[m][1] = (f32x4){0.f, 0.f, 0.f, 0.f}; }
        E.begin(pm, pn, wr, mq, fr);
        asm volatile("s_waitcnt vmcnt(0)" ::: "memory"); __builtin_amdgcn_s_barrier();
        SM_STAGE(0, 0); SM_STAGE(1, 1); SM_STAGE(2, 2);
#pragma unroll 1
        for (int t = 0; t < nt; ++t) {
            if (t + 2 < nt) SM_WAIT_V(2 * LPS); else if (t + 1 < nt) SM_WAIT_V(LPS); else SM_WAIT_V(0);
            __builtin_amdgcn_s_barrier();
            if (t + 3 < nt) SM_STAGE((t + 3) & 3, t + 3);
            if (E.RESCALE) { if (t == 8) E.rescale(acc); }
            const PG8_LAS unsigned char* sb = lds + (t & 3) * SM_STAGE_BYTES;
            bf16x8 Af[NM][2], Bf[2][2];
#pragma unroll
            for (int m = 0; m < NM; ++m)
#pragma unroll
                for (int k = 0; k < 2; ++k) Af[m][k] = *(const PG8_LAS bf16x8*)(sb + aoff + m * 2048 + k * 1024);
#pragma unroll
            for (int n = 0; n < 2; ++n)
#pragma unroll
                for (int k = 0; k < 2; ++k) Bf[n][k] = *(const PG8_LAS bf16x8*)(sb + boff + n * 2048 + k * 1024);
#pragma unroll
            for (int m = 0; m < NM; ++m)
#pragma unroll
                for (int n = 0; n < 2; ++n)
#pragma unroll
                    for (int k = 0; k < 2; ++k) acc[m][n] = __builtin_amdgcn_mfma_f32_16x16x32_bf16(Bf[n][k], Af[m][k], acc[m][n], 0, 0, 0);
        }
        E.store(acc, pm, pn, wr, wc, mq, fr, fq, lds, tid);
    }
    asm volatile("s_waitcnt vmcnt(0)" ::: "memory"); __builtin_amdgcn_s_barrier();
#undef SM_STAGE
#undef SM_WAIT_V
}
struct SEpiFF1 {
    static constexpr bool RESCALE = false;
    bf16_t* O; int ldc; const float* ss; int row_base;
    __device__ __forceinline__ void begin(int, int, int, int, int) const {}
    __device__ __forceinline__ void rescale(f32x4 (&)[4][2]) const {}
    __device__ __forceinline__ void store(const f32x4 (&acc)[4][2], int pm, int pn, int wr, int wc, int, int fr, int fq, PG8_LAS unsigned char*, int) const {
        const size_t r0 = (size_t)row_base + (size_t)pm * 128; bf16_t* Ot = O + (r0 * ldc + (size_t)pn * 128); const float* sst = ss + r0 * 16;
        unsigned rl0 = (unsigned)(wr * 64 + fr), cl0 = (unsigned)(wc * 32 + 8 * fq); asm volatile("" : "+v"(rl0), "+v"(cl0));
        unsigned vo[4]; f32x4 sv[4];
#pragma unroll
        for (int m = 0; m < 4; ++m) vo[m] = ((rl0 + (unsigned)(m * 16)) * 16u + 4u * (unsigned)fq) * 4u;
        ld4_b128(sv, sst, vo);
#pragma unroll
        for (int m = 0; m < 4; ++m) { const unsigned rl = rl0 + (unsigned)(m * 16); const float rs = rstd_from_slots(sv[m]);
            f32x4 v0 = acc[m][0] * rs, v1 = acc[m][1] * rs;
            v0 = __builtin_elementwise_max(v0, (f32x4){0.f, 0.f, 0.f, 0.f}); v1 = __builtin_elementwise_max(v1, (f32x4){0.f, 0.f, 0.f, 0.f}); v0 = v0 * v0; v1 = v1 * v1;
            u32x4 w; w.x = cvt_pk_bf16(v0[0], v0[1]); w.y = cvt_pk_bf16(v0[2], v0[3]); w.z = cvt_pk_bf16(v1[0], v1[1]); w.w = cvt_pk_bf16(v1[2], v1[3]);
            *(u32x4*)(Ot + (rl * (unsigned)ldc + cl0)) = w; }
    }
};
struct SEpiDt {
    static constexpr bool RESCALE = false;
    float* DT; const float* ss; const float* bias; const float* ssx;
    __device__ __forceinline__ void begin(int, int, int, int, int) const {}
    __device__ __forceinline__ void rescale(f32x4 (&)[1][2]) const {}
    __device__ __forceinline__ void store(const f32x4 (&acc)[1][2], int pm, int, int, int wc, int mq, int fr, int fq, PG8_LAS unsigned char*, int) const {
        const size_t r0 = (size_t)pm * 64; unsigned rl = (unsigned)(mq * 16 + fr); asm volatile("" : "+v"(rl));
        float rs;
        if (pm < 256) { f32x4 sv; ld1_b128(sv, ss + r0 * 16, (rl * 16u + 4u * (unsigned)fq) * 4u); rs = rstd_from_slots(sv); }
        else { f32x4 s0, s1; ld2_b128(s0, s1, ssx + (r0 - 16384) * 32, (rl * 32u + 8u * (unsigned)fq) * 4u); rs = rstd_from_slots32(s0, s1); }
        if (wc == 0 && fq == 0) { const f32x4 b0 = *(const f32x4*)bias, b1 = *(const f32x4*)(bias + 4); f32x4 d0, d1;
#pragma unroll
            for (int i = 0; i < 4; ++i) { d0[i] = softplus_f(acc[0][0][i] * rs + b0[i]); d1[i] = softplus_f(acc[0][1][i] * rs + b1[i]); }
            float* dst = DT + (r0 + rl) * 8; *(f32x4*)dst = d0; *(f32x4*)(dst + 4) = d1; }
    }
};
template <bool RS> struct SEpiRes {
    static constexpr bool RESCALE = RS;
    const float* base; float* X; bf16_t* XB; float* ssout; const float* ssg; int row_base;
    mutable float rsl;
    __device__ __forceinline__ void begin(int pm, int, int, int mq, int fr) const {
        if (RS) { f32x2 v; ld1_b64(v, ssg + ((size_t)row_base + (size_t)pm * 64) * 2, (unsigned)(mq * 16 + fr) * 8u); rsl = __builtin_amdgcn_rsqf((v.x + v.y) * (1.0f / 512.0f) + 1e-5f); }
    }
    __device__ __forceinline__ void rescale(f32x4 (&acc)[1][2]) const { acc[0][0] = acc[0][0] * rsl; acc[0][1] = acc[0][1] * rsl; }
    __device__ __forceinline__ void store(const f32x4 (&acc)[1][2], int pm, int pn, int, int wc, int mq, int fr, int fq, PG8_LAS unsigned char* lds, int tid) const {
        const size_t r0 = (size_t)row_base + (size_t)pm * 64, tb = r0 * 1024 + (size_t)pn * 64;
        const float* bt = base + tb; float* Xt = X + tb; bf16_t* XBt = XB + tb;
        unsigned rl = (unsigned)(mq * 16 + fr), cl0 = (unsigned)(wc * 32 + 8 * fq); asm volatile("" : "+v"(rl), "+v"(cl0));
        const unsigned off = rl * 1024u + cl0;
        f32x4 b0, b1; ld2_b128(b0, b1, bt, off * 4u);
        const f32x4 x0 = b0 + acc[0][0], x1 = b1 + acc[0][1];
        *(f32x4*)(Xt + off) = x0; *(f32x4*)(Xt + (off + 4u)) = x1;
        u32x4 w; w.x = cvt_pk_bf16(x0[0], x0[1]); w.y = cvt_pk_bf16(x0[2], x0[3]); w.z = cvt_pk_bf16(x1[0], x1[1]); w.w = cvt_pk_bf16(x1[2], x1[3]);
        *(u32x4*)(XBt + off) = w;
        float sq = (x0[0] * x0[0] + x0[1] * x0[1]) + (x0[2] * x0[2] + x0[3] * x0[3]) + (x1[0] * x1[0] + x1[1] * x1[1]) + (x1[2] * x1[2] + x1[3] * x1[3]);
        sq += xswz<16>(sq); sq = sum_halves(sq);
        PG8_LAS float* sqp = (PG8_LAS float*)(lds + SM_SQ_OFF);
        if (fq == 0) sqp[rl * 2u + (unsigned)wc] = sq;
        asm volatile("s_waitcnt lgkmcnt(0)" ::: "memory"); __builtin_amdgcn_s_barrier(); asm volatile("" ::: "memory");
        if (tid < 64) ssout[(r0 + (size_t)tid) * 16 + pn] = sqp[tid * 2] + sqp[tid * 2 + 1];
    }
};
}

constexpr int NWAVES = 8;
constexpr int DM = 1024, DEPTH = 4, MP = 16384, MS = 1024, M = MP + MS, SEQ = 2048, DSEQ = 8, NB = 8, NDB = 128;
constexpr int DIN = 2824, DING = 2816, FF = 4096;
constexpr int C_U = 0, C_V = 256, C_BG = 512, C_CG = 768, C_HB = 1024, C_Z = 1280, C_XBC = 1792, C_DT = 2816;
constexpr float EPS = 1e-5f;
constexpr size_t O_YP = 0, O_YS = 16777216, O_CVP = 17825792, O_CP = 18874368, O_SCP = 18890752, O_SP = 18989056, O_CVS = 21086208, O_CS = 22134784, O_SCS = 22396928, O_SS = 23969792, O_END = 57524224;
enum { I_XP = 0, I_XS, I_SC, I_SSC, I_SSM, I_N1, I_WIN, I_WS, I_BS, I_CW, I_SCW, I_SCB, I_DTB, I_ALOG, I_DSK, I_SSN, I_WOUT, I_N2, I_W1, I_W2, I_FN, N_IN };

constexpr size_t al256(size_t x) { return (x + 255) & ~(size_t)255; }
constexpr size_t WS_CTL = 0, CTL_ZERO_BYTES = 1u << 20;
constexpr size_t WS_WIN = CTL_ZERO_BYTES;
constexpr size_t WS_WOUT = WS_WIN + (size_t)DEPTH * DING * DM * 2;
constexpr size_t WS_W1 = WS_WOUT + (size_t)DEPTH * DM * DM * 2;
constexpr size_t WS_W2 = WS_W1 + (size_t)DEPTH * FF * DM * 2;
constexpr size_t WS_WDT = WS_W2 + (size_t)DEPTH * DM * FF * 2;
constexpr size_t WS_WDTB = WS_WDT + (size_t)DEPTH * DM * 8 * 4;
constexpr size_t WS_WMB = WS_WDTB + (size_t)DEPTH * 64 * DM * 2;
constexpr size_t WS_XB = WS_WMB + (size_t)DEPTH * 4 * 128 * 128 * 2;
constexpr size_t WS_SS1 = WS_XB + (size_t)M * DM * 2;
constexpr size_t WS_SS2 = WS_SS1 + (size_t)M * 16 * 4;
constexpr size_t WS_SSX1 = WS_SS2 + (size_t)M * 16 * 4;
constexpr size_t WS_SSX2 = WS_SSX1 + (size_t)MS * 32 * 4;
constexpr size_t WS_DT = WS_SSX2 + (size_t)MS * 32 * 4;
constexpr size_t WS_CUM = WS_DT + (size_t)M * 8 * 4;
constexpr size_t WS_SSG = WS_CUM + (size_t)M * 8 * 4;
constexpr size_t WS_CD = WS_SSG + (size_t)M * 2 * 4;
constexpr size_t WS_YCAT = WS_CD + 64 * 16 * 4;
constexpr size_t WS_YS = WS_YCAT + (size_t)M * DM * 2;
constexpr size_t WS_XBCS = WS_YS + (size_t)MS * 512 * 4;
constexpr size_t WS_XBCB = WS_XBCS + (size_t)MS * DM * 4;
constexpr size_t WS_SBUF = WS_XBCB + (size_t)MP * DM * 2;
constexpr size_t WS_HB = WS_SBUF + (size_t)64 * 16 * 8192 * 4;
constexpr size_t WS_PROJ = WS_HB + (size_t)64 * 16 * 8192 * 2;
constexpr size_t WS_HID = WS_PROJ + (size_t)M * DING * 2;
constexpr size_t WS_END = WS_HID + (size_t)M * FF * 2;
static_assert(WS_PROJ + (size_t)M * DING * 2 <= WS_END, "HID overlay");
static_assert(WS_WIN % 256 == 0 && WS_XB % 256 == 0 && WS_SS1 % 256 == 0 && WS_PROJ % 256 == 0 && WS_XBCB % 256 == 0 && WS_SBUF % 256 == 0 && WS_HB % 256 == 0 && WS_YCAT % 256 == 0 && WS_WMB % 256 == 0, "align");
constexpr int CW_BAR = 4096;
#ifndef CVT_SHARES
#define CVT_SHARES 0, 0, 1, 1, 2, 2, 3, 3
#endif
__device__ __forceinline__ constexpr int CVT_SHARE(int j) { constexpr int t[8] = {CVT_SHARES}; return t[j]; }

constexpr int RING_BYTES = 131072, PHASE_LDS = 147456, LDSCTL_OFF = PHASE_LDS, MISC_OFF = LDSCTL_OFF + 320, LDS_BYTES = 151552;

#define GAS __attribute__((address_space(1)))
#define LAS __attribute__((address_space(3)))
typedef unsigned short bf16;
typedef unsigned v4u __attribute__((ext_vector_type(4)));
typedef unsigned v2u __attribute__((ext_vector_type(2)));
typedef float f32x4 __attribute__((ext_vector_type(4)));
typedef GAS unsigned gu32;
#define RLX_AGENT __ATOMIC_RELAXED, __HIP_MEMORY_SCOPE_AGENT
#define LDS_WAIT() asm volatile("s_waitcnt lgkmcnt(0)" ::: "memory")
#define LAUNDER_V(x) asm volatile("" : "+v"(x))
#define LAUNDER_S(x) asm volatile("" : "+s"(x))
__device__ __forceinline__ unsigned f2bf(float f) { unsigned u = __builtin_bit_cast(unsigned, f); return (u + 0x7fffu + ((u >> 16) & 1u)) >> 16; }
__device__ __forceinline__ unsigned pk2(float lo, float hi) { return f2bf(lo) | (f2bf(hi) << 16); }
__device__ __forceinline__ float bf2f(unsigned b) { return __builtin_bit_cast(float, b << 16); }
__device__ __forceinline__ float bflo(unsigned w) { return __builtin_bit_cast(float, w << 16); }
__device__ __forceinline__ float bfhi(unsigned w) { return __builtin_bit_cast(float, w & 0xffff0000u); }

#define XB_TMO      128
#define XB_XCNT(j)  (256  + 64 * (j))
#define XB_XSUB(j)  (1280 + 64 * (j))
#define XB_XGEN(j)  (2304 + 64 * (j))
#define XB_TOP      3328
#define XB_TOPGEN   3392
#define XB_HTOP(h)  (3456 + 128 * (h))
#define XCD_BAR_WORDS 3712
#define XB_SPIN_CAP (1u << 18)
__device__ __forceinline__ unsigned xb_ld(unsigned* p)              { return __hip_atomic_load(p, __ATOMIC_RELAXED, __HIP_MEMORY_SCOPE_AGENT); }
__device__ __forceinline__ unsigned xb_add(unsigned* p, unsigned v) { return __hip_atomic_fetch_add(p, v, __ATOMIC_RELAXED, __HIP_MEMORY_SCOPE_AGENT); }
__device__ __forceinline__ unsigned xb_xcc_id() { return (unsigned)__builtin_amdgcn_s_getreg((3 << 11) | 20) & 0xFu; }
#define XB_SPIN(cond, bar) do { unsigned _sp = 0; while (cond) { __builtin_amdgcn_s_sleep(1); \
    if ((++_sp & 255u) == 0u) { if (xb_ld(&(bar)[XB_TMO])) break; if (_sp > XB_SPIN_CAP) { atomicAdd(&(bar)[XB_TMO], 1u); break; } } } } while (0)
struct XcdBarrier { unsigned* bar; unsigned x; volatile LAS unsigned* st; };
__device__ __forceinline__ XcdBarrier xcd_barrier_post(unsigned* bar, volatile LAS unsigned* st) {
    XcdBarrier b; b.bar = bar; b.x = xb_xcc_id(); b.st = st;
    if (threadIdx.x == 0) st[2] = xb_add(&bar[XB_XCNT(b.x)], 1u) + 1u;
    return b;
}
__device__ __forceinline__ void xcd_barrier_complete(unsigned* bar, unsigned x, unsigned& nloc, unsigned& nx, unsigned& even) {
    const unsigned G = gridDim.x * gridDim.y * gridDim.z;
    asm volatile("" : "+s"(x));
    unsigned sum, cnt, mine, sp = 0u;
    for (;;) {
        sum = 0u; cnt = 0u; mine = 0u;
#pragma unroll
        for (unsigned j = 0; j < 16; ++j) { const unsigned c = xb_ld(&bar[XB_XCNT(j)]); sum += c; cnt += (c > 0u) ? 1u : 0u; mine = (j == x) ? c : mine; }
        if (sum == G) break;
        __builtin_amdgcn_s_sleep(1);
        if ((++sp & 255u) == 0u) { if (xb_ld(&bar[XB_TMO])) break; if (sp > XB_SPIN_CAP) { atomicAdd(&bar[XB_TMO], 1u); break; } }
    }
    nloc = mine > 0u ? mine : 1u; nx = cnt > 0u ? cnt : 1u;
    bool ev = (G == 256u) && (cnt == 8u);
#pragma unroll
    for (unsigned j = 0; j < 8; ++j) ev = ev && (xb_ld(&bar[XB_XCNT(j)]) == 32u);
    even = ev ? 1u : 2u;
}
__device__ __forceinline__ void xcd_barrier(const XcdBarrier& b, const bool local = false, const int half = -1, unsigned* wflag = nullptr, const unsigned wneed = 0u, const bool sig = false) {
    asm volatile("s_waitcnt vmcnt(0)" ::: "memory");
    __syncthreads();
    if (threadIdx.x == 0) {
        unsigned* bar = b.bar;
        __builtin_amdgcn_s_waitcnt(0);
        unsigned nloc = b.st[0], nx = b.st[1];
        if (nloc == 0u) { unsigned ev_; xcd_barrier_complete(bar, b.x, nloc, nx, ev_); b.st[0] = nloc; b.st[1] = nx; b.st[3] = ev_; }
        const unsigned topi = half >= 0 ? (unsigned)XB_HTOP(half) : (unsigned)XB_TOP; if (half >= 0) nx = 4u;
        const unsigned old = xb_add(&bar[XB_XSUB(b.x)], 1u);
        const unsigned gen = old / nloc;
        if (local) {
            if (old + 1u == (gen + 1u) * nloc) {
                if (sig) {
                    __builtin_amdgcn_fence(__ATOMIC_RELEASE, "agent"); asm volatile("s_waitcnt vmcnt(0)" ::: "memory");
                    const unsigned oc = xb_add(&bar[XB_HTOP(0)], 1u); if (oc + 1u == 8u) xb_add(&bar[XB_HTOP(0) + 64], 1u); }
                if (wneed) XB_SPIN(xb_ld(wflag) < wneed, bar);
                xb_add(&bar[XB_XGEN(b.x)], 1u); }
            else XB_SPIN(xb_ld(&bar[XB_XGEN(b.x)]) == gen, bar);
            __builtin_amdgcn_fence(__ATOMIC_ACQUIRE, "agent");
            asm volatile("s_waitcnt vmcnt(0)" ::: "memory");
        } else if (old + 1u == (gen + 1u) * nloc) {
            __builtin_amdgcn_fence(__ATOMIC_RELEASE, "agent");
            asm volatile("s_waitcnt vmcnt(0)" ::: "memory");
            const unsigned og = xb_add(&bar[topi], 1u);
            const unsigned tg = og / nx;
            if (og + 1u == (tg + 1u) * nx) xb_add(&bar[topi + 64u], 1u);
            else XB_SPIN(xb_ld(&bar[topi + 64u]) == tg, bar);
            if (wneed) XB_SPIN(xb_ld(wflag) < wneed, bar);
            __builtin_amdgcn_fence(__ATOMIC_ACQUIRE, "agent");
            xb_add(&bar[XB_XGEN(b.x)], 1u);
            asm volatile("s_waitcnt vmcnt(0)" ::: "memory");
        } else {
            XB_SPIN(xb_ld(&bar[XB_XGEN(b.x)]) == gen, bar);
            __builtin_amdgcn_fence(__ATOMIC_ACQUIRE, "agent");
            asm volatile("s_waitcnt vmcnt(0)" ::: "memory");
        }
    }
    __syncthreads();
}

struct Args { const float* in[N_IN]; float* out; unsigned char* ws; int ph_lo, ph_hi; };
struct Frame {
    LAS unsigned char* lds;
    int tid, lane, wave, vcu, G, bid;
    const __attribute__((address_space(4))) Args* ap; float* out; unsigned char* ws;
    __device__ __forceinline__ const float* inp(int i) const { return ap->in[i]; }
};
__device__ __forceinline__ float wave_sum(float v) {
    v += xswz<1>(v); v += xswz<2>(v); v += xswz<4>(v); v += xswz<8>(v); v += xswz<16>(v); v = sum_halves(v);
    return v;
}
__device__ __forceinline__ float silu_f(float v) { return v * __builtin_amdgcn_rcpf(1.0f + __expf(-v)); }
struct CvtItem { const float* W; const float* gain; bf16* WT; int ldw, K, gain_n, krot, k0, n0; };
struct CvtRegs { f32x4 w[8]; float g; };
__device__ __forceinline__ CvtItem cvt_item(const Frame& F, int it) {
    constexpr int I_IN = (DM / 64) * (DING / 32), I_O = (DM / 64) * (DM / 32), I_1 = (DM / 64) * (FF / 32), I_2 = (FF / 64) * (DM / 32), I_L = I_IN + I_O + I_1 + I_2;
    const int l = it / I_L; int r = it % I_L; CvtItem d; int nblk;
    if (r < I_IN) { d.W = F.inp(I_WIN) + (size_t)l * DM * DIN; d.ldw = DIN; d.K = DM; nblk = DING / 32; d.gain = F.inp(I_N1) + l * DM; d.gain_n = DM; d.krot = 0; d.WT = (bf16*)(F.ws + WS_WIN) + (size_t)l * DING * DM; }
    else if ((r -= I_IN) < I_O) { d.W = F.inp(I_WOUT) + (size_t)l * DM * DM; d.ldw = DM; d.K = DM; nblk = DM / 32; d.gain = F.inp(I_SSN) + l * 512; d.gain_n = 512; d.krot = 512; d.WT = (bf16*)(F.ws + WS_WOUT) + (size_t)l * DM * DM; }
    else if ((r -= I_O) < I_1) { d.W = F.inp(I_W1) + (size_t)l * DM * FF; d.ldw = FF; d.K = DM; nblk = FF / 32; d.gain = F.inp(I_N2) + l * DM; d.gain_n = DM; d.krot = 0; d.WT = (bf16*)(F.ws + WS_W1) + (size_t)l * FF * DM; }
    else { r -= I_1; d.W = F.inp(I_W2) + (size_t)l * FF * DM; d.ldw = DM; d.K = FF; nblk = DM / 32; d.gain = F.inp(I_N1); d.gain_n = 0; d.krot = 0; d.WT = (bf16*)(F.ws + WS_W2) + (size_t)l * DM * FF; }
    d.k0 = 64 * (r / nblk); d.n0 = 32 * (r % nblk);
    return d;
}
__device__ __forceinline__ void cvt_load(const CvtItem& d, CvtRegs& R, int lane) {
    const int gmask = d.gain_n > 0 ? d.gain_n - 1 : 0;
#pragma unroll
    for (int s8 = 0; s8 < 8; ++s8) { const int ks = (d.k0 + 8 * s8 + (lane >> 3) + d.krot) & (d.K - 1); R.w[s8] = *(const f32x4*)(d.W + (size_t)ks * d.ldw + d.n0 + 4 * (lane & 7)); }
    R.g = d.gain[(d.k0 + lane) & gmask];
}
__device__ __forceinline__ void cvt_finish(const CvtItem& d, const CvtRegs& R, LAS float* scr, int lane) {
    const float gl = (d.k0 + lane < d.gain_n) ? R.g : 1.0f;
#pragma unroll
    for (int s8 = 0; s8 < 8; ++s8) { const int kk = 8 * s8 + (lane >> 3);
        const float g = __builtin_bit_cast(float, __builtin_amdgcn_ds_bpermute(4 * kk, __builtin_bit_cast(int, gl)));
        LAS float* q = scr + kk * 33 + 4 * (lane & 7); const f32x4 v = R.w[s8] * g; q[0] = v.x; q[1] = v.y; q[2] = v.z; q[3] = v.w; }
    LDS_WAIT(); asm volatile("" ::: "memory");
    const int c = lane & 7;
#pragma unroll
    for (int j = 0; j < 4; ++j) { const int n = (lane >> 3) + 8 * j; const LAS float* sp = scr + (8 * c) * 33 + n;
        v4u o; o.x = pk2(sp[0 * 33], sp[1 * 33]); o.y = pk2(sp[2 * 33], sp[3 * 33]); o.z = pk2(sp[4 * 33], sp[5 * 33]); o.w = pk2(sp[6 * 33], sp[7 * 33]);
        *(v4u*)(d.WT + (size_t)(d.n0 + n) * d.K + d.k0 + 8 * c) = o; }
    LDS_WAIT(); asm volatile("" ::: "memory");
}
__device__ __forceinline__ const float* xin_row(const Frame& F, int l, int r) {
    if (l == 0) return r < MP ? F.inp(I_XP) + (size_t)r * DM : F.inp(I_XS) + (size_t)(r - MP) * DM;
    return F.out + (size_t)r * DM;
}
__device__ __forceinline__ void p0_prologue(const Frame& F, const int role, const int blo = 0, const int bhi = 0) {
    LAS float* scr = (LAS float*)(F.lds + F.wave * 16384);
    constexpr int I_IN = (DM / 64) * (DING / 32), I_O = (DM / 64) * (DM / 32), I_1 = (DM / 64) * (FF / 32), I_2 = (FF / 64) * (DM / 32), I_L = I_IN + I_O + I_1 + I_2;
    const int gw = role == 4 ? (F.vcu & 31) * NWAVES + F.wave : F.vcu * NWAVES + F.wave, NGW = role == 4 ? 32 * NWAVES : F.G * NWAVES;
    const int it_lo = role == 4 ? blo : 0, it_hi = role == 4 ? bhi : (role == 3 ? I_IN : DEPTH * I_L);
    {
        CvtRegs R0, R1, R2; const int j0 = it_lo + gw;
        if (j0 < it_hi) cvt_load(cvt_item(F, j0), R0, F.lane);
        if (j0 + NGW < it_hi) cvt_load(cvt_item(F, j0 + NGW), R1, F.lane);
        if (j0 + 2 * NGW < it_hi) cvt_load(cvt_item(F, j0 + 2 * NGW), R2, F.lane);
#pragma unroll 1
        for (int it = j0; it < it_hi; it += 3 * NGW) {
            cvt_finish(cvt_item(F, it), R0, scr, F.lane); if (it + 3 * NGW < it_hi) cvt_load(cvt_item(F, it + 3 * NGW), R0, F.lane);
            if (it + NGW < it_hi) { cvt_finish(cvt_item(F, it + NGW), R1, scr, F.lane); if (it + 4 * NGW < it_hi) cvt_load(cvt_item(F, it + 4 * NGW), R1, F.lane); }
            if (it + 2 * NGW < it_hi) { cvt_finish(cvt_item(F, it + 2 * NGW), R2, scr, F.lane); if (it + 5 * NGW < it_hi) cvt_load(cvt_item(F, it + 5 * NGW), R2, F.lane); }
        }
    }
    const int gt = gw * 64 + F.lane, NGT = NGW * 64;
    if (role != 4) {
    for (int i = gt; i < DEPTH * DM * 8; i += NGT) { const int l = i / (DM * 8), k = (i / 8) % DM, j = i % 8;
        ((float*)(F.ws + WS_WDT))[i] = F.inp(I_N1)[l * DM + k] * F.inp(I_WIN)[((size_t)l * DM + k) * DIN + C_DT + j]; }
    for (int i = gt; i < DEPTH * 64 * DM; i += NGT) { const int l = i / (64 * DM), n = (i / DM) % 64, k = i % DM;
        ((bf16*)(F.ws + WS_WDTB))[i] = n < 8 ? (bf16)f2bf(F.inp(I_N1)[l * DM + k] * F.inp(I_WIN)[((size_t)l * DM + k) * DIN + C_DT + n]) : (bf16)0; }
    for (int i = gt; i < DEPTH * 4 * 128 * 128; i += NGT) { const int t = (i >> 7) & 127, s = i & 127; ((bf16*)(F.ws + WS_WMB))[i] = s <= t ? (bf16)f2bf(F.inp(I_WS)[i]) : (bf16)0; }
    }
    for (int gi = gw; gi < (role == 4 ? 0 : M / 4); gi += NGW) {
        const int r4 = 4 * gi;
        f32x4 v[4][4];
#pragma unroll
        for (int q = 0; q < 4; ++q) { const f32x4* xr = (const f32x4*)xin_row(F, 0, r4 + q) + F.lane;
#pragma unroll
            for (int j = 0; j < 4; ++j) v[q][j] = xr[64 * j]; }
#pragma unroll
        for (int q = 0; q < 4; ++q) { float s = 0.f; v2u* o8 = (v2u*)((bf16*)(F.ws + WS_XB) + (size_t)(r4 + q) * DM) + F.lane;
#pragma unroll
            for (int j = 0; j < 4; ++j) { const f32x4 x = v[q][j]; s += (x.x * x.x + x.y * x.y) + (x.z * x.z + x.w * x.w); v2u w; w.x = pk2(x.x, x.y); w.y = pk2(x.z, x.w); o8[64 * j] = w; }
            s = wave_sum(s);
            if (r4 + q < MP) { if (F.lane < 16) ((float*)(F.ws + WS_SS1))[(size_t)(r4 + q) * 16 + F.lane] = F.lane == 0 ? s : 0.f; }
            else if (F.lane < 32) ((float*)(F.ws + WS_SSX1))[(size_t)(r4 + q - MP) * 32 + F.lane] = F.lane == 0 ? s : 0.f; }
    }
}

typedef float f32x16 __attribute__((ext_vector_type(16)));
typedef short s16x8 __attribute__((ext_vector_type(8)));
constexpr int LDT = 136;
constexpr int YC_YC = 0, YC_YA = 512, YC_YB = 768;
__device__ __forceinline__ f32x16 mma32(const LAS bf16* A, const LAS bf16* B, int K, f32x16 acc, int lane) {
    const LAS bf16* ap = A + (lane & 31) * LDT + 8 * (lane >> 5); const LAS bf16* bp = B + (lane & 31) * LDT + 8 * (lane >> 5);
    for (int k = 0; k < K; k += 16) { const s16x8 a = *(const LAS s16x8*)(ap + k), b = *(const LAS s16x8*)(bp + k); acc = __builtin_amdgcn_mfma_f32_32x32x16_bf16(a, b, acc, 0, 0, 0); }
    return acc;
}
__device__ __forceinline__ int crow(int reg, int half) { return (reg & 3) + 8 * (reg >> 2) + 4 * half; }
__device__ __forceinline__ void unpack8(const v4u w, float (&f)[8]) { f[0] = bflo(w.x); f[1] = bfhi(w.x); f[2] = bflo(w.y); f[3] = bfhi(w.y); f[4] = bflo(w.z); f[5] = bfhi(w.z); f[6] = bflo(w.w); f[7] = bfhi(w.w); }
__device__ __forceinline__ v4u pack8(float a, float b, float c, float d, float e, float f, float g, float h) { v4u w; w.x = pg8::cvt_pk_bf16(a, b); w.y = pg8::cvt_pk_bf16(c, d); w.z = pg8::cvt_pk_bf16(e, f); w.w = pg8::cvt_pk_bf16(g, h); return w; }
__device__ __forceinline__ float rstd_row16(const float* ss, int r) {
    const f32x4* p = (const f32x4*)(ss + (size_t)r * 16); const f32x4 a = p[0], b = p[1], c = p[2], d = p[3];
    const float s = ((a.x + a.y) + (a.z + a.w)) + ((b.x + b.y) + (b.z + b.w)) + ((c.x + c.y) + (c.z + c.w)) + ((d.x + d.y) + (d.z + d.w));
    return 1.0f / sqrtf(s * (1.0f / DM) + EPS);
}

__device__ __forceinline__ void m1_prompt_unit(const Frame& F, int l, int u) {
    const int g = u & 1, c = (u >> 1) & 15, b = u >> 5, r0 = b * SEQ + c * 128;
    int tid = F.tid, lane = F.lane, w = F.wave;
#define M_RELAUNDER() do { LAUNDER_V(tid); lane = tid & 63; w = __builtin_amdgcn_readfirstlane(tid >> 6); } while (0)
    LAS float* rs = (LAS float*)F.lds;
    LAS float* dtl = rs + 128;
    LAS float* cuml = dtl + 1024;
    LAS float* wl = cuml + 1024;
    LAS bf16* XTp = (LAS bf16*)(F.lds + 16384);
    LAS bf16* BmT = XTp + 256 * LDT;
    LAS bf16* VT = XTp;
    LAS bf16* Wl = XTp + 128 * LDT;
    const bf16* PROJ = (const bf16*)(F.ws + WS_PROJ); bf16* YCAT = (bf16*)(F.ws + WS_YCAT); bf16* XBCB = (bf16*)(F.ws + WS_XBCB);
    const float* scw = F.inp(I_SCW) + l * 4 * 1024; const float* scb = F.inp(I_SCB) + l * 1024;
    const int co3 = tid & 63, t03 = 16 * w;
    const int ch3 = co3 < 32 ? 256 * g + 8 * co3 : (co3 < 48 ? 512 + 128 * g + 8 * (co3 - 32) : 768 + 128 * g + 8 * (co3 - 48));
    v4u xr[19];
#pragma unroll
    for (int i = 0; i < 19; ++i) { const int t = t03 - 3 + i;
        if (t >= 0 || c > 0) xr[i] = *(const v4u*)(PROJ + (size_t)(r0 + t) * DING + C_XBC + ch3); else xr[i] = (v4u){0u, 0u, 0u, 0u}; }
    f32x4 wkv[4][2], biasv[2];
#pragma unroll
    for (int k = 0; k < 4; ++k) { wkv[k][0] = *(const f32x4*)(scw + k * 1024 + ch3); wkv[k][1] = *(const f32x4*)(scw + k * 1024 + ch3 + 4); }
    biasv[0] = *(const f32x4*)(scb + ch3); biasv[1] = *(const f32x4*)(scb + ch3 + 4);
    __syncthreads();
    { const float* DTg = (const float*)(F.ws + WS_DT) + (size_t)r0 * 8; dtl[tid] = DTg[tid]; dtl[tid + 512] = DTg[tid + 512]; }
    __syncthreads();
    M_RELAUNDER();
    if (tid < 8) { const float A = -expf(F.inp(I_ALOG)[l * 8 + tid]); float cs = 0.f;
#pragma unroll 8
        for (int t = 0; t < 128; ++t) { cs += dtl[t * 8 + tid] * A; cuml[t * 8 + tid] = cs; } }
    __syncthreads();
    for (int i = tid; i < 1024; i += NWAVES * 64) { const int t = i >> 3, h = i & 7; const float d = dtl[i], cs = cuml[i], tot = cuml[127 * 8 + h];
        wl[i] = __expf(tot - cs) * d;
        if ((h >> 2) == g) { ((float*)(F.ws + WS_CUM))[(size_t)(r0 + t) * 8 + h] = cs;
            if (t == 127) ((float*)(F.ws + WS_CD))[(b * 8 + h) * 16 + c] = __expf(tot); } }
    __syncthreads();
    M_RELAUNDER();
    {
        const int co = co3, tg = t03 >> 4, t0 = t03, ch = ch3;
        float wk[4][8], bias[8];
#pragma unroll
        for (int k = 0; k < 4; ++k) { wk[k][0] = wkv[k][0].x; wk[k][1] = wkv[k][0].y; wk[k][2] = wkv[k][0].z; wk[k][3] = wkv[k][0].w; wk[k][4] = wkv[k][1].x; wk[k][5] = wkv[k][1].y; wk[k][6] = wkv[k][1].z; wk[k][7] = wkv[k][1].w; }
        bias[0] = biasv[0].x; bias[1] = biasv[0].y; bias[2] = biasv[0].z; bias[3] = biasv[0].w; bias[4] = biasv[1].x; bias[5] = biasv[1].y; bias[6] = biasv[1].z; bias[7] = biasv[1].w;
        asm volatile("" ::: "memory");
        if (c == 15 && tg == 7) {
#pragma unroll
            for (int i = 16; i < 19; ++i) { float xv[8]; unpack8(xr[i], xv); float* dst = F.out + O_SCP + ((size_t)(l * NB + b) * 3 + (i - 16)) * 1024 + ch;
                *(f32x4*)dst = (f32x4){xv[0], xv[1], xv[2], xv[3]}; *(f32x4*)(dst + 4) = (f32x4){xv[4], xv[5], xv[6], xv[7]}; }
        }
#pragma unroll
        for (int q = 0; q < 4; ++q) {
            float x[7][8];
#pragma unroll
            for (int i = 0; i < 7; ++i) unpack8(xr[4 * q + i], x[i]);
            float o[4][8];
#pragma unroll
            for (int tt = 0; tt < 4; ++tt) {
#pragma unroll
                for (int j = 0; j < 8; ++j) { const float v = bias[j] + wk[0][j] * x[tt][j] + wk[1][j] * x[tt + 1][j] + wk[2][j] * x[tt + 2][j] + wk[3][j] * x[tt + 3][j]; o[tt][j] = silu_f(v); }
                *(v4u*)(XBCB + (size_t)(r0 + t0 + 4 * q + tt) * DM + ch) = pack8(o[tt][0], o[tt][1], o[tt][2], o[tt][3], o[tt][4], o[tt][5], o[tt][6], o[tt][7]); }
            if (co < 32) { const int h = 4 * g + (co >> 3); float sc[4];
#pragma unroll
                for (int tt = 0; tt < 4; ++tt) sc[tt] = wl[(t0 + 4 * q + tt) * 8 + h];
#pragma unroll
                for (int j = 0; j < 8; ++j) { v2u pw; pw.x = pg8::cvt_pk_bf16(o[0][j] * sc[0], o[1][j] * sc[1]); pw.y = pg8::cvt_pk_bf16(o[2][j] * sc[2], o[3][j] * sc[3]); *(LAS v2u*)(XTp + (8 * co + j) * LDT + t0 + 4 * q) = pw; }
            } else if (co < 48) {
#pragma unroll
                for (int j = 0; j < 8; ++j) { v2u pw; pw.x = pg8::cvt_pk_bf16(o[0][j], o[1][j]); pw.y = pg8::cvt_pk_bf16(o[2][j], o[3][j]); *(LAS v2u*)(BmT + (8 * (co - 32) + j) * LDT + t0 + 4 * q) = pw; }
            }
        }
    }
    __syncthreads();
    M_RELAUNDER();
    const int eo5 = tid & 15, t05 = 4 * (tid >> 4);
    v4u vvp[4], wv5[8];
    {   const int col = C_V + 128 * g + 8 * eo5;
#pragma unroll
        for (int tt = 0; tt < 4; ++tt) vvp[tt] = *(const v4u*)(PROJ + (size_t)(r0 + t05 + tt) * DING + col);
        const bf16* wsrc = (const bf16*)(F.ws + WS_WMB) + (size_t)(l * 4 + 2 * g) * 128 * 128;
#pragma unroll
        for (int j = 0; j < 8; ++j) { const int i = tid + 512 * j; wv5[j] = *(const v4u*)(wsrc + (size_t)i * 8); } }
    {
        const int pb = w >> 2, nb = w & 3; bf16* SB = (bf16*)(F.ws + WS_SBUF);
#pragma unroll 1
        for (int hl = 0; hl < 4; ++hl) {
            f32x16 acc;
#pragma unroll
            for (int i = 0; i < 16; ++i) acc[i] = 0.f;
            acc = mma32(XTp + (hl * 64 + 32 * pb) * LDT, BmT + (32 * nb) * LDT, 128, acc, lane);
            bf16* dst = SB + (((size_t)(b * 8 + 4 * g + hl) * 16 + c) * 64 + 32 * pb) * 128 + 32 * nb + (lane & 30);
            const bool odd = (lane & 1) != 0;
#pragma unroll
            for (int reg = 0; reg < 16; reg += 2) { const float a0 = acc[reg], a1 = acc[reg + 1], n0 = xswz<1>(a0), n1 = xswz<1>(a1);
                const unsigned pw = pg8::cvt_pk_bf16(odd ? n1 : a0, odd ? a1 : n0);
                *(unsigned*)(dst + (crow(reg, lane >> 5) + (odd ? 1 : 0)) * 128) = pw; }
        }
    }
    __syncthreads();
    M_RELAUNDER();
    {
        LAS bf16* Wl2 = Wl + 128 * LDT;
        { const int eo = eo5, t0 = t05; float vv[4][8];
#pragma unroll
            for (int tt = 0; tt < 4; ++tt) unpack8(vvp[tt], vv[tt]);
            v4u wv[8];
#pragma unroll
            for (int j = 0; j < 8; ++j) wv[j] = wv5[j];
#pragma unroll
            for (int j = 0; j < 8; ++j) { v2u pw; pw.x = pg8::cvt_pk_bf16(vv[0][j], vv[1][j]); pw.y = pg8::cvt_pk_bf16(vv[2][j], vv[3][j]); *(LAS v2u*)(VT + (8 * eo + j) * LDT + t0) = pw; }
            if (c == 15) {
#pragma unroll
                for (int tt = 0; tt < 4; ++tt) { float* dst = F.out + O_CVP + ((size_t)(l * NB + b) * 128 + t0 + tt) * 256 + 128 * g + 8 * eo;
                    *(f32x4*)dst = (f32x4){vv[tt][0], vv[tt][1], vv[tt][2], vv[tt][3]}; *(f32x4*)(dst + 4) = (f32x4){vv[tt][4], vv[tt][5], vv[tt][6], vv[tt][7]}; } }
#pragma unroll
            for (int j = 0; j < 8; ++j) { const int i = tid + 512 * j, hh = i >> 11, row = (i >> 4) & 127, ck = i & 15; *(LAS v4u*)((hh ? Wl2 : Wl) + row * LDT + 8 * ck) = wv[j]; }
        }
        __syncthreads();
        const int tb = w & 3, eh = w >> 2;
#pragma unroll
        for (int hh = 0; hh < 2; ++hh) {
            const int ha = 2 * g + hh;
            f32x16 acc;
#pragma unroll
            for (int i = 0; i < 16; ++i) acc[i] = 0.f;
            const int e = 32 * eh + (lane & 31), col = ha * 64 + e; const float* bsv = F.inp(I_BS) + (l * 4 + ha) * 128;
            unsigned ur[16]; f32x4 bq[4];
#pragma unroll
            for (int reg = 0; reg < 16; ++reg) ur[reg] = PROJ[(size_t)(r0 + 32 * tb + crow(reg, lane >> 5)) * DING + C_U + col];
#pragma unroll
            for (int q4 = 0; q4 < 4; ++q4) bq[q4] = *(const f32x4*)(bsv + 32 * tb + 8 * q4 + 4 * (lane >> 5));
            acc = mma32((hh ? Wl2 : Wl) + (32 * tb) * LDT, VT + (hh * 64 + 32 * eh) * LDT, 32 * (tb + 1), acc, lane);
#pragma unroll
            for (int reg = 0; reg < 16; ++reg) { const int t = 32 * tb + crow(reg, lane >> 5); const float sv = acc[reg] + bq[reg >> 2][reg & 3];
                YCAT[(size_t)(r0 + t) * DM + YC_YA + col] = (bf16)f2bf(bf2f(ur[reg]) * sv); }
        }
        __syncthreads();
    }
    M_RELAUNDER();
    {
        const int co = tid & 15, tq = tid >> 4, t0 = 4 * tq, ch = 128 * g + 8 * co; const float* cw = F.inp(I_CW) + l * 3 * 256 + ch;
        v4u ra[6], rh[6], rb[4];
#pragma unroll
        for (int i = 0; i < 6; ++i) { const int t = t0 - 2 + i;
            if (t >= 0 || c > 0) { ra[i] = *(const v4u*)(PROJ + (size_t)(r0 + t) * DING + C_CG + ch); rh[i] = *(const v4u*)(PROJ + (size_t)(r0 + t) * DING + C_HB + ch); }
            else { ra[i] = (v4u){0u, 0u, 0u, 0u}; rh[i] = (v4u){0u, 0u, 0u, 0u}; } }
#pragma unroll
        for (int tt = 0; tt < 4; ++tt) rb[tt] = *(const v4u*)(PROJ + (size_t)(r0 + t0 + tt) * DING + C_BG + ch);
        asm volatile("" ::: "memory");
        float w0[8], w1[8], w2[8];
        { const f32x4 a = *(const f32x4*)cw, bq = *(const f32x4*)(cw + 4); w0[0] = a.x; w0[1] = a.y; w0[2] = a.z; w0[3] = a.w; w0[4] = bq.x; w0[5] = bq.y; w0[6] = bq.z; w0[7] = bq.w; }
        { const f32x4 a = *(const f32x4*)(cw + 256), bq = *(const f32x4*)(cw + 260); w1[0] = a.x; w1[1] = a.y; w1[2] = a.z; w1[3] = a.w; w1[4] = bq.x; w1[5] = bq.y; w1[6] = bq.z; w1[7] = bq.w; }
        { const f32x4 a = *(const f32x4*)(cw + 512), bq = *(const f32x4*)(cw + 516); w2[0] = a.x; w2[1] = a.y; w2[2] = a.z; w2[3] = a.w; w2[4] = bq.x; w2[5] = bq.y; w2[6] = bq.z; w2[7] = bq.w; }
        float cin[6][8];
#pragma unroll
        for (int i = 0; i < 6; ++i) { float a[8], hb[8]; unpack8(ra[i], a); unpack8(rh[i], hb);
#pragma unroll
            for (int j = 0; j < 8; ++j) cin[i][j] = a[j] * hb[j]; }
#pragma unroll
        for (int tt = 0; tt < 4; ++tt) { float bg[8], yb[8]; unpack8(rb[tt], bg);
#pragma unroll
            for (int j = 0; j < 8; ++j) yb[j] = bg[j] * (w0[j] * cin[tt][j] + w1[j] * cin[tt + 1][j] + w2[j] * cin[tt + 2][j]);
            *(v4u*)(YCAT + (size_t)(r0 + t0 + tt) * DM + YC_YB + ch) = pack8(yb[0], yb[1], yb[2], yb[3], yb[4], yb[5], yb[6], yb[7]); }
        if (c == 15 && tq == 31) {
#pragma unroll
            for (int tt = 2; tt < 4; ++tt) { float* dst = F.out + O_CP + ((size_t)(l * NB + b) * 2 + (tt - 2)) * 256 + ch;
                *(f32x4*)dst = (f32x4){cin[tt + 2][0], cin[tt + 2][1], cin[tt + 2][2], cin[tt + 2][3]}; *(f32x4*)(dst + 4) = (f32x4){cin[tt + 2][4], cin[tt + 2][5], cin[tt + 2][6], cin[tt + 2][7]}; } }
    }
}

__device__ __forceinline__ void m2_scan_unit(const Frame& F, int l, int u) {
    const int bh = u >> 2, pq = u & 3, tid = F.tid, p = 16 * pq + (tid >> 5), n = 4 * (tid & 31);
    const bf16* SB = (const bf16*)(F.ws + WS_SBUF) + ((size_t)bh * 16 * 64 + p) * 128 + n; const float* CD = (const float*)(F.ws + WS_CD) + bh * 16;
    bf16* HB = (bf16*)(F.ws + WS_HB) + ((size_t)bh * 16 * 64 + p) * 128 + n;
    f32x4 S[16]; float cd[16];
#pragma unroll
    for (int c = 0; c < 16; ++c) { const v2u sw = *(const v2u*)(SB + (size_t)c * 8192); S[c] = (f32x4){bflo(sw.x), bfhi(sw.x), bflo(sw.y), bfhi(sw.y)}; cd[c] = CD[c]; }
    f32x4 H = (f32x4){0.f, 0.f, 0.f, 0.f};
#pragma unroll
    for (int c = 0; c < 16; ++c) {
        if (c > 0) { v2u o; o.x = pg8::cvt_pk_bf16(H.x, H.y); o.y = pg8::cvt_pk_bf16(H.z, H.w); *(v2u*)(HB + (size_t)c * 8192) = o; }
        H = H * cd[c] + S[c];
    }
    *(f32x4*)(F.out + O_SP + ((size_t)l * 64 + bh) * 8192 + p * 128 + n) = H;
}

__device__ __forceinline__ void ssd_sample_quad(const Frame& F, int l, int u0) {
    const int tid = F.tid, gq = tid >> 7, tl = tid & 127, p = tl >> 1, nh = tl & 1, u = u0 + gq, s = u >> 3, h = u & 7, g = h >> 2, r0 = s * DSEQ;
    LAS float* base = (LAS float*)F.lds + gq * 2688;
    LAS float* Xs = base;
    LAS float* Bs = Xs + 512;
    LAS float* Cs = Bs + 1024;
    LAS float* cbs = Cs + 1024;
    LAS float* sm = cbs + 64;
    const float* XBCS = (const float*)(F.ws + WS_XBCS); const float* DT = (const float*)(F.ws + WS_DT);
    const float* h0 = F.inp(I_SSM) + ((size_t)(l * NDB + s) * 8 + h) * 8192 + p * 128 + 64 * nh;
    __syncthreads();
    f32x4 H[16];
#pragma unroll
    for (int i = 0; i < 16; ++i) H[i] = *(const f32x4*)(h0 + 4 * i);
    f32x4 xv_, bv_[2], cv_[2]; float dv_[8];
    xv_ = *(const f32x4*)(XBCS + (size_t)(r0 + (tl >> 4)) * 1024 + h * 64 + 4 * (tl & 15));
#pragma unroll
    for (int j = 0; j < 2; ++j) { const int i = tl + 128 * j, t = i >> 5, q = i & 31;
        bv_[j] = *(const f32x4*)(XBCS + (size_t)(r0 + t) * 1024 + 512 + g * 128 + 4 * q); cv_[j] = *(const f32x4*)(XBCS + (size_t)(r0 + t) * 1024 + 768 + g * 128 + 4 * q); }
#pragma unroll
    for (int t2 = 0; t2 < 8; ++t2) dv_[t2] = DT[(size_t)(MP + r0 + t2) * 8 + h];
    const float A = -expf(F.inp(I_ALOG)[l * 8 + h]);
    asm volatile("" ::: "memory");
    *(LAS f32x4*)(Xs + 4 * tl) = xv_;
#pragma unroll
    for (int j = 0; j < 2; ++j) { const int i = tl + 128 * j; *(LAS f32x4*)(Bs + 4 * i) = bv_[j]; *(LAS f32x4*)(Cs + 4 * i) = cv_[j]; }
    if (tl < 8) {
        float cs = 0.f, c7 = 0.f, d = 0.f;
#pragma unroll
        for (int t2 = 0; t2 < 8; ++t2) { const float dd = dv_[t2]; c7 += dd * A; if (t2 <= tl) cs += dd * A; if (t2 == tl) d = dd; }
        sm[tl] = d; sm[8 + tl] = cs; sm[16 + tl] = __expf(cs); sm[24 + tl] = __expf(c7 - cs) * d;
    }
    __syncthreads();
    {
        const int t = p >> 3, s2 = p & 7; float a = 0.f;
#pragma unroll
        for (int i = 0; i < 16; ++i) { const f32x4 cv = *(const LAS f32x4*)(Cs + t * 128 + 64 * nh + 4 * i), bv = *(const LAS f32x4*)(Bs + s2 * 128 + 64 * nh + 4 * i); a += (cv.x * bv.x + cv.y * bv.y) + (cv.z * bv.z + cv.w * bv.w); }
        a += xswz<1>(a);
        if (nh == 0) cbs[p] = s2 <= t ? a * __expf(sm[8 + t] - sm[8 + s2]) * sm[s2] : 0.f;
    }
    __syncthreads();
    const float dsk = F.inp(I_DSK)[l * 8 + h];
    float* Yo = (float*)(F.ws + WS_YS) + (size_t)r0 * 512 + h * 64 + p;
#pragma unroll
    for (int t = 0; t < 8; ++t) {
        float a = 0.f;
#pragma unroll
        for (int i = 0; i < 16; ++i) { const f32x4 cv = *(const LAS f32x4*)(Cs + t * 128 + 64 * nh + 4 * i); a += (H[i].x * cv.x + H[i].y * cv.y) + (H[i].z * cv.z + H[i].w * cv.w); }
        a += xswz<1>(a);
        float y = a * sm[16 + t] + dsk * Xs[t * 64 + p];
#pragma unroll
        for (int s2 = 0; s2 <= t; ++s2) y += cbs[t * 8 + s2] * Xs[s2 * 64 + p];
        if ((t & 1) == nh) Yo[(size_t)t * 512] = y;
    }
    const float e7 = sm[16 + 7];
#pragma unroll
    for (int i = 0; i < 16; ++i) H[i] = H[i] * e7;
#pragma unroll
    for (int s2 = 0; s2 < 8; ++s2) { const float cx = sm[24 + s2] * Xs[s2 * 64 + p];
#pragma unroll
        for (int i = 0; i < 16; ++i) H[i] += *(const LAS f32x4*)(Bs + s2 * 128 + 64 * nh + 4 * i) * cx; }
    float* ho = F.out + O_SS + ((size_t)(l * NDB + s) * 8 + h) * 8192 + p * 128 + 64 * nh;
#pragma unroll
    for (int i = 0; i < 16; ++i) *(f32x4*)(ho + 4 * i) = H[i];
}

__device__ __forceinline__ void m2_combined(const Frame& F, int l, int us, int u0) {
    const int tid = F.tid, gq = tid >> 7, tl = tid & 127, p = tl >> 1, nh = tl & 1, u = u0 + gq, s = u >> 3, h = u & 7, g = h >> 2, r0 = s * DSEQ;
    LAS float* base = (LAS float*)F.lds + gq * 2688;
    LAS float* Xs = base;
    LAS float* Bs = Xs + 512;
    LAS float* Cs = Bs + 1024;
    LAS float* cbs = Cs + 1024;
    LAS float* sm = cbs + 64;
    const float* XBCS = (const float*)(F.ws + WS_XBCS); const float* DT = (const float*)(F.ws + WS_DT);
    const float* h0 = F.inp(I_SSM) + ((size_t)(l * NDB + s) * 8 + h) * 8192 + p * 128 + 64 * nh;
    __syncthreads();
    f32x4 H[16];
#pragma unroll
    for (int i = 0; i < 16; ++i) H[i] = *(const f32x4*)(h0 + 4 * i);
    f32x4 xv_, bv_[2], cv_[2]; float dv_[8];
    xv_ = *(const f32x4*)(XBCS + (size_t)(r0 + (tl >> 4)) * 1024 + h * 64 + 4 * (tl & 15));
#pragma unroll
    for (int j = 0; j < 2; ++j) { const int i = tl + 128 * j, t = i >> 5, q = i & 31;
        bv_[j] = *(const f32x4*)(XBCS + (size_t)(r0 + t) * 1024 + 512 + g * 128 + 4 * q); cv_[j] = *(const f32x4*)(XBCS + (size_t)(r0 + t) * 1024 + 768 + g * 128 + 4 * q); }
#pragma unroll
    for (int t2 = 0; t2 < 8; ++t2) dv_[t2] = DT[(size_t)(MP + r0 + t2) * 8 + h];
    const int bh_ = us >> 2, ps_ = 16 * (us & 3) + (tid >> 5), ns_ = 4 * (tid & 31);
    const bf16* SB_ = (const bf16*)(F.ws + WS_SBUF) + ((size_t)bh_ * 16 * 64 + ps_) * 128 + ns_; const float* CD_ = (const float*)(F.ws + WS_CD) + bh_ * 16;
    bf16* HB_ = (bf16*)(F.ws + WS_HB) + ((size_t)bh_ * 16 * 64 + ps_) * 128 + ns_;
    v2u S_[16]; float cd_[16];
#pragma unroll
    for (int c = 0; c < 16; ++c) { S_[c] = *(const v2u*)(SB_ + (size_t)c * 8192); cd_[c] = CD_[c]; }
    const float A = -expf(F.inp(I_ALOG)[l * 8 + h]);
    asm volatile("" ::: "memory");
    {
        f32x4 Hs = (f32x4){0.f, 0.f, 0.f, 0.f};
#pragma unroll
        for (int c = 0; c < 16; ++c) {
            if (c > 0) { v2u o; o.x = pg8::cvt_pk_bf16(Hs.x, Hs.y); o.y = pg8::cvt_pk_bf16(Hs.z, Hs.w); *(v2u*)(HB_ + (size_t)c * 8192) = o; }
            Hs = Hs * cd_[c] + (f32x4){bflo(S_[c].x), bfhi(S_[c].x), bflo(S_[c].y), bfhi(S_[c].y)};
        }
        *(f32x4*)(F.out + O_SP + ((size_t)l * 64 + bh_) * 8192 + ps_ * 128 + ns_) = Hs;
    }
    *(LAS f32x4*)(Xs + 4 * tl) = xv_;
#pragma unroll
    for (int j = 0; j < 2; ++j) { const int i = tl + 128 * j; *(LAS f32x4*)(Bs + 4 * i) = bv_[j]; *(LAS f32x4*)(Cs + 4 * i) = cv_[j]; }
    if (tl < 8) {
        float cs = 0.f, c7 = 0.f, d = 0.f;
#pragma unroll
        for (int t2 = 0; t2 < 8; ++t2) { const float dd = dv_[t2]; c7 += dd * A; if (t2 <= tl) cs += dd * A; if (t2 == tl) d = dd; }
        sm[tl] = d; sm[8 + tl] = cs; sm[16 + tl] = __expf(cs); sm[24 + tl] = __expf(c7 - cs) * d;
    }
    __syncthreads();
    {
        const int t = p >> 3, s2 = p & 7; float a = 0.f;
#pragma unroll
        for (int i = 0; i < 16; ++i) { const f32x4 cv = *(const LAS f32x4*)(Cs + t * 128 + 64 * nh + 4 * i), bv = *(const LAS f32x4*)(Bs + s2 * 128 + 64 * nh + 4 * i); a += (cv.x * bv.x + cv.y * bv.y) + (cv.z * bv.z + cv.w * bv.w); }
        a += xswz<1>(a);
        if (nh == 0) cbs[p] = s2 <= t ? a * __expf(sm[8 + t] - sm[8 + s2]) * sm[s2] : 0.f;
    }
    __syncthreads();
    const float dsk = F.inp(I_DSK)[l * 8 + h];
    float* Yo = (float*)(F.ws + WS_YS) + (size_t)r0 * 512 + h * 64 + p;
#pragma unroll
    for (int t = 0; t < 8; ++t) {
        float a = 0.f;
#pragma unroll
        for (int i = 0; i < 16; ++i) { const f32x4 cv = *(const LAS f32x4*)(Cs + t * 128 + 64 * nh + 4 * i); a += (H[i].x * cv.x + H[i].y * cv.y) + (H[i].z * cv.z + H[i].w * cv.w); }
        a += xswz<1>(a);
        float y = a * sm[16 + t] + dsk * Xs[t * 64 + p];
#pragma unroll
        for (int s2 = 0; s2 <= t; ++s2) y += cbs[t * 8 + s2] * Xs[s2 * 64 + p];
        if ((t & 1) == nh) Yo[(size_t)t * 512] = y;
    }
    const float e7 = sm[16 + 7];
#pragma unroll
    for (int i = 0; i < 16; ++i) H[i] = H[i] * e7;
#pragma unroll
    for (int s2 = 0; s2 < 8; ++s2) { const float cx = sm[24 + s2] * Xs[s2 * 64 + p];
#pragma unroll
        for (int i = 0; i < 16; ++i) H[i] += *(const LAS f32x4*)(Bs + s2 * 128 + 64 * nh + 4 * i) * cx; }
    float* ho = F.out + O_SS + ((size_t)(l * NDB + s) * 8 + h) * 8192 + p * 128 + 64 * nh;
#pragma unroll
    for (int i = 0; i < 16; ++i) *(f32x4*)(ho + 4 * i) = H[i];
}

typedef float f32x2_t __attribute__((ext_vector_type(2))); typedef __bf16 bf16x2_t __attribute__((ext_vector_type(2)));
__device__ __forceinline__ unsigned cvtpk_s(float lo, float hi) { const f32x2_t v = {lo, hi}; const bf16x2_t bb = __builtin_convertvector(v, bf16x2_t); return __builtin_bit_cast(unsigned, bb); }
__device__ __forceinline__ void m3_prompt_unit(const Frame& F, int l, int u) {
    const int g = u & 1, c = (u >> 1) & 15, b = u >> 5, r0 = b * SEQ + c * 128;
    int tid = F.tid, lane = F.lane, w = F.wave;
    LAS float* cumT = (LAS float*)F.lds;
    LAS float* dtT = cumT + 512;
    LAS float* sqp = dtT + 512;
    LAS bf16* Cm = (LAS bf16*)(F.lds + 8192);
    LAS bf16* Bm = Cm + 128 * LDT;
    LAS bf16* XT = Bm + 128 * LDT;
    const bf16* PROJ = (const bf16*)(F.ws + WS_PROJ); bf16* YCAT = (bf16*)(F.ws + WS_YCAT); const bf16* XBCB = (const bf16*)(F.ws + WS_XBCB);
    __syncthreads();
    { const int t = tid >> 2, hl = tid & 3; cumT[hl * 128 + t] = ((const float*)(F.ws + WS_CUM))[(size_t)(r0 + t) * 8 + 4 * g + hl]; dtT[hl * 128 + t] = ((const float*)(F.ws + WS_DT))[(size_t)(r0 + t) * 8 + 4 * g + hl]; }
    {
        v4u cbv[8];
#pragma unroll
        for (int j = 0; j < 8; ++j) { const int i = tid + 512 * j, which = i >> 11, row = (i >> 4) & 127, ck = i & 15; cbv[j] = *(const v4u*)(XBCB + (size_t)(r0 + row) * DM + (which ? 512 : 768) + 128 * g + 8 * ck); }
        const int po = tid & 31, t0 = 8 * (tid >> 5); v4u xr[8];
#pragma unroll
        for (int tt = 0; tt < 8; ++tt) xr[tt] = *(const v4u*)(XBCB + (size_t)(r0 + t0 + tt) * DM + 256 * g + 8 * po);
        asm volatile("" ::: "memory");
#pragma unroll
        for (int j = 0; j < 8; ++j) { const int i = tid + 512 * j, which = i >> 11, row = (i >> 4) & 127, ck = i & 15; *(LAS v4u*)((which ? Bm : Cm) + row * LDT + 8 * ck) = cbv[j]; }
#pragma unroll
        for (int j = 0; j < 8; ++j) { const unsigned sel = (j & 1) ? 0x07060302u : 0x05040100u; v4u o;
            o.x = __builtin_amdgcn_perm(xr[1][j >> 1], xr[0][j >> 1], sel); o.y = __builtin_amdgcn_perm(xr[3][j >> 1], xr[2][j >> 1], sel);
            o.z = __builtin_amdgcn_perm(xr[5][j >> 1], xr[4][j >> 1], sel); o.w = __builtin_amdgcn_perm(xr[7][j >> 1], xr[6][j >> 1], sel);
            *(LAS v4u*)(XT + (8 * po + j) * LDT + t0) = o; }
    }
    __syncthreads();
    M_RELAUNDER();
    const int hl = w & 3, th = w >> 2, h = 4 * g + hl, half = lane >> 5, l31 = lane & 31;
    const LAS float* cumh = cumT + hl * 128; const LAS float* dth = dtT + hl * 128;
    f32x16 y[2][2];
#pragma unroll
    for (int a = 0; a < 2; ++a)
#pragma unroll
        for (int q = 0; q < 2; ++q)
#pragma unroll
            for (int i = 0; i < 16; ++i) y[a][q][i] = 0.f;
    if (c > 0) {
        const bf16* hsrc = (const bf16*)(F.ws + WS_HB) + ((size_t)(b * 8 + h) * 16 + c) * 8192 + l31 * 128 + 8 * half;
#pragma unroll
        for (int k = 0; k < 128; k += 16) {
            const s16x8 hb0 = *(const s16x8*)(hsrc + k), hb1 = *(const s16x8*)(hsrc + 32 * 128 + k);
#pragma unroll
            for (int tbl = 0; tbl < 2; ++tbl) { const s16x8 ca = *(const LAS s16x8*)(Cm + (32 * (2 * th + tbl) + l31) * LDT + k + 8 * half);
                y[tbl][0] = __builtin_amdgcn_mfma_f32_32x32x16_bf16(ca, hb0, y[tbl][0], 0, 0, 0); y[tbl][1] = __builtin_amdgcn_mfma_f32_32x32x16_bf16(ca, hb1, y[tbl][1], 0, 0, 0); }
        }
#pragma unroll
        for (int tbl = 0; tbl < 2; ++tbl)
#pragma unroll
            for (int q4 = 0; q4 < 4; ++q4) { const f32x4 cv = *(const LAS f32x4*)(cumh + 32 * (2 * th + tbl) + 8 * q4 + 4 * half);
#pragma unroll
                for (int i = 0; i < 4; ++i) { const float e = __expf(cv[i]); y[tbl][0][4 * q4 + i] *= e; y[tbl][1][4 * q4 + i] *= e; } }
    }
#pragma unroll
    for (int tbl = 0; tbl < 2; ++tbl) {
        const int tb = 2 * th + tbl; const int t = 32 * tb + l31; const float ct = cumh[t];
#pragma unroll 1
        for (int sb = 0; sb <= tb; ++sb) {
            f32x16 x;
#pragma unroll
            for (int i = 0; i < 16; ++i) x[i] = 0.f;
            x = mma32(Bm + (32 * sb) * LDT, Cm + (32 * tb) * LDT, 128, x, lane);
#pragma unroll
            for (int q4 = 0; q4 < 4; ++q4) { const f32x4 cs = *(const LAS f32x4*)(cumh + 32 * sb + 8 * q4 + 4 * half), ds = *(const LAS f32x4*)(dth + 32 * sb + 8 * q4 + 4 * half);
#pragma unroll
                for (int i = 0; i < 4; ++i) { const int s = 32 * sb + 8 * q4 + 4 * half + i; x[4 * q4 + i] = s <= t ? x[4 * q4 + i] * __expf(ct - cs[i]) * ds[i] : 0.f; } }
#pragma unroll
            for (int sp = 0; sp < 2; ++sp) {
                v4u pa; pa.x = cvtpk_s(x[8 * sp], x[8 * sp + 1]); pa.y = cvtpk_s(x[8 * sp + 2], x[8 * sp + 3]); pa.z = cvtpk_s(x[8 * sp + 4], x[8 * sp + 5]); pa.w = cvtpk_s(x[8 * sp + 6], x[8 * sp + 7]);
                const s16x8 xa = __builtin_bit_cast(s16x8, pa);
#pragma unroll
                for (int q = 0; q < 2; ++q) { const LAS bf16* xp = XT + (hl * 64 + 32 * q + l31) * LDT + 32 * sb + 16 * sp + 4 * half;
                    const v2u lo = *(const LAS v2u*)xp, hi = *(const LAS v2u*)(xp + 8); const v4u pb = {lo.x, lo.y, hi.x, hi.y};
                    y[tbl][q] = __builtin_amdgcn_mfma_f32_32x32x16_bf16(xa, __builtin_bit_cast(s16x8, pb), y[tbl][q], 0, 0, 0); }
            }
        }
    }
    const float dsk = F.inp(I_DSK)[l * 8 + h];
#pragma unroll
    for (int tbl = 0; tbl < 2; ++tbl) { const int tb = 2 * th + tbl; float sq[16];
#pragma unroll
        for (int i = 0; i < 16; ++i) sq[i] = 0.f;
        unsigned zr[2][16];
#pragma unroll
        for (int q = 0; q < 2; ++q)
#pragma unroll
            for (int reg = 0; reg < 16; ++reg) zr[q][reg] = PROJ[(size_t)(r0 + 32 * tb + crow(reg, half)) * DING + C_Z + h * 64 + 32 * q + l31];
#pragma unroll
        for (int q = 0; q < 2; ++q) { const int p = 32 * q + l31, col = h * 64 + p;
#pragma unroll
            for (int reg = 0; reg < 16; ++reg) { const int t = 32 * tb + crow(reg, half);
                const float xv = bf2f(XT[(hl * 64 + p) * LDT + t]); const float yv = y[tbl][q][reg] + dsk * xv;
                const float z = bf2f(zr[q][reg]); const float gv = yv * silu_f(z);
                sq[reg] += gv * gv; YCAT[(size_t)(r0 + t) * DM + YC_YC + col] = (bf16)f2bf(gv); } }
#pragma unroll
        for (int reg = 0; reg < 16; ++reg) { float v = sq[reg]; v += xswz<1>(v); v += xswz<2>(v); v += xswz<4>(v); v += xswz<8>(v); v += xswz<16>(v);
            if (l31 == 0) sqp[hl * 128 + 32 * tb + crow(reg, half)] = v; }
    }
    __syncthreads();
    if (tid < 128) ((float*)(F.ws + WS_SSG))[(size_t)(r0 + tid) * 2 + g] = (sqp[tid] + sqp[128 + tid]) + (sqp[256 + tid] + sqp[384 + tid]);
}

__device__ __forceinline__ void conv_sample_phase(const Frame& F, int l) {
    const int gw = F.vcu * NWAVES + F.wave, NGW = F.G * NWAVES, lane = F.lane;
    const bf16* PROJ = (const bf16*)(F.ws + WS_PROJ); bf16* YCAT = (bf16*)(F.ws + WS_YCAT); float* XBCS = (float*)(F.ws + WS_XBCS);
    const float* cw = F.inp(I_CW) + l * 3 * 256; const float* scw = F.inp(I_SCW) + l * 4 * 1024; const float* scb = F.inp(I_SCB) + l * 1024;
    const int wi_ = (F.vcu & 31) * NWAVES + F.wave;
    for (int r = F.G == 256 ? MP + 128 * (F.vcu >> 5) + wi_ : MP + gw; F.G == 256 ? (wi_ < 128 && r < MP + 128 * (F.vcu >> 5) + 128) : r < M; r += F.G == 256 ? 1024 : NGW) {
        const int t = (r - MP) & 7, sidx = (r - MP) >> 3;
        {
            const int ch = 4 * lane; v2u cgr[3], hbr[3]; f32x4 str[3], w3[3];
#pragma unroll
            for (int k = 0; k < 3; ++k) { const int back = 2 - k, rp = (t - back >= 0) ? r - back : r, si = (t - back >= 0) ? 0 : 2 + t - back;
                cgr[k] = *(const v2u*)(PROJ + (size_t)rp * DING + C_CG + ch); hbr[k] = *(const v2u*)(PROJ + (size_t)rp * DING + C_HB + ch);
                str[k] = *(const f32x4*)(F.inp(I_SC) + ((size_t)(l * NDB + sidx) * 2 + si) * 256 + ch); w3[k] = *(const f32x4*)(cw + k * 256 + ch); }
            const v2u bg = *(const v2u*)(PROJ + (size_t)r * DING + C_BG + ch);
            asm volatile("" ::: "memory");
            float cin[3][4];
#pragma unroll
            for (int k = 0; k < 3; ++k) { const bool own = t - (2 - k) >= 0;
                cin[k][0] = own ? bflo(cgr[k].x) * bflo(hbr[k].x) : str[k].x; cin[k][1] = own ? bfhi(cgr[k].x) * bfhi(hbr[k].x) : str[k].y;
                cin[k][2] = own ? bflo(cgr[k].y) * bflo(hbr[k].y) : str[k].z; cin[k][3] = own ? bfhi(cgr[k].y) * bfhi(hbr[k].y) : str[k].w; }
            const float bgf[4] = {bflo(bg.x), bfhi(bg.x), bflo(bg.y), bfhi(bg.y)}; float yb[4];
#pragma unroll
            for (int j = 0; j < 4; ++j) yb[j] = bgf[j] * (w3[0][j] * cin[0][j] + w3[1][j] * cin[1][j] + w3[2][j] * cin[2][j]);
            v2u wv; wv.x = pk2(yb[0], yb[1]); wv.y = pk2(yb[2], yb[3]); *(v2u*)(YCAT + (size_t)r * DM + YC_YB + ch) = wv;
            if (t >= DSEQ - 2) { float* dst = F.out + O_CS + ((size_t)(l * NDB + sidx) * 2 + (t - (DSEQ - 2))) * 256; *(f32x4*)(dst + ch) = (f32x4){cin[2][0], cin[2][1], cin[2][2], cin[2][3]}; }
        }
        {
            v2u xr[4][4]; f32x4 str[4][4], w4[4][4], bq[4];
#pragma unroll
            for (int jg = 0; jg < 4; ++jg) { const int ch = jg * 256 + 4 * lane; bq[jg] = *(const f32x4*)(scb + ch);
#pragma unroll
                for (int k = 0; k < 4; ++k) { const int back = 3 - k, rp = (t - back >= 0) ? r - back : r, si = (t - back >= 0) ? 0 : 3 + t - back;
                    xr[jg][k] = *(const v2u*)(PROJ + (size_t)rp * DING + C_XBC + ch); str[jg][k] = *(const f32x4*)(F.inp(I_SSC) + ((size_t)(l * NDB + sidx) * 3 + si) * 1024 + ch);
                    w4[jg][k] = *(const f32x4*)(scw + k * 1024 + ch); } }
            asm volatile("" ::: "memory");
#pragma unroll
            for (int jg = 0; jg < 4; ++jg) { const int ch = jg * 256 + 4 * lane; float xv[4][4];
#pragma unroll
                for (int k = 0; k < 4; ++k) { const bool own = t - (3 - k) >= 0;
                    xv[k][0] = own ? bflo(xr[jg][k].x) : str[jg][k].x; xv[k][1] = own ? bfhi(xr[jg][k].x) : str[jg][k].y; xv[k][2] = own ? bflo(xr[jg][k].y) : str[jg][k].z; xv[k][3] = own ? bfhi(xr[jg][k].y) : str[jg][k].w; }
                f32x4 o;
#pragma unroll
                for (int j = 0; j < 4; ++j) { const float v = bq[jg][j] + w4[jg][0][j] * xv[0][j] + w4[jg][1][j] * xv[1][j] + w4[jg][2][j] * xv[2][j] + w4[jg][3][j] * xv[3][j]; o[j] = silu_f(v); }
                *(f32x4*)(XBCS + (size_t)(r - MP) * 1024 + ch) = o;
                if (t >= DSEQ - 3) { float* dst = F.out + O_SCS + ((size_t)(l * NDB + sidx) * 3 + (t - (DSEQ - 3))) * 1024; *(f32x4*)(dst + ch) = (f32x4){xv[3][0], xv[3][1], xv[3][2], xv[3][3]}; } }
        }
    }
}
__device__ __forceinline__ void mixa_sample_phase(const Frame& F, int l) {
    LAS bf16* Vs = (LAS bf16*)F.lds;
    LAS float* Wsl = (LAS float*)(F.lds + 4096);
    LAS float* Bsl = Wsl + 256;
    const bf16* PROJ = (const bf16*)(F.ws + WS_PROJ); bf16* YCAT = (bf16*)(F.ws + WS_YCAT);
    const int tid = F.tid;
    for (int u = F.G == 256 ? ((F.vcu & 31) < 16 ? 16 * (F.vcu >> 5) + (F.vcu & 31) : NDB) : F.vcu; u < NDB; u += F.G) {
        const int r0 = MP + u * 8;
        __syncthreads();
        {
            v4u vv = (v4u){0u, 0u, 0u, 0u}; float wq = 0.f, bq = 0.f; unsigned ur[8];
            if (tid < 256) vv = *(const v4u*)(PROJ + (size_t)(r0 + (tid >> 5)) * DING + C_V + (tid & 31) * 8);
            else { const int i = tid - 256, hh = i >> 6, tt = (i >> 3) & 7, s2 = i & 7; wq = F.inp(I_WS)[((size_t)(l * 4 + hh) * 128 + tt) * 128 + s2]; }
            if (tid < 32) bq = F.inp(I_BS)[(l * 4 + (tid >> 3)) * 128 + (tid & 7)];
            const int col = tid & 255;
#pragma unroll
            for (int t = 0; t < 8; ++t) ur[t] = PROJ[(size_t)(r0 + t) * DING + C_U + col];
            asm volatile("" ::: "memory");
            if (tid < 256) *(LAS v4u*)(Vs + (tid >> 5) * 256 + (tid & 31) * 8) = vv; else Wsl[tid - 256] = wq;
            if (tid < 32) Bsl[tid] = bq;
            __syncthreads();
            if (tid < 256) { const int h = col >> 6; float vcol[8];
#pragma unroll
                for (int t = 0; t < 8; ++t) vcol[t] = bf2f(Vs[t * 256 + col]);
#pragma unroll
                for (int t = 0; t < 8; ++t) { float acc = Bsl[h * 8 + t];
#pragma unroll
                    for (int s2 = 0; s2 <= t; ++s2) acc += Wsl[(h * 8 + t) * 8 + s2] * vcol[s2];
                    YCAT[(size_t)(r0 + t) * DM + YC_YA + col] = (bf16)f2bf(bf2f(ur[t]) * acc); } }
        }
        float* dst = F.out + O_CVS + (size_t)(l * NDB + u) * 8 * 256; for (int i = tid; i < 8 * 256; i += NWAVES * 64) dst[i] = bf2f(Vs[i]);
    }
}
__device__ __forceinline__ void gnorm_sample_phase(const Frame& F, int l) {
    const int gw = F.vcu * NWAVES + F.wave, NGW = F.G * NWAVES, lane = F.lane;
    const bf16* PROJ = (const bf16*)(F.ws + WS_PROJ); bf16* YCAT = (bf16*)(F.ws + WS_YCAT); const float* Y = (const float*)(F.ws + WS_YS);
    const int wi_ = (F.vcu & 31) * NWAVES + F.wave;
    for (int r = F.G == 256 ? MP + 128 * (F.vcu >> 5) + wi_ : MP + gw; F.G == 256 ? (wi_ < 128 && r < MP + 128 * (F.vcu >> 5) + 128) : r < M; r += F.G == 256 ? 1024 : NGW) {
        const f32x4 y0 = *(const f32x4*)(Y + (size_t)(r - MP) * 512 + 8 * lane), y1 = *(const f32x4*)(Y + (size_t)(r - MP) * 512 + 8 * lane + 4);
        float z[8]; unpack8(*(const v4u*)(PROJ + (size_t)r * DING + C_Z + 8 * lane), z);
        float gv[8] = {y0.x * silu_f(z[0]), y0.y * silu_f(z[1]), y0.z * silu_f(z[2]), y0.w * silu_f(z[3]), y1.x * silu_f(z[4]), y1.y * silu_f(z[5]), y1.z * silu_f(z[6]), y1.w * silu_f(z[7])};
        float s = 0.f;
#pragma unroll
        for (int j = 0; j < 8; ++j) s += gv[j] * gv[j];
        s = wave_sum(s);
        *(v4u*)(YCAT + (size_t)r * DM + YC_YC + 8 * lane) = pack8(gv[0], gv[1], gv[2], gv[3], gv[4], gv[5], gv[6], gv[7]);
        if (lane < 2) ((float*)(F.ws + WS_SSG))[(size_t)r * 2 + lane] = lane == 0 ? s : 0.f;
    }
}
__device__ __forceinline__ void final_phase(const Frame& F) {
    const int gw = F.vcu * NWAVES + F.wave, NGW = F.G * NWAVES, lane = F.lane;
    const f32x4* gp = (const f32x4*)F.inp(I_FN) + 2 * lane;
    f32x4 gv[2][2];
#pragma unroll
    for (int j = 0; j < 2; ++j) { gv[j][0] = gp[128 * j]; gv[j][1] = gp[128 * j + 1]; }
    const bf16* XB = (const bf16*)(F.ws + WS_XB);
    const int wi_ = (F.vcu & 31) * NWAVES + F.wave, xs_ = F.vcu >> 5;
    for (int gi = F.G == 256 ? wi_ : gw; gi < (F.G == 256 ? 544 : M / 4); gi += F.G == 256 ? 256 : NGW) {
        const int r4 = F.G == 256 ? (gi < 512 ? 2048 * xs_ + 4 * gi : MP + 128 * xs_ + 4 * (gi - 512)) : 4 * gi;
        v4u v[4][2];
#pragma unroll
        for (int q = 0; q < 4; ++q) { const v4u* xr = (const v4u*)(XB + (size_t)(r4 + q) * DM) + lane;
#pragma unroll
            for (int j = 0; j < 2; ++j) v[q][j] = xr[64 * j]; }
#pragma unroll
        for (int q = 0; q < 4; ++q) { float s = 0.f; f32x4* yr = (f32x4*)(F.out + (size_t)(r4 + q) * DM) + 2 * lane; f32x4 x[2][2];
#pragma unroll
            for (int j = 0; j < 2; ++j) { pg8::unpk8(v[q][j], x[j][0], x[j][1]);
#pragma unroll
                for (int h = 0; h < 2; ++h) s += (x[j][h].x * x[j][h].x + x[j][h].y * x[j][h].y) + (x[j][h].z * x[j][h].z + x[j][h].w * x[j][h].w); }
            s = wave_sum(s); const float rsd = 1.0f / sqrtf(s * (1.0f / DM) + EPS);
#pragma unroll
            for (int j = 0; j < 2; ++j) { yr[128 * j] = x[j][0] * rsd * gv[j][0]; yr[128 * j + 1] = x[j][1] * rsd * gv[j][1]; } }
    }
}

constexpr int PH_PER_LAYER = 7, N_PHASES = 1 + DEPTH * PH_PER_LAYER + 1;
__global__ void __launch_bounds__(NWAVES * 64, 2) mega(Args args) {
    extern __shared__ __attribute__((aligned(16))) unsigned char lds[];
    Frame F;
    F.lds = (LAS unsigned char*)lds;
    F.tid = threadIdx.x; F.lane = F.tid & 63; F.wave = __builtin_amdgcn_readfirstlane(F.tid >> 6);
    F.G = gridDim.x; { const int bx = blockIdx.x; F.vcu = (F.G % 8 == 0) ? (bx % 8) * (F.G / 8) + bx / 8 : bx; }
    const __attribute__((address_space(4))) Args* ap0 = (const __attribute__((address_space(4))) Args*)__builtin_amdgcn_kernarg_segment_ptr();
    F.ap = ap0; F.out = args.out; F.ws = args.ws;
    volatile LAS unsigned* MISC = (volatile LAS unsigned*)(F.lds + MISC_OFF);
    for (int u = F.tid; u < (LDS_BYTES - LDSCTL_OFF) / 4; u += NWAVES * 64) ((LAS unsigned*)(F.lds + LDSCTL_OFF))[u] = 0u;
    __syncthreads();
    const int wave_s = __builtin_amdgcn_readfirstlane(threadIdx.x >> 6);
    const bool multi = args.ph_hi - args.ph_lo > 1;
    XcdBarrier bar; bar.bar = (unsigned*)(F.ws + WS_CTL) + CW_BAR; bar.x = 0; bar.st = nullptr; bool even = false; unsigned ev_s = 0u, tk_s = 0u;
    if (multi) {
        bar = xcd_barrier_post((unsigned*)(F.ws + WS_CTL) + CW_BAR, MISC + 8);
        if (threadIdx.x == 0) { unsigned nloc_, nx_, ev_; xcd_barrier_complete(bar.bar, bar.x, nloc_, nx_, ev_); bar.st[0] = nloc_; bar.st[1] = nx_; bar.st[3] = ev_; }
        __syncthreads();
        ev_s = __builtin_amdgcn_readfirstlane(MISC[11]); tk_s = __builtin_amdgcn_readfirstlane(MISC[10]);
    }

#define PH_TID() do { int wv_ = wave_s; LAUNDER_S(wv_); unsigned z_ = 0u; LAUNDER_S(z_); int t_ = wv_ * 64 + (int)__builtin_amdgcn_mbcnt_hi(~0u, __builtin_amdgcn_mbcnt_lo(~0u, z_)); LAUNDER_V(t_); F.tid = t_; F.lane = t_ & 63; F.wave = wv_; } while (0)
    for (int ph = args.ph_lo; ph < args.ph_hi; ++ph) {
        {
            const __attribute__((address_space(4))) Args* q = ap0; asm volatile("" : "+s"(q)); F.ap = q; F.out = q->out; F.ws = q->ws;
            int bx = blockIdx.x; asm volatile("" : "+s"(bx));
            even = multi && ev_s == 1u;
            if (even) bx = (int)((tk_s - 1u) * 8u + bar.x);
            F.bid = bx; F.vcu = (F.G % 8 == 0) ? (bx % 8) * (F.G / 8) + bx / 8 : bx;
            bar.bar = (unsigned*)(F.ws + WS_CTL) + CW_BAR;
        }
        if (ph == 0) {
            if (!even) { PH_TID(); p0_prologue(F, 0); }
            else {
                PH_TID(); p0_prologue(F, 3);
                xcd_barrier(bar, false);
                constexpr int I_IN_ = (DM / 64) * (DING / 32), I_ALL_ = DEPTH * ((DM / 64) * (DING / 32) + (DM / 64) * (DM / 32) + (DM / 64) * (FF / 32) + (FF / 64) * (DM / 32)), R_ = I_ALL_ - I_IN_;
                const int xx_ = (int)bar.x; int c0_ = 0, c1_ = 0, ct_ = 0;
#pragma unroll
                for (int j = 0; j < 8; ++j) { const int w_ = CVT_SHARE(j); if (j < xx_) c0_ += w_; if (j <= xx_) c1_ += w_; ct_ += w_; }
                const int blo_ = I_IN_ + (int)((long)R_ * c0_ / ct_), bhi_ = I_IN_ + (int)((long)R_ * c1_ / ct_);
                PH_TID(); p0_prologue(F, 4, blo_, bhi_);
            }
        }
        else if (ph == N_PHASES - 1) { PH_TID(); final_phase(F); }
        else {
            const int l = (ph - 1) / PH_PER_LAYER, s = (ph - 1) % PH_PER_LAYER;
#ifndef PROBE_S
#define PROBE_S -1
#endif
            for (int rep = 0; rep < ((s == PROBE_S) ? 2 : 1); ++rep) {
            bf16* XB = (bf16*)(F.ws + WS_XB); float* SS1 = (float*)(F.ws + WS_SS1); float* SS2 = (float*)(F.ws + WS_SS2); float* SSX1 = (float*)(F.ws + WS_SSX1); float* SSX2 = (float*)(F.ws + WS_SSX2);
            if (s == 0) {
                PH_TID();
                { pg8::GemmX g{XB, XB + (size_t)MP * DM, (const bf16*)(F.ws + WS_WIN) + (size_t)l * DING * DM, DM}; pg8::StaticOrder S; S.init(MP, DING, F.G, F.bid);
                  pg8::EpiScaleActX<0> E{(bf16*)(F.ws + WS_PROJ), (bf16*)(F.ws + WS_PROJ) + (size_t)MP * DING, DING, SS1, SSX1, 2};
                  pg8::gemm_phase_x<pg8::EpiScaleActX<0>, pg8::StaticOrder>(F.lds, g, S, E, F.tid); }
                PH_TID();
                { pg8::SEpiDt Ed{(float*)(F.ws + WS_DT), SS1, F.inp(I_DTB) + l * 8, (const float*)(F.ws + WS_SSX1)};
                  pg8::small_gemm_phase<64, pg8::SEpiDt>(F.lds, XB, (const bf16*)(F.ws + WS_WDTB) + (size_t)l * 64 * DM, DM, 1, MP / 64, F.vcu, F.G, Ed, F.tid);
                  if (F.G == 256) { if ((F.vcu & 31) < 2) { PH_TID(); const int us_ = MP / 64 + 2 * (F.vcu >> 5) + (F.vcu & 31);
                      pg8::small_gemm_phase<64, pg8::SEpiDt>(F.lds, XB, (const bf16*)(F.ws + WS_WDTB) + (size_t)l * 64 * DM, DM, 1, us_ + 1, us_, 1, Ed, F.tid); } }
                  else { PH_TID(); pg8::small_gemm_phase<64, pg8::SEpiDt>(F.lds, XB, (const bf16*)(F.ws + WS_WDTB) + (size_t)l * 64 * DM, DM, 1, M / 64, MP / 64 + F.vcu, F.G, Ed, F.tid); } }
            } else if (s == 1) {
                PH_TID();
                for (int u = F.vcu; u < 256; u += F.G) m1_prompt_unit(F, l, u);
                PH_TID(); conv_sample_phase(F, l); PH_TID(); mixa_sample_phase(F, l);
            } else if (s == 2) {
                PH_TID();
                if (F.G == 256) m2_combined(F, l, F.vcu, 4 * F.vcu);
                else { for (int u = F.vcu; u < 256; u += F.G) m2_scan_unit(F, l, u);
                    PH_TID();
                    for (int u = 4 * F.vcu; u < NDB * 8; u += 4 * F.G) ssd_sample_quad(F, l, u); }
            } else if (s == 3) {
                PH_TID();
                for (int u = F.vcu; u < 256; u += F.G) m3_prompt_unit(F, l, u);
                PH_TID(); gnorm_sample_phase(F, l);
            } else if (s == 4) {
                PH_TID();
                { pg8::GemmX g{(const bf16*)(F.ws + WS_YCAT), (const bf16*)(F.ws + WS_YCAT) + (size_t)MP * DM, (const bf16*)(F.ws + WS_WOUT) + (size_t)l * DM * DM, DM}; pg8::StaticOrder S; S.init(MP, DM, F.G, F.bid);
                  pg8::EpiResX<true> E{XB, SS2, SSX2, (const float*)(F.ws + WS_SSG)};
                  pg8::gemm_phase_x<pg8::EpiResX<true>, pg8::StaticOrder>(F.lds, g, S, E, F.tid); }
            } else if (s == 5) {
                PH_TID();
                { pg8::GemmX g{XB, XB + (size_t)MP * DM, (const bf16*)(F.ws + WS_W1) + (size_t)l * FF * DM, DM}; pg8::StaticOrder S; S.init(MP, FF, F.G, F.bid);
                  pg8::EpiScaleActX<1> E{(bf16*)(F.ws + WS_HID), (bf16*)(F.ws + WS_HID) + (size_t)MP * FF, FF, SS2, SSX2, 0};
                  pg8::gemm_phase_x<pg8::EpiScaleActX<1>, pg8::StaticOrder>(F.lds, g, S, E, F.tid); }
            } else {
                PH_TID();
                { pg8::GemmX g{(const bf16*)(F.ws + WS_HID), (const bf16*)(F.ws + WS_HID) + (size_t)MP * FF, (const bf16*)(F.ws + WS_W2) + (size_t)l * DM * FF, FF}; pg8::StaticOrder S; S.init(MP, DM, F.G, F.bid);
                  pg8::EpiResX<false> E{XB, SS1, SSX1, nullptr};
                  pg8::gemm_phase_x<pg8::EpiResX<false>, pg8::StaticOrder>(F.lds, g, S, E, F.tid); }
            }
            }
        }
        if (ph + 1 < args.ph_hi) {
            if (!even) xcd_barrier(bar, false);
            else xcd_barrier(bar, true, -1, bar.bar + XB_HTOP(0) + 64, ph == 4 ? 1u : 0u, ph == 0);
        }
    }
}

extern "C" void kernel_launch(void* const* d_in, const int* in_sizes, int n_in, void* d_out, int out_size, void* d_ws, size_t ws_size, hipStream_t stream) {
    static int grid = 0;
    if (grid == 0) {
        if (n_in != N_IN || (size_t)out_size != O_END || ws_size < WS_END) { fprintf(stderr, "kernel_launch: unexpected sizes n_in %d out %d ws %zu (need %zu)\n", n_in, out_size, ws_size, (size_t)WS_END); grid = -1; return; }
        int dev = 0, cus = 0;
        if (hipGetDevice(&dev) != hipSuccess || hipDeviceGetAttribute(&cus, hipDeviceAttributeMultiprocessorCount, dev) != hipSuccess) { grid = -1; return; }
        if (hipFuncSetAttribute((const void*)mega, hipFuncAttributeMaxDynamicSharedMemorySize, LDS_BYTES) != hipSuccess) { fprintf(stderr, "kernel_launch: hipFuncSetAttribute failed\n"); grid = -1; return; }
        (void)hipGetLastError();
        grid = cus;
    }
    if (grid < 0) return;
    if (hipMemsetAsync((char*)d_ws + WS_CTL, 0, CTL_ZERO_BYTES, stream) != hipSuccess) return;
    Args a{};
    for (int i = 0; i < N_IN; ++i) a.in[i] = (const float*)d_in[i];
    a.out = (float*)d_out; a.ws = (unsigned char*)d_ws;
#if MK_ONE_LAUNCH
    a.ph_lo = 0; a.ph_hi = N_PHASES;
    hipLaunchKernelGGL(mega, dim3(grid), dim3(NWAVES * 64), LDS_BYTES, stream, a);
#else
    for (int ph = 0; ph < N_PHASES; ++ph) { a.ph_lo = ph; a.ph_hi = ph + 1; hipLaunchKernelGGL(mega, dim3(grid), dim3(NWAVES * 64), LDS_BYTES, stream, a); }
#endif
}
```

```cpp
#include <hip/hip_runtime.h>
#include <cstdio>
#include <cstdint>

#ifndef MK_ONE_LAUNCH
#define MK_ONE_LAUNCH 1
#endif


template <int K> __device__ __forceinline__ float xswz(float v) { return __builtin_bit_cast(float, __builtin_amdgcn_ds_swizzle(__builtin_bit_cast(int, v), (K << 10) | 0x1f)); }
__device__ __forceinline__ float sum_halves(float v) {
    const unsigned b = __builtin_bit_cast(unsigned, v); unsigned b2 = b; asm volatile("" : "+v"(b2));
    auto r = __builtin_amdgcn_permlane32_swap(b, b2, false, false); unsigned r0 = r[0], r1 = r[1]; asm volatile("" : "+v"(r0), "+v"(r1));
    return __builtin_bit_cast(float, r0) + __builtin_bit_cast(float, r1);
}
__device__ __forceinline__ float softplus_f(float v) {
    const float e = __expf(-fabsf(v));
    const float lg = e < 0.03125f ? e * (1.0f - e * (0.5f - e * (0.33333334f - 0.25f * e))) : __logf(1.0f + e);
    return fmaxf(v, 0.f) + lg;
}

namespace pg8 {
#define PG8_LAS __attribute__((address_space(3)))
typedef unsigned short bf16_t;
typedef short bf16x8 __attribute__((ext_vector_type(8)));
typedef float f32x4 __attribute__((ext_vector_type(4)));
typedef float f32x2 __attribute__((ext_vector_type(2)));
typedef unsigned u32x4 __attribute__((ext_vector_type(4)));
constexpr int BM = 256, BK = 64, HALF = 128, HTB = HALF * BK * 2, STAGE_BYTES = 8 * HTB, NXCD = 8, WGM = 8;

__host__ __device__ __forceinline__ int lds_byte(int r, int c) { const int st = (r >> 4) * 2 + (c >> 5), rr = r & 15, cc = c & 31, ob = rr * 64 + cc * 2; return st * 1024 + (ob ^ (((ob >> 9) & 1) << 5)); }
__host__ __device__ __forceinline__ void stage_rc(int b, int& R, int& C) { const int st = b / 1024, sb = b % 1024, swz = sb ^ (((sb >> 9) & 1) << 5); R = (st >> 1) * 16 + swz / 64; C = (st & 1) * 32 + (swz % 64) / 2; }
__host__ __device__ __forceinline__ int perm32(int rho) { const int n = rho >> 4, i = rho & 15; return 8 * (i >> 2) + 4 * n + (i & 3); }

struct Unit { int pm, pn; };
struct Gemm { const bf16_t* A; const bf16_t* Bt; int M, N, K; };

struct StaticOrder {
    int nM, nN, nwg, G, c;
    __host__ __device__ void init(int M, int N, int G_, int c_) { nM = M / BM; nN = N / BM; nwg = nM * nN; G = G_; c = c_; }
    __host__ __device__ bool next(int i, Unit& u) const {
        const long L = (long)i * G + c; if (L >= nwg) return false;
        int wgid = (int)L; { const int q = nwg / NXCD, r = nwg % NXCD, xcd = wgid % NXCD, off = wgid / NXCD; wgid = (xcd < r ? xcd * (q + 1) : r * (q + 1) + (xcd - r) * q) + off; }
        const int nig = WGM * nN, gid = wgid / nig, fm = gid * WGM, gsz = (nM - fm) < WGM ? (nM - fm) : WGM;
        u.pm = fm + ((wgid % nig) % gsz); u.pn = (wgid % nig) / gsz; return true;
    }
    __device__ __forceinline__ void a_ready(const Unit&) const {}
    __device__ __forceinline__ void done(const Unit&) const {}
};

__device__ __forceinline__ unsigned cvt_pk_bf16(float lo, float hi) { unsigned r; asm volatile("v_cvt_pk_bf16_f32 %0, %1, %2" : "=v"(r) : "v"(lo), "v"(hi)); return r; }
__device__ __forceinline__ f32x2 gelu_pk(f32x2 v) {
    const f32x2 av = __builtin_elementwise_abs(v), d = av * 0.2316418882f + 1.0f;
    f32x2 t; t.x = __builtin_amdgcn_rcpf(d.x); t.y = __builtin_amdgcn_rcpf(d.y);
    f32x2 q = t * 0.5307027145f + (-0.7265760135f); q = q * t + 0.7107068705f; q = q * t + (-0.142248368f); q = q * t + 0.127414796f; q = q * t;
    const f32x2 s = (v * v) * (-0.72134752044f);
    f32x2 e; e.x = __builtin_amdgcn_exp2f(s.x); e.y = __builtin_amdgcn_exp2f(s.y);
    const f32x2 m = v * (q * e), r = v - m;
    f32x2 o; o.x = v.x < 0.f ? m.x : r.x; o.y = v.y < 0.f ? m.y : r.y; return o;
}

__device__ __forceinline__ const void* uni_ptr(const void* p) {
    const unsigned long long v = (unsigned long long)p; const unsigned lo = __builtin_amdgcn_readfirstlane((unsigned)v), hi = __builtin_amdgcn_readfirstlane((unsigned)(v >> 32));
    return (const void*)(((unsigned long long)hi << 32) | lo);
}
__device__ __forceinline__ void ld1_b128(f32x4& d, const void* sb, unsigned vo) {
    asm volatile("s_nop 4\n\tglobal_load_dwordx4 %0, %1, %2\n\ts_waitcnt vmcnt(0)" : "=&v"(d) : "v"(vo), "s"(uni_ptr(sb)) : "memory"); }
__device__ __forceinline__ void ld1_b64(f32x2& d, const void* sb, unsigned vo) {
    asm volatile("s_nop 4\n\tglobal_load_dwordx2 %0, %1, %2\n\ts_waitcnt vmcnt(0)" : "=&v"(d) : "v"(vo), "s"(uni_ptr(sb)) : "memory"); }
__device__ __forceinline__ void ld2_b128(f32x4& d0, f32x4& d1, const void* sb, unsigned vo) {
    asm volatile("s_nop 4\n\tglobal_load_dwordx4 %0, %2, %3\n\tglobal_load_dwordx4 %1, %2, %3 offset:16\n\ts_waitcnt vmcnt(0)" : "=&v"(d0), "=&v"(d1) : "v"(vo), "s"(uni_ptr(sb)) : "memory"); }
__device__ __forceinline__ void ld4_b128(f32x4 (&d)[4], const void* sb, const unsigned (&vo)[4]) {
    asm volatile("s_nop 4\n\tglobal_load_dwordx4 %0, %4, %8\n\tglobal_load_dwordx4 %1, %5, %8\n\tglobal_load_dwordx4 %2, %6, %8\n\tglobal_load_dwordx4 %3, %7, %8\n\ts_waitcnt vmcnt(0)"
        : "=&v"(d[0]), "=&v"(d[1]), "=&v"(d[2]), "=&v"(d[3]) : "v"(vo[0]), "v"(vo[1]), "v"(vo[2]), "v"(vo[3]), "s"(uni_ptr(sb)) : "memory"); }
__device__ __forceinline__ void ld8_b128(f32x4 (&d)[8], const void* sb, const unsigned (&vo)[8]) {
    asm volatile("s_nop 4\n\tglobal_load_dwordx4 %0, %8, %16\n\tglobal_load_dwordx4 %1, %9, %16\n\tglobal_load_dwordx4 %2, %10, %16\n\tglobal_load_dwordx4 %3, %11, %16\n\t"
                 "global_load_dwordx4 %4, %12, %16\n\tglobal_load_dwordx4 %5, %13, %16\n\tglobal_load_dwordx4 %6, %14, %16\n\tglobal_load_dwordx4 %7, %15, %16\n\ts_waitcnt vmcnt(0)"
        : "=&v"(d[0]), "=&v"(d[1]), "=&v"(d[2]), "=&v"(d[3]), "=&v"(d[4]), "=&v"(d[5]), "=&v"(d[6]), "=&v"(d[7])
        : "v"(vo[0]), "v"(vo[1]), "v"(vo[2]), "v"(vo[3]), "v"(vo[4]), "v"(vo[5]), "v"(vo[6]), "v"(vo[7]), "s"(uni_ptr(sb)) : "memory"); }
__device__ __forceinline__ void ld8_b64(f32x2 (&d)[8], const void* sb, const unsigned (&vo)[8]) {
    asm volatile("s_nop 4\n\tglobal_load_dwordx2 %0, %8, %16\n\tglobal_load_dwordx2 %1, %9, %16\n\tglobal_load_dwordx2 %2, %10, %16\n\tglobal_load_dwordx2 %3, %11, %16\n\t"
                 "global_load_dwordx2 %4, %12, %16\n\tglobal_load_dwordx2 %5, %13, %16\n\tglobal_load_dwordx2 %6, %14, %16\n\tglobal_load_dwordx2 %7, %15, %16\n\ts_waitcnt vmcnt(0)"
        : "=&v"(d[0]), "=&v"(d[1]), "=&v"(d[2]), "=&v"(d[3]), "=&v"(d[4]), "=&v"(d[5]), "=&v"(d[6]), "=&v"(d[7])
        : "v"(vo[0]), "v"(vo[1]), "v"(vo[2]), "v"(vo[3]), "v"(vo[4]), "v"(vo[5]), "v"(vo[6]), "v"(vo[7]), "s"(uni_ptr(sb)) : "memory"); }
__device__ __forceinline__ void ld16_res(f32x4 (&d)[16], const void* sb, const unsigned (&vo)[4]) {
    asm volatile("s_nop 4\n\t"
        "global_load_dwordx4 %0, %16, %20\n\tglobal_load_dwordx4 %1, %16, %20 offset:16\n\tglobal_load_dwordx4 %2, %16, %20 offset:512\n\tglobal_load_dwordx4 %3, %16, %20 offset:528\n\t"
        "global_load_dwordx4 %4, %17, %20\n\tglobal_load_dwordx4 %5, %17, %20 offset:16\n\tglobal_load_dwordx4 %6, %17, %20 offset:512\n\tglobal_load_dwordx4 %7, %17, %20 offset:528\n\t"
        "global_load_dwordx4 %8, %18, %20\n\tglobal_load_dwordx4 %9, %18, %20 offset:16\n\tglobal_load_dwordx4 %10, %18, %20 offset:512\n\tglobal_load_dwordx4 %11, %18, %20 offset:528\n\t"
        "global_load_dwordx4 %12, %19, %20\n\tglobal_load_dwordx4 %13, %19, %20 offset:16\n\tglobal_load_dwordx4 %14, %19, %20 offset:512\n\tglobal_load_dwordx4 %15, %19, %20 offset:528\n\t"
        "s_waitcnt vmcnt(0)"
        : "=&v"(d[0]), "=&v"(d[1]), "=&v"(d[2]), "=&v"(d[3]), "=&v"(d[4]), "=&v"(d[5]), "=&v"(d[6]), "=&v"(d[7]), "=&v"(d[8]), "=&v"(d[9]), "=&v"(d[10]), "=&v"(d[11]), "=&v"(d[12]), "=&v"(d[13]), "=&v"(d[14]), "=&v"(d[15])
        : "v"(vo[0]), "v"(vo[1]), "v"(vo[2]), "v"(vo[3]), "s"(uni_ptr(sb)) : "memory"); }
__device__ __forceinline__ void ld16_resb(u32x4 (&d)[16], const void* sb, const unsigned (&vo)[8]) {
    asm volatile("s_nop 4\n\t"
        "global_load_dwordx4 %0, %16, %24\n\tglobal_load_dwordx4 %1, %16, %24 offset:256\n\tglobal_load_dwordx4 %2, %17, %24\n\tglobal_load_dwordx4 %3, %17, %24 offset:256\n\t"
        "global_load_dwordx4 %4, %18, %24\n\tglobal_load_dwordx4 %5, %18, %24 offset:256\n\tglobal_load_dwordx4 %6, %19, %24\n\tglobal_load_dwordx4 %7, %19, %24 offset:256\n\t"
        "global_load_dwordx4 %8, %20, %24\n\tglobal_load_dwordx4 %9, %20, %24 offset:256\n\tglobal_load_dwordx4 %10, %21, %24\n\tglobal_load_dwordx4 %11, %21, %24 offset:256\n\t"
        "global_load_dwordx4 %12, %22, %24\n\tglobal_load_dwordx4 %13, %22, %24 offset:256\n\tglobal_load_dwordx4 %14, %23, %24\n\tglobal_load_dwordx4 %15, %23, %24 offset:256\n\t"
        "s_waitcnt vmcnt(0)"
        : "=&v"(d[0]), "=&v"(d[1]), "=&v"(d[2]), "=&v"(d[3]), "=&v"(d[4]), "=&v"(d[5]), "=&v"(d[6]), "=&v"(d[7]), "=&v"(d[8]), "=&v"(d[9]), "=&v"(d[10]), "=&v"(d[11]), "=&v"(d[12]), "=&v"(d[13]), "=&v"(d[14]), "=&v"(d[15])
        : "v"(vo[0]), "v"(vo[1]), "v"(vo[2]), "v"(vo[3]), "v"(vo[4]), "v"(vo[5]), "v"(vo[6]), "v"(vo[7]), "s"(uni_ptr(sb)) : "memory"); }
__device__ __forceinline__ void ld1_u128(u32x4& d, const void* sb, unsigned vo) {
    asm volatile("s_nop 4\n\tglobal_load_dwordx4 %0, %1, %2\n\ts_waitcnt vmcnt(0)" : "=&v"(d) : "v"(vo), "s"(uni_ptr(sb)) : "memory"); }
__device__ __forceinline__ void unpk8(const u32x4 w, f32x4& lo, f32x4& hi) {
    lo = (f32x4){__builtin_bit_cast(float, w.x << 16), __builtin_bit_cast(float, w.x & 0xffff0000u), __builtin_bit_cast(float, w.y << 16), __builtin_bit_cast(float, w.y & 0xffff0000u)};
    hi = (f32x4){__builtin_bit_cast(float, w.z << 16), __builtin_bit_cast(float, w.z & 0xffff0000u), __builtin_bit_cast(float, w.w << 16), __builtin_bit_cast(float, w.w & 0xffff0000u)}; }
__device__ __forceinline__ float rstd_from_slots(const f32x4 v) {
    float s = (v[0] + v[1]) + (v[2] + v[3]);
    s += xswz<16>(s); s = sum_halves(s);
    return __builtin_amdgcn_rsqf(s * (1.0f / 1024.0f) + 1e-5f);
}

__device__ __forceinline__ float rstd_from_slots32(const f32x4 a, const f32x4 b) {
    float s = ((a[0] + a[1]) + (a[2] + a[3])) + ((b[0] + b[1]) + (b[2] + b[3]));
    s += xswz<16>(s); s = sum_halves(s);
    return __builtin_amdgcn_rsqf(s * (1.0f / 1024.0f) + 1e-5f);
}

template <int ACT> struct EpiScaleAct {
    static constexpr bool PERM = true, AFTER_DRAIN = false, RESCALE = false;
    bf16_t* O; int ldc; const float* ss; int gelu_tiles;
    __device__ __forceinline__ void operator()(const f32x4 (&acc)[2][2][4][2], const Unit& u, int wr, int wc, int fr, int fq) const {
        bf16_t* Ot = O + ((size_t)u.pm * BM * ldc + (size_t)u.pn * BM); const float* sst = ss + (size_t)u.pm * BM * 16;
        unsigned rl0 = (unsigned)(wr * 64 + fr), cl0 = (unsigned)(wc * 32 + 8 * fq); const unsigned uld = (unsigned)ldc;
        asm volatile("" : "+v"(rl0), "+v"(cl0));
        const bool gl = (ACT == 0) && (u.pn < gelu_tiles);
        unsigned vo[8]; f32x4 sv[8]; float rsv[8];
#pragma unroll
        for (int i = 0; i < 8; ++i) vo[i] = ((rl0 + (unsigned)((i >> 2) * HALF + (i & 3) * 16)) * 16u + 4u * (unsigned)fq) * 4u;
        ld8_b128(sv, sst, vo);
#pragma unroll
        for (int i = 0; i < 8; ++i) rsv[i] = rstd_from_slots(sv[i]);
#pragma unroll
        for (int ai = 0; ai < 2; ++ai)
#pragma unroll
            for (int m = 0; m < 4; ++m) { const float rs = rsv[ai * 4 + m]; const unsigned off = (rl0 + (unsigned)(ai * HALF + m * 16)) * uld + cl0;
#pragma unroll
                for (int bj = 0; bj < 2; ++bj) { f32x4 v0 = acc[ai][bj][m][0] * rs, v1 = acc[ai][bj][m][1] * rs;
                    if (ACT == 0) { if (gl) { f32x2 a = gelu_pk((f32x2){v0[0], v0[1]}), b = gelu_pk((f32x2){v0[2], v0[3]}), c = gelu_pk((f32x2){v1[0], v1[1]}), d = gelu_pk((f32x2){v1[2], v1[3]});
                        v0 = (f32x4){a.x, a.y, b.x, b.y}; v1 = (f32x4){c.x, c.y, d.x, d.y}; } }
                    else { v0 = __builtin_elementwise_max(v0, (f32x4){0.f, 0.f, 0.f, 0.f}); v1 = __builtin_elementwise_max(v1, (f32x4){0.f, 0.f, 0.f, 0.f}); v0 = v0 * v0; v1 = v1 * v1; }
                    u32x4 w; w.x = cvt_pk_bf16(v0[0], v0[1]); w.y = cvt_pk_bf16(v0[2], v0[3]); w.z = cvt_pk_bf16(v1[0], v1[1]); w.w = cvt_pk_bf16(v1[2], v1[3]);
                    *(u32x4*)(Ot + (off + (unsigned)(bj * HALF))) = w; } }
    }
};
template <bool RS> struct EpiRes {
    static constexpr bool PERM = true, AFTER_DRAIN = false, RESCALE = RS;
    const float* baseP; const float* baseS; float* X; bf16_t* XB; float* ssout; const float* ssg;
    __device__ __forceinline__ void rescale(f32x4 (&acc)[2][2][4][2], const Unit& u, int wr, int fr) const {
        const float* sgt = ssg + (size_t)u.pm * BM * 2; unsigned rl0 = (unsigned)(wr * 64 + fr); asm volatile("" : "+v"(rl0));
        unsigned vo[8]; f32x2 gv[8];
#pragma unroll
        for (int i = 0; i < 8; ++i) vo[i] = (rl0 + (unsigned)((i >> 2) * HALF + (i & 3) * 16)) * 8u;
        ld8_b64(gv, sgt, vo);
#pragma unroll
        for (int ai = 0; ai < 2; ++ai)
#pragma unroll
            for (int m = 0; m < 4; ++m) { const f32x2 v = gv[ai * 4 + m];
                const float rs = __builtin_amdgcn_rsqf((v.x + v.y) * (1.0f / 512.0f) + 1e-5f);
#pragma unroll
                for (int bj = 0; bj < 2; ++bj)
#pragma unroll
                    for (int n = 0; n < 2; ++n) acc[ai][bj][m][n] = acc[ai][bj][m][n] * rs; }
    }
    __device__ __forceinline__ void operator()(const f32x4 (&acc)[2][2][4][2], const Unit& u, int wr, int wc, int fr, int fq) const {
        const size_t tb = (size_t)u.pm * BM * 1024 + (size_t)u.pn * BM;
        const float* bt = baseP + tb;
        float* Xt = X + tb; bf16_t* XBt = XB + tb; float* sot = ssout + ((size_t)u.pm * BM * 16 + (size_t)(u.pn * 4 + wc));
        unsigned rl0 = (unsigned)(wr * 64 + fr), cl0 = (unsigned)(wc * 32 + 8 * fq);
        asm volatile("" : "+v"(rl0), "+v"(cl0));
#pragma unroll
        for (int ai = 0; ai < 2; ++ai) {
            unsigned vo[4]; f32x4 bv[16];
#pragma unroll
            for (int m = 0; m < 4; ++m) vo[m] = ((rl0 + (unsigned)(ai * HALF + m * 16)) * 1024u + cl0) * 4u;
            ld16_res(bv, bt, vo);
#pragma unroll
            for (int m = 0; m < 4; ++m) { const unsigned rl = rl0 + (unsigned)(ai * HALF + m * 16), off = rl * 1024u + cl0; float sq = 0.f;
#pragma unroll
                for (int bj = 0; bj < 2; ++bj) { const unsigned o2 = off + (unsigned)(bj * HALF);
                    const f32x4 x0 = bv[4 * m + 2 * bj] + acc[ai][bj][m][0], x1 = bv[4 * m + 2 * bj + 1] + acc[ai][bj][m][1];
                    *(f32x4*)(Xt + o2) = x0; *(f32x4*)(Xt + (o2 + 4u)) = x1;
                    u32x4 w; w.x = cvt_pk_bf16(x0[0], x0[1]); w.y = cvt_pk_bf16(x0[2], x0[3]); w.z = cvt_pk_bf16(x1[0], x1[1]); w.w = cvt_pk_bf16(x1[2], x1[3]);
                    *(u32x4*)(XBt + o2) = w;
                    sq += (x0[0] * x0[0] + x0[1] * x0[1]) + (x0[2] * x0[2] + x0[3] * x0[3]) + (x1[0] * x1[0] + x1[1] * x1[1]) + (x1[2] * x1[2] + x1[3] * x1[3]); }
                sq += xswz<16>(sq); sq = sum_halves(sq);
                if (fq == 0) sot[rl * 16u] = sq; }
        }
    }
};

template <class Epi, class Sched, bool ALIGN_EPI = false, bool SP2 = false>
__device__ __forceinline__ void gemm_phase(PG8_LAS unsigned char* lds, const Gemm g, const Sched& S, const Epi& E, const int tid) {
    const int wid = __builtin_amdgcn_readfirstlane(tid >> 6), lane = tid & 63, wr = wid >> 2, wc = wid & 3, fr = lane & 15, fq = lane >> 4;
    const int K = g.K, nt = K / BK;
    unsigned voffA[2], voffB[2];
#pragma unroll
    for (int i = 0; i < 2; ++i) { int R, C; stage_rc(tid * 16 + i * 8192, R, C); const int Rb = Epi::PERM ? ((R & ~31) + perm32(R & 31)) : R;
        voffA[i] = (unsigned)(R * K + C) * 2u; voffB[i] = (unsigned)(Rb * K + C) * 2u; }
    const size_t kstep = (size_t)(BK * 2);
    const size_t hstep = (size_t)HALF * K * 2;
    const size_t tstep = 2 * hstep;
    const unsigned ldsw = (unsigned)wid * 1024u;
    const int aoff = lds_byte(wr * 64 + fr, fq * 8), boff = lds_byte(wc * 32 + fr, fq * 8);
#define PG8_SA(b, h) (((b) * 2 + (h)) * HTB)
#define PG8_SB(b, h) ((4 + (b) * 2 + (h)) * HTB)
#define PG8_STAGE(bufoff, gbase, voff) do { _Pragma("unroll") for (int _i = 0; _i < 2; ++_i) \
        __builtin_amdgcn_global_load_lds((const unsigned*)((const char*)(gbase) + (voff)[_i]), (PG8_LAS unsigned*)(lds + (bufoff) + ldsw + _i * 8192), 16, 0, 0); } while (0)
#define PG8_LDA(dst, b, h) do { _Pragma("unroll") for (int m = 0; m < 4; ++m) _Pragma("unroll") for (int k = 0; k < 2; ++k) dst[m][k] = *(const PG8_LAS bf16x8*)(lds + PG8_SA(b, h) + aoff + m * 2048 + k * 1024); } while (0)
#define PG8_LDB(dst, b, h) do { _Pragma("unroll") for (int n = 0; n < 2; ++n) _Pragma("unroll") for (int k = 0; k < 2; ++k) dst[n][k] = *(const PG8_LAS bf16x8*)(lds + PG8_SB(b, h) + boff + n * 2048 + k * 1024); } while (0)
#define PG8_MMA(ai, bj, At, Bt) do { __builtin_amdgcn_s_setprio(1); _Pragma("unroll") for (int m = 0; m < 4; ++m) _Pragma("unroll") for (int n = 0; n < 2; ++n) _Pragma("unroll") for (int k = 0; k < 2; ++k) \
        acc[ai][bj][m][n] = __builtin_amdgcn_mfma_f32_16x16x32_bf16(Bt[n][k], At[m][k], acc[ai][bj][m][n], 0, 0, 0); __builtin_amdgcn_s_setprio(0); } while (0)
#define PG8_WAIT_V(n) asm volatile("s_waitcnt vmcnt(" #n ")" ::: "memory")
#define PG8_WAIT_L(n) asm volatile("s_waitcnt lgkmcnt(" #n ")" ::: "memory")
#define PG8_BAR __builtin_amdgcn_s_barrier()
#define PG8_SCHED __builtin_amdgcn_sched_barrier(0)
    Unit cur, nxt; int ui = 0;
    if (!S.next(0, cur)) return;
    f32x4 acc[2][2][4][2];
#pragma unroll
    for (int a = 0; a < 2; ++a)
#pragma unroll
        for (int b = 0; b < 2; ++b)
#pragma unroll
            for (int m = 0; m < 4; ++m)
#pragma unroll
                for (int n = 0; n < 2; ++n) acc[a][b][m][n] = (f32x4){0.f, 0.f, 0.f, 0.f};
    bf16x8 At[4][2], B0[2][2], B1[2][2];
    const char* cA = (const char*)g.A + (size_t)cur.pm * tstep; const char* cB = (const char*)g.Bt + (size_t)cur.pn * tstep;
    S.a_ready(cur);
    if constexpr (SP2) {
        PG8_STAGE(PG8_SB(0, 0), cB, voffB); PG8_STAGE(PG8_SB(0, 1), cB + hstep, voffB); PG8_STAGE(PG8_SA(0, 0), cA, voffA); PG8_STAGE(PG8_SA(0, 1), cA + hstep, voffA);
        if (wr == 1) PG8_BAR;
        PG8_WAIT_V(2); PG8_BAR;
        PG8_STAGE(PG8_SB(1, 0), cB + kstep, voffB); PG8_STAGE(PG8_SA(1, 0), cA + kstep, voffA); PG8_STAGE(PG8_SB(1, 1), cB + hstep + kstep, voffB);
        PG8_WAIT_V(6); PG8_BAR;
    } else {
        PG8_STAGE(PG8_SB(0, 0), cB, voffB); PG8_STAGE(PG8_SA(0, 0), cA, voffA); PG8_STAGE(PG8_SB(0, 1), cB + hstep, voffB); PG8_STAGE(PG8_SA(0, 1), cA + hstep, voffA);
        if (wr == 1) PG8_BAR;
        PG8_WAIT_V(4); PG8_BAR;
        PG8_STAGE(PG8_SB(1, 0), cB + kstep, voffB); PG8_STAGE(PG8_SA(1, 0), cA + kstep, voffA); PG8_STAGE(PG8_SB(1, 1), cB + hstep + kstep, voffB);
        PG8_WAIT_V(6); PG8_BAR;
    }
    for (;;) {
        const bool has_next = S.next(ui + 1, nxt);
        const char* nA = has_next ? (const char*)g.A + (size_t)nxt.pm * tstep : cA; const char* nB = has_next ? (const char*)g.Bt + (size_t)nxt.pn * tstep : cB;
        for (int t = 0; t < nt; t += 2) {
            const bool last = (t == nt - 2);
            const char* a1 = cA + (size_t)(t + 1) * kstep;
            const char* a2 = last ? nA : cA + (size_t)(t + 2) * kstep; const char* b2 = last ? nB : cB + (size_t)(t + 2) * kstep;
            const char* a3 = a2 + kstep; const char* b3 = b2 + kstep;
            if (last && has_next) S.a_ready(nxt);
            if constexpr (Epi::RESCALE) { if (t == 8) E.rescale(acc, cur, wr, fr); }
            if constexpr (SP2) {
            PG8_LDB(B0, 0, 0); PG8_LDB(B1, 0, 1); PG8_SCHED; PG8_LDA(At, 0, 0); PG8_STAGE(PG8_SA(1, 1), a1 + hstep, voffA);
            PG8_WAIT_V(8); PG8_WAIT_L(0); PG8_BAR; PG8_MMA(0, 0, At, B0); PG8_MMA(0, 1, At, B1); PG8_BAR; PG8_SCHED;
            PG8_LDA(At, 0, 1); PG8_STAGE(PG8_SB(0, 0), b2, voffB); PG8_STAGE(PG8_SB(0, 1), b2 + hstep, voffB); PG8_STAGE(PG8_SA(0, 0), a2, voffA);
            PG8_WAIT_V(8); PG8_WAIT_L(0); PG8_BAR; PG8_MMA(1, 0, At, B0); PG8_MMA(1, 1, At, B1); PG8_BAR; PG8_SCHED;
            PG8_LDB(B0, 1, 0); PG8_LDB(B1, 1, 1); PG8_SCHED; PG8_LDA(At, 1, 0); PG8_STAGE(PG8_SA(0, 1), a2 + hstep, voffA);
            PG8_WAIT_V(8); PG8_WAIT_L(0); PG8_BAR; PG8_MMA(0, 0, At, B0); PG8_MMA(0, 1, At, B1); PG8_BAR; PG8_SCHED;
            PG8_LDA(At, 1, 1); PG8_STAGE(PG8_SB(1, 0), b3, voffB); PG8_STAGE(PG8_SB(1, 1), b3 + hstep, voffB); PG8_STAGE(PG8_SA(1, 0), a3, voffA);
            PG8_WAIT_V(8); PG8_WAIT_L(0); PG8_BAR; PG8_MMA(1, 0, At, B0); PG8_MMA(1, 1, At, B1); PG8_BAR; PG8_SCHED;
            } else {
            PG8_LDB(B0, 0, 0); PG8_SCHED; PG8_LDA(At, 0, 0); PG8_STAGE(PG8_SA(1, 1), a1 + hstep, voffA);
            PG8_WAIT_L(8); PG8_BAR; PG8_WAIT_L(0); PG8_MMA(0, 0, At, B0); PG8_BAR; PG8_SCHED;
            PG8_LDB(B1, 0, 1); PG8_STAGE(PG8_SB(0, 0), b2, voffB);
            PG8_BAR; PG8_WAIT_L(0); PG8_MMA(0, 1, At, B1); PG8_BAR;
            PG8_LDA(At, 0, 1); PG8_STAGE(PG8_SA(0, 0), a2, voffA);
            PG8_BAR; PG8_WAIT_L(0); PG8_MMA(1, 0, At, B0); PG8_BAR; PG8_SCHED;
            PG8_STAGE(PG8_SB(0, 1), b2 + hstep, voffB);
            PG8_WAIT_V(6); PG8_BAR; PG8_MMA(1, 1, At, B1); PG8_BAR;
            PG8_LDB(B0, 1, 0); PG8_SCHED; PG8_LDA(At, 1, 0); PG8_STAGE(PG8_SA(0, 1), a2 + hstep, voffA);
            PG8_WAIT_L(8); PG8_BAR; PG8_WAIT_L(0); PG8_MMA(0, 0, At, B0); PG8_BAR; PG8_SCHED;
            PG8_LDB(B1, 1, 1); PG8_STAGE(PG8_SB(1, 0), b3, voffB);
            PG8_BAR; PG8_WAIT_L(0); PG8_MMA(0, 1, At, B1); PG8_BAR;
            PG8_LDA(At, 1, 1); PG8_STAGE(PG8_SA(1, 0), a3, voffA);
            PG8_BAR; PG8_WAIT_L(0); PG8_MMA(1, 0, At, B0); PG8_BAR; PG8_SCHED;
            PG8_STAGE(PG8_SB(1, 1), b3 + hstep, voffB);
            PG8_WAIT_V(6); PG8_BAR; PG8_MMA(1, 1, At, B1); PG8_BAR;
            }
        }
        if constexpr (ALIGN_EPI) { if (wr == 0) PG8_BAR; }
        if constexpr (!Epi::AFTER_DRAIN) { E(acc, cur, wr, wc, fr, fq); S.done(cur); }
        if (!has_next) break;
#pragma unroll
        for (int a = 0; a < 2; ++a)
#pragma unroll
            for (int b = 0; b < 2; ++b)
#pragma unroll
                for (int m = 0; m < 4; ++m)
#pragma unroll
                    for (int n = 0; n < 2; ++n) acc[a][b][m][n] = (f32x4){0.f, 0.f, 0.f, 0.f};
        cur = nxt; cA = nA; cB = nB; ++ui;
        if constexpr (ALIGN_EPI) { if (wr == 1) PG8_BAR; }
    }
    PG8_WAIT_V(0);
    if constexpr (!ALIGN_EPI) { if (wr == 0) PG8_BAR; }
    PG8_BAR;
#undef PG8_SA
#undef PG8_SB
#undef PG8_STAGE
#undef PG8_LDA
#undef PG8_LDB
#undef PG8_MMA
#undef PG8_WAIT_V
#undef PG8_WAIT_L
#undef PG8_BAR
#undef PG8_SCHED
}

constexpr int EXOFF = 131072;
struct GemmX { const bf16_t* A; const bf16_t* AX; const bf16_t* Bt; int K; };
template <class Epi, class Sched>
__device__ __forceinline__ void gemm_phase_x(PG8_LAS unsigned char* lds, const GemmX g, const Sched& S, const Epi& E, const int tid) {
    const int wid = __builtin_amdgcn_readfirstlane(tid >> 6), lane = tid & 63, wr = wid >> 2, wc = wid & 3, fr = lane & 15, fq = lane >> 4;
    const int K = g.K, nt = K / BK;
    unsigned voffA[2], voffB[2];
#pragma unroll
    for (int i = 0; i < 2; ++i) { int R, C; stage_rc(tid * 16 + i * 8192, R, C); const int Rb = (R & ~31) + perm32(R & 31);
        voffA[i] = (unsigned)(R * K + C) * 2u; voffB[i] = (unsigned)(Rb * K + C) * 2u; }
    const unsigned voffX = (unsigned)((tid >> 5) * K + ((((tid & 31) >> 2) ^ ((tid >> 6) & 3)) * 4 + (tid & 3)) * 2) * 2u;
    const size_t kstep = (size_t)(BK * 2);
    const size_t hstep = (size_t)HALF * K * 2;
    const size_t tstep = 2 * hstep;
    const size_t xstep = (size_t)16 * K * 2;
    const unsigned ldsw = (unsigned)wid * 1024u;
    const int aoff = lds_byte(wr * 64 + fr, fq * 8), boff = lds_byte(wc * 32 + fr, fq * 8);
    const int xoff = EXOFF + fr * 128 + (fq ^ ((fr >> 1) & 3)) * 16;
#define PG8_SA(b, h) (((b) * 2 + (h)) * HTB)
#define PG8_SB(b, h) ((4 + (b) * 2 + (h)) * HTB)
#define PG8_STAGE(bufoff, gbase, voff) do { _Pragma("unroll") for (int _i = 0; _i < 2; ++_i) \
        __builtin_amdgcn_global_load_lds((const unsigned*)((const char*)(gbase) + (voff)[_i]), (PG8_LAS unsigned*)(lds + (bufoff) + ldsw + _i * 8192), 16, 0, 0); } while (0)
#define PG8_STAGEX(b, gbase) __builtin_amdgcn_global_load_lds((const unsigned*)((const char*)(gbase) + voffX), (PG8_LAS unsigned*)(lds + EXOFF + (b) * 2048 + wid * 256), 4, 0, 0)
#define PG8_LDA(dst, b, h) do { _Pragma("unroll") for (int m = 0; m < 4; ++m) _Pragma("unroll") for (int k = 0; k < 2; ++k) dst[m][k] = *(const PG8_LAS bf16x8*)(lds + PG8_SA(b, h) + aoff + m * 2048 + k * 1024); } while (0)
#define PG8_LDB(dst, b, h) do { _Pragma("unroll") for (int n = 0; n < 2; ++n) _Pragma("unroll") for (int k = 0; k < 2; ++k) dst[n][k] = *(const PG8_LAS bf16x8*)(lds + PG8_SB(b, h) + boff + n * 2048 + k * 1024); } while (0)
#define PG8_LDX(dst, b) do { _Pragma("unroll") for (int k = 0; k < 2; ++k) dst[k] = *(const PG8_LAS bf16x8*)(lds + (b) * 2048 + xoff + k * 64); } while (0)
#define PG8_MMA(ai, bj, At, Bt) do { __builtin_amdgcn_s_setprio(1); _Pragma("unroll") for (int m = 0; m < 4; ++m) _Pragma("unroll") for (int n = 0; n < 2; ++n) _Pragma("unroll") for (int k = 0; k < 2; ++k) \
        acc[ai][bj][m][n] = __builtin_amdgcn_mfma_f32_16x16x32_bf16(Bt[n][k], At[m][k], acc[ai][bj][m][n], 0, 0, 0); __builtin_amdgcn_s_setprio(0); } while (0)
#define PG8_MMAX(Bt) do { _Pragma("unroll") for (int n = 0; n < 2; ++n) _Pragma("unroll") for (int k = 0; k < 2; ++k) accx[n] = __builtin_amdgcn_mfma_f32_16x16x32_bf16(Bt[n][k], Ax[k], accx[n], 0, 0, 0); } while (0)
#define PG8_WAIT_V(n) asm volatile("s_waitcnt vmcnt(" #n ")" ::: "memory")
#define PG8_WAIT_L(n) asm volatile("s_waitcnt lgkmcnt(" #n ")" ::: "memory")
#define PG8_BAR __builtin_amdgcn_s_barrier()
#define PG8_SCHED __builtin_amdgcn_sched_barrier(0)
    Unit cur, nxt; int ui = 0;
    if (!S.next(0, cur)) return;
    f32x4 acc[2][2][4][2], accx[2];
#pragma unroll
    for (int a = 0; a < 2; ++a)
#pragma unroll
        for (int b = 0; b < 2; ++b)
#pragma unroll
            for (int m = 0; m < 4; ++m)
#pragma unroll
                for (int n = 0; n < 2; ++n) acc[a][b][m][n] = (f32x4){0.f, 0.f, 0.f, 0.f};
    accx[0] = (f32x4){0.f, 0.f, 0.f, 0.f}; accx[1] = (f32x4){0.f, 0.f, 0.f, 0.f};
    bf16x8 At[4][2], B0[2][2], B1[2][2], Ax[2];
    const char* cA = (const char*)g.A + (size_t)cur.pm * tstep; const char* cB = (const char*)g.Bt + (size_t)cur.pn * tstep; const char* cX = (const char*)g.AX + (size_t)cur.pm * xstep;
    PG8_STAGE(PG8_SB(0, 0), cB, voffB); PG8_STAGE(PG8_SB(0, 1), cB + hstep, voffB); PG8_STAGE(PG8_SA(0, 0), cA, voffA); PG8_STAGEX(0, cX); PG8_STAGE(PG8_SA(0, 1), cA + hstep, voffA);
    if (wr == 1) PG8_BAR;
    PG8_WAIT_V(2); PG8_BAR;
    PG8_STAGE(PG8_SB(1, 0), cB + kstep, voffB); PG8_STAGE(PG8_SA(1, 0), cA + kstep, voffA); PG8_STAGEX(1, cX + kstep); PG8_STAGE(PG8_SB(1, 1), cB + hstep + kstep, voffB);
    PG8_WAIT_V(7); PG8_BAR;
    for (;;) {
        const bool has_next = S.next(ui + 1, nxt);
        const char* nA = has_next ? (const char*)g.A + (size_t)nxt.pm * tstep : cA; const char* nB = has_next ? (const char*)g.Bt + (size_t)nxt.pn * tstep : cB;
        const char* nX = has_next ? (const char*)g.AX + (size_t)nxt.pm * xstep : cX;
        for (int t = 0; t < nt; t += 2) {
            const bool last = (t == nt - 2);
            const char* a1 = cA + (size_t)(t + 1) * kstep;
            const char* a2 = last ? nA : cA + (size_t)(t + 2) * kstep; const char* b2 = last ? nB : cB + (size_t)(t + 2) * kstep; const char* x2 = last ? nX : cX + (size_t)(t + 2) * kstep;
            const char* a3 = a2 + kstep; const char* b3 = b2 + kstep; const char* x3 = x2 + kstep;
            if constexpr (Epi::RESCALE) { if (t == 8) E.rescale(acc, accx, cur, wr, fr); }
            PG8_LDB(B0, 0, 0); PG8_LDB(B1, 0, 1); PG8_SCHED; PG8_LDA(At, 0, 0); PG8_LDX(Ax, 0); PG8_STAGE(PG8_SA(1, 1), a1 + hstep, voffA);
            PG8_WAIT_V(9); PG8_WAIT_L(0); PG8_BAR; PG8_MMA(0, 0, At, B0); PG8_MMA(0, 1, At, B1); if (wr == 0) PG8_MMAX(B0); else PG8_MMAX(B1); PG8_BAR; PG8_SCHED;
            PG8_LDA(At, 0, 1); PG8_STAGE(PG8_SB(0, 0), b2, voffB); PG8_STAGE(PG8_SB(0, 1), b2 + hstep, voffB); PG8_STAGE(PG8_SA(0, 0), a2, voffA); PG8_STAGEX(0, x2);
            PG8_WAIT_V(9); PG8_WAIT_L(0); PG8_BAR; PG8_MMA(1, 0, At, B0); PG8_MMA(1, 1, At, B1); PG8_BAR; PG8_SCHED;
            PG8_LDB(B0, 1, 0); PG8_LDB(B1, 1, 1); PG8_SCHED; PG8_LDA(At, 1, 0); PG8_LDX(Ax, 1); PG8_STAGE(PG8_SA(0, 1), a2 + hstep, voffA);
            PG8_WAIT_V(9); PG8_WAIT_L(0); PG8_BAR; PG8_MMA(0, 0, At, B0); PG8_MMA(0, 1, At, B1); if (wr == 0) PG8_MMAX(B0); else PG8_MMAX(B1); PG8_BAR; PG8_SCHED;
            PG8_LDA(At, 1, 1); PG8_STAGE(PG8_SB(1, 0), b3, voffB); PG8_STAGE(PG8_SB(1, 1), b3 + hstep, voffB); PG8_STAGE(PG8_SA(1, 0), a3, voffA); PG8_STAGEX(1, x3);
            PG8_WAIT_V(9); PG8_WAIT_L(0); PG8_BAR; PG8_MMA(1, 0, At, B0); PG8_MMA(1, 1, At, B1); PG8_BAR; PG8_SCHED;
        }
        if (wr == 0) PG8_BAR;
        E(acc, accx, cur, wr, wc, fr, fq);
        if (!has_next) break;
#pragma unroll
        for (int a = 0; a < 2; ++a)
#pragma unroll
            for (int b = 0; b < 2; ++b)
#pragma unroll
                for (int m = 0; m < 4; ++m)
#pragma unroll
                    for (int n = 0; n < 2; ++n) acc[a][b][m][n] = (f32x4){0.f, 0.f, 0.f, 0.f};
        accx[0] = (f32x4){0.f, 0.f, 0.f, 0.f}; accx[1] = (f32x4){0.f, 0.f, 0.f, 0.f};
        cur = nxt; cA = nA; cB = nB; cX = nX; ++ui;
        if (wr == 1) PG8_BAR;
    }
    PG8_WAIT_V(0);
    PG8_BAR;
#undef PG8_SA
#undef PG8_SB
#undef PG8_STAGE
#undef PG8_STAGEX
#undef PG8_LDA
#undef PG8_LDB
#undef PG8_LDX
#undef PG8_MMA
#undef PG8_MMAX
#undef PG8_WAIT_V
#undef PG8_WAIT_L
#undef PG8_BAR
#undef PG8_SCHED
}
template <int ACT> struct EpiScaleActX {
    static constexpr bool RESCALE = false;
    bf16_t* O; bf16_t* OS; int ldc; const float* ss; const float* ssx; int gelu_tiles;
    __device__ __forceinline__ void act8(f32x4& v0, f32x4& v1, bool gl) const {
        if (ACT == 0) { if (gl) { f32x2 a = gelu_pk((f32x2){v0[0], v0[1]}), b = gelu_pk((f32x2){v0[2], v0[3]}), c = gelu_pk((f32x2){v1[0], v1[1]}), d = gelu_pk((f32x2){v1[2], v1[3]});
            v0 = (f32x4){a.x, a.y, b.x, b.y}; v1 = (f32x4){c.x, c.y, d.x, d.y}; } }
        else { v0 = __builtin_elementwise_max(v0, (f32x4){0.f, 0.f, 0.f, 0.f}); v1 = __builtin_elementwise_max(v1, (f32x4){0.f, 0.f, 0.f, 0.f}); v0 = v0 * v0; v1 = v1 * v1; }
    }
    __device__ __forceinline__ void operator()(const f32x4 (&acc)[2][2][4][2], const f32x4 (&accx)[2], const Unit& u, int wr, int wc, int fr, int fq) const {
        bf16_t* Ot = O + ((size_t)u.pm * BM * ldc + (size_t)u.pn * BM); const float* sst = ss + (size_t)u.pm * BM * 16;
        unsigned rl0 = (unsigned)(wr * 64 + fr), cl0 = (unsigned)(wc * 32 + 8 * fq); const unsigned uld = (unsigned)ldc; unsigned frv = (unsigned)fr;
        asm volatile("" : "+v"(rl0), "+v"(cl0), "+v"(frv));
        const bool gl = (ACT == 0) && (u.pn < gelu_tiles);
        {
            f32x4 s0, s1; ld2_b128(s0, s1, ssx + (size_t)u.pm * 16 * 32, (frv * 32u + 8u * (unsigned)fq) * 4u); const float rs = rstd_from_slots32(s0, s1);
            f32x4 v0 = accx[0] * rs, v1 = accx[1] * rs; act8(v0, v1, gl);
            u32x4 w; w.x = cvt_pk_bf16(v0[0], v0[1]); w.y = cvt_pk_bf16(v0[2], v0[3]); w.z = cvt_pk_bf16(v1[0], v1[1]); w.w = cvt_pk_bf16(v1[2], v1[3]);
            *(u32x4*)(OS + ((size_t)u.pm * 16 * ldc + (size_t)u.pn * BM) + (frv * uld + (unsigned)(wr * HALF) + cl0)) = w; }
        unsigned vo[8]; f32x4 sv[8]; float rsv[8];
#pragma unroll
        for (int i = 0; i < 8; ++i) vo[i] = ((rl0 + (unsigned)((i >> 2) * HALF + (i & 3) * 16)) * 16u + 4u * (unsigned)fq) * 4u;
        ld8_b128(sv, sst, vo);
#pragma unroll
        for (int i = 0; i < 8; ++i) rsv[i] = rstd_from_slots(sv[i]);
#pragma unroll
        for (int ai = 0; ai < 2; ++ai)
#pragma unroll
            for (int m = 0; m < 4; ++m) { const float rs = rsv[ai * 4 + m]; const unsigned off = (rl0 + (unsigned)(ai * HALF + m * 16)) * uld + cl0;
#pragma unroll
                for (int bj = 0; bj < 2; ++bj) { f32x4 v0 = acc[ai][bj][m][0] * rs, v1 = acc[ai][bj][m][1] * rs; act8(v0, v1, gl);
                    u32x4 w; w.x = cvt_pk_bf16(v0[0], v0[1]); w.y = cvt_pk_bf16(v0[2], v0[3]); w.z = cvt_pk_bf16(v1[0], v1[1]); w.w = cvt_pk_bf16(v1[2], v1[3]);
                    *(u32x4*)(Ot + (off + (unsigned)(bj * HALF))) = w; } }
    }
};
template <bool RS> struct EpiResX {
    static constexpr bool RESCALE = RS;
    bf16_t* XB; float* ssout; float* ssxout; const float* ssg;
    __device__ __forceinline__ void rescale(f32x4 (&acc)[2][2][4][2], f32x4 (&accx)[2], const Unit& u, int wr, int fr) const {
        const float* sgt = ssg + (size_t)u.pm * BM * 2; unsigned rl0 = (unsigned)(wr * 64 + fr), frv = (unsigned)fr; asm volatile("" : "+v"(rl0), "+v"(frv));
        unsigned vo[8]; f32x2 gv[8]; f32x2 gx;
#pragma unroll
        for (int i = 0; i < 8; ++i) vo[i] = (rl0 + (unsigned)((i >> 2) * HALF + (i & 3) * 16)) * 8u;
        ld1_b64(gx, ssg + ((size_t)16384 + (size_t)u.pm * 16) * 2, frv * 8u);
        ld8_b64(gv, sgt, vo);
        { const float rs = __builtin_amdgcn_rsqf((gx.x + gx.y) * (1.0f / 512.0f) + 1e-5f); accx[0] = accx[0] * rs; accx[1] = accx[1] * rs; }
#pragma unroll
        for (int ai = 0; ai < 2; ++ai)
#pragma unroll
            for (int m = 0; m < 4; ++m) { const f32x2 v = gv[ai * 4 + m];
                const float rs = __builtin_amdgcn_rsqf((v.x + v.y) * (1.0f / 512.0f) + 1e-5f);
#pragma unroll
                for (int bj = 0; bj < 2; ++bj)
#pragma unroll
                    for (int n = 0; n < 2; ++n) acc[ai][bj][m][n] = acc[ai][bj][m][n] * rs; }
    }
    __device__ __forceinline__ void operator()(const f32x4 (&acc)[2][2][4][2], const f32x4 (&accx)[2], const Unit& u, int wr, int wc, int fr, int fq) const {
        const size_t tb = (size_t)u.pm * BM * 1024 + (size_t)u.pn * BM;
        bf16_t* XBt = XB + tb; float* sot = ssout + ((size_t)u.pm * BM * 16 + (size_t)(u.pn * 4 + wc));
        unsigned rl0 = (unsigned)(wr * 64 + fr), cl0 = (unsigned)(wc * 32 + 8 * fq), frv = (unsigned)fr;
        asm volatile("" : "+v"(rl0), "+v"(cl0), "+v"(frv));
        {
            const size_t sb = (size_t)u.pm * 16 * 1024 + (size_t)u.pn * BM; const unsigned off = frv * 1024u + (unsigned)(wr * HALF) + cl0;
            bf16_t* XBs = XB + ((size_t)16384 * 1024 + sb);
            u32x4 br; ld1_u128(br, XBs, off * 2u); f32x4 b0, b1; unpk8(br, b0, b1);
            const f32x4 x0 = b0 + accx[0], x1 = b1 + accx[1];
            u32x4 w; w.x = cvt_pk_bf16(x0[0], x0[1]); w.y = cvt_pk_bf16(x0[2], x0[3]); w.z = cvt_pk_bf16(x1[0], x1[1]); w.w = cvt_pk_bf16(x1[2], x1[3]);
            *(u32x4*)(XBs + off) = w;
            float sq = (x0[0] * x0[0] + x0[1] * x0[1]) + (x0[2] * x0[2] + x0[3] * x0[3]) + (x1[0] * x1[0] + x1[1] * x1[1]) + (x1[2] * x1[2] + x1[3] * x1[3]);
            sq += xswz<16>(sq); sq = sum_halves(sq);
            if (fq == 0) ssxout[((size_t)u.pm * 16) * 32 + (size_t)(u.pn * 8 + wr * 4 + wc) + frv * 32u] = sq; }
        unsigned vo[8]; u32x4 bv[16];
#pragma unroll
        for (int i = 0; i < 8; ++i) vo[i] = ((rl0 + (unsigned)((i >> 2) * HALF + (i & 3) * 16)) * 1024u + cl0) * 2u;
        ld16_resb(bv, XBt, vo);
#pragma unroll
        for (int ai = 0; ai < 2; ++ai) {
#pragma unroll
            for (int m = 0; m < 4; ++m) { const unsigned rl = rl0 + (unsigned)(ai * HALF + m * 16), off = rl * 1024u + cl0; float sq = 0.f;
#pragma unroll
                for (int bj = 0; bj < 2; ++bj) { const unsigned o2 = off + (unsigned)(bj * HALF);
                    f32x4 b0, b1; unpk8(bv[2 * (4 * ai + m) + bj], b0, b1);
                    const f32x4 x0 = b0 + acc[ai][bj][m][0], x1 = b1 + acc[ai][bj][m][1];
                    u32x4 w; w.x = cvt_pk_bf16(x0[0], x0[1]); w.y = cvt_pk_bf16(x0[2], x0[3]); w.z = cvt_pk_bf16(x1[0], x1[1]); w.w = cvt_pk_bf16(x1[2], x1[3]);
                    *(u32x4*)(XBt + o2) = w;
                    sq += (x0[0] * x0[0] + x0[1] * x0[1]) + (x0[2] * x0[2] + x0[3] * x0[3]) + (x1[0] * x1[0] + x1[1] * x1[1]) + (x1[2] * x1[2] + x1[3] * x1[3]); }
                sq += xswz<16>(sq); sq = sum_halves(sq);
                if (fq == 0) sot[rl * 16u] = sq; }
        }
    }
};

constexpr int SM_STAGE_BYTES = 32768, SM_SQ_OFF = 148480;
template <int TS, class EpiS>
__device__ __forceinline__ void small_gemm_phase(PG8_LAS unsigned char* lds, const bf16_t* A, const bf16_t* Bt, const int K, const int nN, const int n_units, const int first_unit, const int unit_stride, const EpiS& E, const int tid) {
    constexpr int NP = TS / 64, NM = TS == 128 ? 4 : 1, LPS = 2 * NP;
    const int wid = __builtin_amdgcn_readfirstlane(tid >> 6), lane = tid & 63, fr = lane & 15, fq = lane >> 4;
    const int wr = TS == 128 ? (wid >> 2) : 0, wc = TS == 128 ? (wid & 3) : (wid >> 2), mq = wid & 3;
    const int nt = K / BK;
    unsigned voffA[NP], voffB[NP];
#pragma unroll
    for (int i = 0; i < NP; ++i) { int R, C; stage_rc(tid * 16 + i * 8192, R, C); const int Rb = (R & ~31) + perm32(R & 31); voffA[i] = (unsigned)(R * K + C) * 2u; voffB[i] = (unsigned)(Rb * K + C) * 2u; }
    const unsigned ldsw = (unsigned)wid * 1024u;
    const int aoff = TS == 128 ? lds_byte(wr * 64 + fr, fq * 8) : lds_byte(mq * 16 + fr, fq * 8), boff = 16384 + lds_byte(wc * 32 + fr, fq * 8);
#define SM_STAGE(st, kt) do { _Pragma("unroll") for (int _i = 0; _i < NP; ++_i) { \
        __builtin_amdgcn_global_load_lds((const unsigned*)(cA + voffA[_i] + (size_t)(kt) * 128), (PG8_LAS unsigned*)(lds + (st) * SM_STAGE_BYTES + ldsw + _i * 8192), 16, 0, 0); \
        __builtin_amdgcn_global_load_lds((const unsigned*)(cB + voffB[_i] + (size_t)(kt) * 128), (PG8_LAS unsigned*)(lds + (st) * SM_STAGE_BYTES + 16384 + ldsw + _i * 8192), 16, 0, 0); } } while (0)
#define SM_WAIT_V(n) asm volatile("s_waitcnt vmcnt(%0)" :: "n"(n) : "memory")
    for (int u = first_unit; u < n_units; u += unit_stride) {
        const int pm = u / nN, pn = u % nN;
        const char* cA = (const char*)A + (size_t)pm * TS * K * 2; const char* cB = (const char*)Bt + (size_t)pn * TS * K * 2;
        f32x4 acc[NM][2];
#pragma unroll
        for (int m = 0; m < NM; ++m) { acc[m][0] = (f32x4){0.f, 0.f, 0.f, 0.f}; acc[m][1] = (f32x4){0.f, 0.f, 0.f, 0.f}; }
        E.begin(pm, pn, wr, mq, fr);
        asm volatile("s_waitcnt vmcnt(0)" ::: "memory"); __builtin_amdgcn_s_barrier();
        SM_STAGE(0, 0); SM_STAGE(1, 1); SM_STAGE(2, 2);
#pragma unroll 1
        for (int t = 0; t < nt; ++t) {
            if (t + 2 < nt) SM_WAIT_V(2 * LPS); else if (t + 1 < nt) SM_WAIT_V(LPS); else SM_WAIT_V(0);
            __builtin_amdgcn_s_barrier();
            if (t + 3 < nt) SM_STAGE((t + 3) & 3, t + 3);
            if (E.RESCALE) { if (t == 8) E.rescale(acc); }
            const PG8_LAS unsigned char* sb = lds + (t & 3) * SM_STAGE_BYTES;
            bf16x8 Af[NM][2], Bf[2][2];
#pragma unroll
            for (int m = 0; m < NM; ++m)
#pragma unroll
                for (int k = 0; k < 2; ++k) Af[m][k] = *(const PG8_LAS bf16x8*)(sb + aoff + m * 2048 + k * 1024);
#pragma unroll
            for (int n = 0; n < 2; ++n)
#pragma unroll
                for (int k = 0; k < 2; ++k) Bf[n][k] = *(const PG8_LAS bf16x8*)(sb + boff + n * 2048 + k * 1024);
#pragma unroll
            for (int m = 0; m < NM; ++m)
#pragma unroll
                for (int n = 0; n < 2; ++n)
#pragma unroll
                    for (int k = 0; k < 2; ++k) acc[m][n] = __builtin_amdgcn_mfma_f32_16x16x32_bf16(Bf[n][k], Af[m][k], acc[m][n], 0, 0, 0);
        }
        E.store(acc, pm, pn, wr, wc, mq, fr, fq, lds, tid);
    }
    asm volatile("s_waitcnt vmcnt(0)" ::: "memory"); __builtin_amdgcn_s_barrier();
#undef SM_STAGE
#undef SM_WAIT_V
}
struct SEpiFF1 {
    static constexpr bool RESCALE = false;
    bf16_t* O; int ldc; const float* ss; int row_base;
    __device__ __forceinline__ void begin(int, int, int, int, int) const {}
    __device__ __forceinline__ void rescale(f32x4 (&)[4][2]) const {}
    __device__ __forceinline__ void store(const f32x4 (&acc)[4][2], int pm, int pn, int wr, int wc, int, int fr, int fq, PG8_LAS unsigned char*, int) const {
        const size_t r0 = (size_t)row_base + (size_t)pm * 128; bf16_t* Ot = O + (r0 * ldc + (size_t)pn * 128); const float* sst = ss + r0 * 16;
        unsigned rl0 = (unsigned)(wr * 64 + fr), cl0 = (unsigned)(wc * 32 + 8 * fq); asm volatile("" : "+v"(rl0), "+v"(cl0));
        unsigned vo[4]; f32x4 sv[4];
#pragma unroll
        for (int m = 0; m < 4; ++m) vo[m] = ((rl0 + (unsigned)(m * 16)) * 16u + 4u * (unsigned)fq) * 4u;
        ld4_b128(sv, sst, vo);
#pragma unroll
        for (int m = 0; m < 4; ++m) { const unsigned rl = rl0 + (unsigned)(m * 16); const float rs = rstd_from_slots(sv[m]);
            f32x4 v0 = acc[m][0] * rs, v1 = acc[m][1] * rs;
            v0 = __builtin_elementwise_max(v0, (f32x4){0.f, 0.f, 0.f, 0.f}); v1 = __builtin_elementwise_max(v1, (f32x4){0.f, 0.f, 0.f, 0.f}); v0 = v0 * v0; v1 = v1 * v1;
            u32x4 w; w.x = cvt_pk_bf16(v0[0], v0[1]); w.y = cvt_pk_bf16(v0[2], v0[3]); w.z = cvt_pk_bf16(v1[0], v1[1]); w.w = cvt_pk_bf16(v1[2], v1[3]);
            *(u32x4*)(Ot + (rl * (unsigned)ldc + cl0)) = w; }
    }
};
struct SEpiDt {
    static constexpr bool RESCALE = false;
    float* DT; const float* ss; const float* bias; const float* ssx;
    __device__ __forceinline__ void begin(int, int, int, int, int) const {}
    __device__ __forceinline__ void rescale(f32x4 (&)[1][2]) const {}
    __device__ __forceinline__ void store(const f32x4 (&acc)[1][2], int pm, int, int, int wc, int mq, int fr, int fq, PG8_LAS unsigned char*, int) const {
        const size_t r0 = (size_t)pm * 64; unsigned rl = (unsigned)(mq * 16 + fr); asm volatile("" : "+v"(rl));
        float rs;
        if (pm < 256) { f32x4 sv; ld1_b128(sv, ss + r0 * 16, (rl * 16u + 4u * (unsigned)fq) * 4u); rs = rstd_from_slots(sv); }
        else { f32x4 s0, s1; ld2_b128(s0, s1, ssx + (r0 - 16384) * 32, (rl * 32u + 8u * (unsigned)fq) * 4u); rs = rstd_from_slots32(s0, s1); }
        if (wc == 0 && fq == 0) { const f32x4 b0 = *(const f32x4*)bias, b1 = *(const f32x4*)(bias + 4); f32x4 d0, d1;
#pragma unroll
            for (int i = 0; i < 4; ++i) { d0[i] = softplus_f(acc[0][0][i] * rs + b0[i]); d1[i] = softplus_f(acc[0][1][i] * rs + b1[i]); }
            float* dst = DT + (r0 + rl) * 8; *(f32x4*)dst = d0; *(f32x4*)(dst + 4) = d1; }
    }
};
template <bool RS> struct SEpiRes {
    static constexpr bool RESCALE = RS;
    const float* base; float* X; bf16_t* XB; float* ssout; const float* ssg; int row_base;
    mutable float rsl;
    __device__ __forceinline__ void begin(int pm, int, int, int mq, int fr) const {
        if (RS) { f32x2 v; ld1_b64(v, ssg + ((size_t)row_base + (size_t)pm * 64) * 2, (unsigned)(mq * 16 + fr) * 8u); rsl = __builtin_amdgcn_rsqf((v.x + v.y) * (1.0f / 512.0f) + 1e-5f); }
    }
    __device__ __forceinline__ void rescale(f32x4 (&acc)[1][2]) const { acc[0][0] = acc[0][0] * rsl; acc[0][1] = acc[0][1] * rsl; }
    __device__ __forceinline__ void store(const f32x4 (&acc)[1][2], int pm, int pn, int, int wc, int mq, int fr, int fq, PG8_LAS unsigned char* lds, int tid) const {
        const size_t r0 = (size_t)row_base + (size_t)pm * 64, tb = r0 * 1024 + (size_t)pn * 64;
        const float* bt = base + tb; float* Xt = X + tb; bf16_t* XBt = XB + tb;
        unsigned rl = (unsigned)(mq * 16 + fr), cl0 = (unsigned)(wc * 32 + 8 * fq); asm volatile("" : "+v"(rl), "+v"(cl0));
        const unsigned off = rl * 1024u + cl0;
        f32x4 b0, b1; ld2_b128(b0, b1, bt, off * 4u);
        const f32x4 x0 = b0 + acc[0][0], x1 = b1 + acc[0][1];
        *(f32x4*)(Xt + off) = x0; *(f32x4*)(Xt + (off + 4u)) = x1;
        u32x4 w; w.x = cvt_pk_bf16(x0[0], x0[1]); w.y = cvt_pk_bf16(x0[2], x0[3]); w.z = cvt_pk_bf16(x1[0], x1[1]); w.w = cvt_pk_bf16(x1[2], x1[3]);
        *(u32x4*)(XBt + off) = w;
        float sq = (x0[0] * x0[0] + x0[1] * x0[1]) + (x0[2] * x0[2] + x0[3] * x0[3]) + (x1[0] * x1[0] + x1[1] * x1[1]) + (x1[2] * x1[2] + x1[3] * x1[3]);
        sq += xswz<16>(sq); sq = sum_halves(sq);
        PG8_LAS float* sqp = (PG8_LAS float*)(lds + SM_SQ_OFF);
        if (fq == 0) sqp[rl * 2u + (unsigned)wc] = sq;
        asm volatile("s_waitcnt lgkmcnt(0)" ::: "memory"); __builtin_amdgcn_s_barrier(); asm volatile("" ::: "memory");
        if (tid < 64) ssout[(r0 + (size_t)tid) * 16 + pn] = sqp[tid * 2] + sqp[tid * 2 + 1];
    }
};
}

constexpr int NWAVES = 8;
constexpr int DM = 1024, DEPTH = 4, MP = 16384, MS = 1024, M = MP + MS, SEQ = 2048, DSEQ = 8, NB = 8, NDB = 128;
constexpr int DIN = 2824, DING = 2816, FF = 4096;
constexpr int C_U = 0, C_V = 256, C_BG = 512, C_CG = 768, C_HB = 1024, C_Z = 1280, C_XBC = 1792, C_DT = 2816;
constexpr float EPS = 1e-5f;
constexpr size_t O_YP = 0, O_YS = 16777216, O_CVP = 17825792, O_CP = 18874368, O_SCP = 18890752, O_SP = 18989056, O_CVS = 21086208, O_CS = 22134784, O_SCS = 22396928, O_SS = 23969792, O_END = 57524224;
enum { I_XP = 0, I_XS, I_SC, I_SSC, I_SSM, I_N1, I_WIN, I_WS, I_BS, I_CW, I_SCW, I_SCB, I_DTB, I_ALOG, I_DSK, I_SSN, I_WOUT, I_N2, I_W1, I_W2, I_FN, N_IN };

constexpr size_t al256(size_t x) { return (x + 255) & ~(size_t)255; }
constexpr size_t WS_CTL = 0, CTL_ZERO_BYTES = 1u << 20;
constexpr size_t WS_WIN = CTL_ZERO_BYTES;
constexpr size_t WS_WOUT = WS_WIN + (size_t)DEPTH * DING * DM * 2;
constexpr size_t WS_W1 = WS_WOUT + (size_t)DEPTH * DM * DM * 2;
constexpr size_t WS_W2 = WS_W1 + (size_t)DEPTH * FF * DM * 2;
constexpr size_t WS_WDT = WS_W2 + (size_t)DEPTH * DM * FF * 2;
constexpr size_t WS_WDTB = WS_WDT + (size_t)DEPTH * DM * 8 * 4;
constexpr size_t WS_WMB = WS_WDTB + (size_t)DEPTH * 64 * DM * 2;
constexpr size_t WS_XB = WS_WMB + (size_t)DEPTH * 4 * 128 * 128 * 2;
constexpr size_t WS_SS1 = WS_XB + (size_t)M * DM * 2;
constexpr size_t WS_SS2 = WS_SS1 + (size_t)M * 16 * 4;
constexpr size_t WS_SSX1 = WS_SS2 + (size_t)M * 16 * 4;
constexpr size_t WS_SSX2 = WS_SSX1 + (size_t)MS * 32 * 4;
constexpr size_t WS_DT = WS_SSX2 + (size_t)MS * 32 * 4;
constexpr size_t WS_CUM = WS_DT + (size_t)M * 8 * 4;
constexpr size_t WS_SSG = WS_CUM + (size_t)M * 8 * 4;
constexpr size_t WS_CD = WS_SSG + (size_t)M * 2 * 4;
constexpr size_t WS_YCAT = WS_CD + 64 * 16 * 4;
constexpr size_t WS_YS = WS_YCAT + (size_t)M * DM * 2;
constexpr size_t WS_XBCS = WS_YS + (size_t)MS * 512 * 4;
constexpr size_t WS_XBCB = WS_XBCS + (size_t)MS * DM * 4;
constexpr size_t WS_SBUF = WS_XBCB + (size_t)MP * DM * 2;
constexpr size_t WS_HB = WS_SBUF + (size_t)64 * 16 * 8192 * 4;
constexpr size_t WS_PROJ = WS_HB + (size_t)64 * 16 * 8192 * 2;
constexpr size_t WS_HID = WS_PROJ + (size_t)M * DING * 2;
constexpr size_t WS_END = WS_HID + (size_t)M * FF * 2;
static_assert(WS_PROJ + (size_t)M * DING * 2 <= WS_END, "HID overlay");
static_assert(WS_WIN % 256 == 0 && WS_XB % 256 == 0 && WS_SS1 % 256 == 0 && WS_PROJ % 256 == 0 && WS_XBCB % 256 == 0 && WS_SBUF % 256 == 0 && WS_HB % 256 == 0 && WS_YCAT % 256 == 0 && WS_WMB % 256 == 0, "align");
constexpr int CW_BAR = 4096;
#ifndef CVT_SHARES
#define CVT_SHARES 0, 0, 1, 1, 2, 2, 3, 3
#endif
__device__ __forceinline__ constexpr int CVT_SHARE(int j) { constexpr int t[8] = {CVT_SHARES}; return t[j]; }

constexpr int RING_BYTES = 131072, PHASE_LDS = 147456, LDSCTL_OFF = PHASE_LDS, MISC_OFF = LDSCTL_OFF + 320, LDS_BYTES = 151552;

#define GAS __attribute__((address_space(1)))
#define LAS __attribute__((address_space(3)))
typedef unsigned short bf16;
typedef unsigned v4u __attribute__((ext_vector_type(4)));
typedef unsigned v2u __attribute__((ext_vector_type(2)));
typedef float f32x4 __attribute__((ext_vector_type(4)));
typedef GAS unsigned gu32;
#define RLX_AGENT __ATOMIC_RELAXED, __HIP_MEMORY_SCOPE_AGENT
#define LDS_WAIT() asm volatile("s_waitcnt lgkmcnt(0)" ::: "memory")
#define LAUNDER_V(x) asm volatile("" : "+v"(x))
#define LAUNDER_S(x) asm volatile("" : "+s"(x))
__device__ __forceinline__ unsigned f2bf(float f) { unsigned u = __builtin_bit_cast(unsigned, f); return (u + 0x7fffu + ((u >> 16) & 1u)) >> 16; }
__device__ __forceinline__ unsigned pk2(float lo, float hi) { return f2bf(lo) | (f2bf(hi) << 16); }
__device__ __forceinline__ float bf2f(unsigned b) { return __builtin_bit_cast(float, b << 16); }
__device__ __forceinline__ float bflo(unsigned w) { return __builtin_bit_cast(float, w << 16); }
__device__ __forceinline__ float bfhi(unsigned w) { return __builtin_bit_cast(float, w & 0xffff0000u); }

#define XB_TMO      128
#define XB_XCNT(j)  (256  + 64 * (j))
#define XB_XSUB(j)  (1280 + 64 * (j))
#define XB_XGEN(j)  (2304 + 64 * (j))
#define XB_TOP      3328
#define XB_TOPGEN   3392
#define XB_HTOP(h)  (3456 + 128 * (h))
#define XCD_BAR_WORDS 3712
#define XB_SPIN_CAP (1u << 18)
__device__ __forceinline__ unsigned xb_ld(unsigned* p)              { return __hip_atomic_load(p, __ATOMIC_RELAXED, __HIP_MEMORY_SCOPE_AGENT); }
__device__ __forceinline__ unsigned xb_add(unsigned* p, unsigned v) { return __hip_atomic_fetch_add(p, v, __ATOMIC_RELAXED, __HIP_MEMORY_SCOPE_AGENT); }
__device__ __forceinline__ unsigned xb_xcc_id() { return (unsigned)__builtin_amdgcn_s_getreg((3 << 11) | 20) & 0xFu; }
#define XB_SPIN(cond, bar) do { unsigned _sp = 0; while (cond) { __builtin_amdgcn_s_sleep(1); \
    if ((++_sp & 255u) == 0u) { if (xb_ld(&(bar)[XB_TMO])) break; if (_sp > XB_SPIN_CAP) { atomicAdd(&(bar)[XB_TMO], 1u); break; } } } } while (0)
struct XcdBarrier { unsigned* bar; unsigned x; volatile LAS unsigned* st; };
__device__ __forceinline__ XcdBarrier xcd_barrier_post(unsigned* bar, volatile LAS unsigned* st) {
    XcdBarrier b; b.bar = bar; b.x = xb_xcc_id(); b.st = st;
    if (threadIdx.x == 0) st[2] = xb_add(&bar[XB_XCNT(b.x)], 1u) + 1u;
    return b;
}
__device__ __forceinline__ void xcd_barrier_complete(unsigned* bar, unsigned x, unsigned& nloc, unsigned& nx, unsigned& even) {
    const unsigned G = gridDim.x * gridDim.y * gridDim.z;
    asm volatile("" : "+s"(x));
    unsigned sum, cnt, mine, sp = 0u;
    for (;;) {
        sum = 0u; cnt = 0u; mine = 0u;
#pragma unroll
        for (unsigned j = 0; j < 16; ++j) { const unsigned c = xb_ld(&bar[XB_XCNT(j)]); sum += c; cnt += (c > 0u) ? 1u : 0u; mine = (j == x) ? c : mine; }
        if (sum == G) break;
        __builtin_amdgcn_s_sleep(1);
        if ((++sp & 255u) == 0u) { if (xb_ld(&bar[XB_TMO])) break; if (sp > XB_SPIN_CAP) { atomicAdd(&bar[XB_TMO], 1u); break; } }
    }
    nloc = mine > 0u ? mine : 1u; nx = cnt > 0u ? cnt : 1u;
    bool ev = (G == 256u) && (cnt == 8u);
#pragma unroll
    for (unsigned j = 0; j < 8; ++j) ev = ev && (xb_ld(&bar[XB_XCNT(j)]) == 32u);
    even = ev ? 1u : 2u;
}
__device__ __forceinline__ void xcd_barrier(const XcdBarrier& b, const bool local = false, const int half = -1, unsigned* wflag = nullptr, const unsigned wneed = 0u, const bool sig = false) {
    asm volatile("s_waitcnt vmcnt(0)" ::: "memory");
    __syncthreads();
    if (threadIdx.x == 0) {
        unsigned* bar = b.bar;
        __builtin_amdgcn_s_waitcnt(0);
        unsigned nloc = b.st[0], nx = b.st[1];
        if (nloc == 0u) { unsigned ev_; xcd_barrier_complete(bar, b.x, nloc, nx, ev_); b.st[0] = nloc; b.st[1] = nx; b.st[3] = ev_; }
        const unsigned topi = half >= 0 ? (unsigned)XB_HTOP(half) : (unsigned)XB_TOP; if (half >= 0) nx = 4u;
        const unsigned old = xb_add(&bar[XB_XSUB(b.x)], 1u);
        const unsigned gen = old / nloc;
        if (local) {
            if (old + 1u == (gen + 1u) * nloc) {
                if (sig) {
                    __builtin_amdgcn_fence(__ATOMIC_RELEASE, "agent"); asm volatile("s_waitcnt vmcnt(0)" ::: "memory");
                    const unsigned oc = xb_add(&bar[XB_HTOP(0)], 1u); if (oc + 1u == 8u) xb_add(&bar[XB_HTOP(0) + 64], 1u); }
                if (wneed) XB_SPIN(xb_ld(wflag) < wneed, bar);
                xb_add(&bar[XB_XGEN(b.x)], 1u); }
            else XB_SPIN(xb_ld(&bar[XB_XGEN(b.x)]) == gen, bar);
            __builtin_amdgcn_fence(__ATOMIC_ACQUIRE, "agent");
            asm volatile("s_waitcnt vmcnt(0)" ::: "memory");
        } else if (old + 1u == (gen + 1u) * nloc) {
            __builtin_amdgcn_fence(__ATOMIC_RELEASE, "agent");
            asm volatile("s_waitcnt vmcnt(0)" ::: "memory");
            const unsigned og = xb_add(&bar[topi], 1u);
            const unsigned tg = og / nx;
            if (og + 1u == (tg + 1u) * nx) xb_add(&bar[topi + 64u], 1u);
            else XB_SPIN(xb_ld(&bar[topi + 64u]) == tg, bar);
            if (wneed) XB_SPIN(xb_ld(wflag) < wneed, bar);
            __builtin_amdgcn_fence(__ATOMIC_ACQUIRE, "agent");
            xb_add(&bar[XB_XGEN(b.x)], 1u);
            asm volatile("s_waitcnt vmcnt(0)" ::: "memory");
        } else {
            XB_SPIN(xb_ld(&bar[XB_XGEN(b.x)]) == gen, bar);
            __builtin_amdgcn_fence(__ATOMIC_ACQUIRE, "agent");
            asm volatile("s_waitcnt vmcnt(0)" ::: "memory");
        }
    }
    __syncthreads();
}

struct Args { const float* in[N_IN]; float* out; unsigned char* ws; int ph_lo, ph_hi; };
struct Frame {
    LAS unsigned char* lds;
    int tid, lane, wave, vcu, G, bid;
    const __attribute__((address_space(4))) Args* ap; float* out; unsigned char* ws;
    __device__ __forceinline__ const float* inp(int i) const { return ap->in[i]; }
};
__device__ __forceinline__ float wave_sum(float v) {
    v += xswz<1>(v); v += xswz<2>(v); v += xswz<4>(v); v += xswz<8>(v); v += xswz<16>(v); v = sum_halves(v);
    return v;
}
__device__ __forceinline__ float silu_f(float v) { return v * __builtin_amdgcn_rcpf(1.0f + __expf(-v)); }
struct CvtItem { const float* W; const float* gain; bf16* WT; int ldw, K, gain_n, krot, k0, n0; };
struct CvtRegs { f32x4 w[8]; float g; };
__device__ __forceinline__ CvtItem cvt_item(const Frame& F, int it) {
    constexpr int I_IN = (DM / 64) * (DING / 32), I_O = (DM / 64) * (DM / 32), I_1 = (DM / 64) * (FF / 32), I_2 = (FF / 64) * (DM / 32), I_L = I_IN + I_O + I_1 + I_2;
    const int l = it / I_L; int r = it % I_L; CvtItem d; int nblk;
    if (r < I_IN) { d.W = F.inp(I_WIN) + (size_t)l * DM * DIN; d.ldw = DIN; d.K = DM; nblk = DING / 32; d.gain = F.inp(I_N1) + l * DM; d.gain_n = DM; d.krot = 0; d.WT = (bf16*)(F.ws + WS_WIN) + (size_t)l * DING * DM; }
    else if ((r -= I_IN) < I_O) { d.W = F.inp(I_WOUT) + (size_t)l * DM * DM; d.ldw = DM; d.K = DM; nblk = DM / 32; d.gain = F.inp(I_SSN) + l * 512; d.gain_n = 512; d.krot = 512; d.WT = (bf16*)(F.ws + WS_WOUT) + (size_t)l * DM * DM; }
    else if ((r -= I_O) < I_1) { d.W = F.inp(I_W1) + (size_t)l * DM * FF; d.ldw = FF; d.K = DM; nblk = FF / 32; d.gain = F.inp(I_N2) + l * DM; d.gain_n = DM; d.krot = 0; d.WT = (bf16*)(F.ws + WS_W1) + (size_t)l * FF * DM; }
    else { r -= I_1; d.W = F.inp(I_W2) + (size_t)l * FF * DM; d.ldw = DM; d.K = FF; nblk = DM / 32; d.gain = F.inp(I_N1); d.gain_n = 0; d.krot = 0; d.WT = (bf16*)(F.ws + WS_W2) + (size_t)l * DM * FF; }
    d.k0 = 64 * (r / nblk); d.n0 = 32 * (r % nblk);
    return d;
}
__device__ __forceinline__ void cvt_load(const CvtItem& d, CvtRegs& R, int lane) {
    const int gmask = d.gain_n > 0 ? d.gain_n - 1 : 0;
#pragma unroll
    for (int s8 = 0; s8 < 8; ++s8) { const int ks = (d.k0 + 8 * s8 + (lane >> 3) + d.krot) & (d.K - 1); R.w[s8] = *(const f32x4*)(d.W + (size_t)ks * d.ldw + d.n0 + 4 * (lane & 7)); }
    R.g = d.gain[(d.k0 + lane) & gmask];
}
__device__ __forceinline__ void cvt_finish(const CvtItem& d, const CvtRegs& R, LAS float* scr, int lane) {
    const float gl = (d.k0 + lane < d.gain_n) ? R.g : 1.0f;
#pragma unroll
    for (int s8 = 0; s8 < 8; ++s8) { const int kk = 8 * s8 + (lane >> 3);
        const float g = __builtin_bit_cast(float, __builtin_amdgcn_ds_bpermute(4 * kk, __builtin_bit_cast(int, gl)));
        LAS float* q = scr + kk * 33 + 4 * (lane & 7); const f32x4 v = R.w[s8] * g; q[0] = v.x; q[1] = v.y; q[2] = v.z; q[3] = v.w; }
    LDS_WAIT(); asm volatile("" ::: "memory");
    const int c = lane & 7;
#pragma unroll
    for (int j = 0; j < 4; ++j) { const int n = (lane >> 3) + 8 * j; const LAS float* sp = scr + (8 * c) * 33 + n;
        v4u o; o.x = pk2(sp[0 * 33], sp[1 * 33]); o.y = pk2(sp[2 * 33], sp[3 * 33]); o.z = pk2(sp[4 * 33], sp[5 * 33]); o.w = pk2(sp[6 * 33], sp[7 * 33]);
        *(v4u*)(d.WT + (size_t)(d.n0 + n) * d.K + d.k0 + 8 * c) = o; }
    LDS_WAIT(); asm volatile("" ::: "memory");
}
__device__ __forceinline__ const float* xin_row(const Frame& F, int l, int r) {
    if (l == 0) return r < MP ? F.inp(I_XP) + (size_t)r * DM : F.inp(I_XS) + (size_t)(r - MP) * DM;
    return F.out + (size_t)r * DM;
}
__device__ __forceinline__ void p0_prologue(const Frame& F, const int role, const int blo = 0, const int bhi = 0) {
    LAS float* scr = (LAS float*)(F.lds + F.wave * 16384);
    constexpr int I_IN = (DM / 64) * (DING / 32), I_O = (DM / 64) * (DM / 32), I_1 = (DM / 64) * (FF / 32), I_2 = (FF / 64) * (DM / 32), I_L = I_IN + I_O + I_1 + I_2;
    const int gw = role == 4 ? (F.vcu & 31) * NWAVES + F.wave : F.vcu * NWAVES + F.wave, NGW = role == 4 ? 32 * NWAVES : F.G * NWAVES;
    const int it_lo = role == 4 ? blo : 0, it_hi = role == 4 ? bhi : (role == 3 ? I_IN : DEPTH * I_L);
    {
        CvtRegs R0, R1, R2; const int j0 = it_lo + gw;
        if (j0 < it_hi) cvt_load(cvt_item(F, j0), R0, F.lane);
        if (j0 + NGW < it_hi) cvt_load(cvt_item(F, j0 + NGW), R1, F.lane);
        if (j0 + 2 * NGW < it_hi) cvt_load(cvt_item(F, j0 + 2 * NGW), R2, F.lane);
#pragma unroll 1
        for (int it = j0; it < it_hi; it += 3 * NGW) {
            cvt_finish(cvt_item(F, it), R0, scr, F.lane); if (it + 3 * NGW < it_hi) cvt_load(cvt_item(F, it + 3 * NGW), R0, F.lane);
            if (it + NGW < it_hi) { cvt_finish(cvt_item(F, it + NGW), R1, scr, F.lane); if (it + 4 * NGW < it_hi) cvt_load(cvt_item(F, it + 4 * NGW), R1, F.lane); }
            if (it + 2 * NGW < it_hi) { cvt_finish(cvt_item(F, it + 2 * NGW), R2, scr, F.lane); if (it + 5 * NGW < it_hi) cvt_load(cvt_item(F, it + 5 * NGW), R2, F.lane); }
        }
    }
    const int gt = gw * 64 + F.lane, NGT = NGW * 64;
    if (role != 4) {
    for (int i = gt; i < DEPTH * DM * 8; i += NGT) { const int l = i / (DM * 8), k = (i / 8) % DM, j = i % 8;
        ((float*)(F.ws + WS_WDT))[i] = F.inp(I_N1)[l * DM + k] * F.inp(I_WIN)[((size_t)l * DM + k) * DIN + C_DT + j]; }
    for (int i = gt; i < DEPTH * 64 * DM; i += NGT) { const int l = i / (64 * DM), n = (i / DM) % 64, k = i % DM;
        ((bf16*)(F.ws + WS_WDTB))[i] = n < 8 ? (bf16)f2bf(F.inp(I_N1)[l * DM + k] * F.inp(I_WIN)[((size_t)l * DM + k) * DIN + C_DT + n]) : (bf16)0; }
    for (int i = gt; i < DEPTH * 4 * 128 * 128; i += NGT) { const int t = (i >> 7) & 127, s = i & 127; ((bf16*)(F.ws + WS_WMB))[i] = s <= t ? (bf16)f2bf(F.inp(I_WS)[i]) : (bf16)0; }
    }
    for (int gi = gw; gi < (role == 4 ? 0 : M / 4); gi += NGW) {
        const int r4 = 4 * gi;
        f32x4 v[4][4];
#pragma unroll
        for (int q = 0; q < 4; ++q) { const f32x4* xr = (const f32x4*)xin_row(F, 0, r4 + q) + F.lane;
#pragma unroll
            for (int j = 0; j < 4; ++j) v[q][j] = xr[64 * j]; }
#pragma unroll
        for (int q = 0; q < 4; ++q) { float s = 0.f; v2u* o8 = (v2u*)((bf16*)(F.ws + WS_XB) + (size_t)(r4 + q) * DM) + F.lane;
#pragma unroll
            for (int j = 0; j < 4; ++j) { const f32x4 x = v[q][j]; s += (x.x * x.x + x.y * x.y) + (x.z * x.z + x.w * x.w); v2u w; w.x = pk2(x.x, x.y); w.y = pk2(x.z, x.w); o8[64 * j] = w; }
            s = wave_sum(s);
            if (r4 + q < MP) { if (F.lane < 16) ((float*)(F.ws + WS_SS1))[(size_t)(r4 + q) * 16 + F.lane] = F.lane == 0 ? s : 0.f; }
            else if (F.lane < 32) ((float*)(F.ws + WS_SSX1))[(size_t)(r4 + q - MP) * 32 + F.lane] = F.lane == 0 ? s : 0.f; }
    }
}

typedef float f32x16 __attribute__((ext_vector_type(16)));
typedef short s16x8 __attribute__((ext_vector_type(8)));
constexpr int LDT = 136;
constexpr int YC_YC = 0, YC_YA = 512, YC_YB = 768;
__device__ __forceinline__ f32x16 mma32(const LAS bf16* A, const LAS bf16* B, int K, f32x16 acc, int lane) {
    const LAS bf16* ap = A + (lane & 31) * LDT + 8 * (lane >> 5); const LAS bf16* bp = B + (lane & 31) * LDT + 8 * (lane >> 5);
    for (int k = 0; k < K; k += 16) { const s16x8 a = *(const LAS s16x8*)(ap + k), b = *(const LAS s16x8*)(bp + k); acc = __builtin_amdgcn_mfma_f32_32x32x16_bf16(a, b, acc, 0, 0, 0); }
    return acc;
}
__device__ __forceinline__ int crow(int reg, int half) { return (reg & 3) + 8 * (reg >> 2) + 4 * half; }
__device__ __forceinline__ void unpack8(const v4u w, float (&f)[8]) { f[0] = bflo(w.x); f[1] = bfhi(w.x); f[2] = bflo(w.y); f[3] = bfhi(w.y); f[4] = bflo(w.z); f[5] = bfhi(w.z); f[6] = bflo(w.w); f[7] = bfhi(w.w); }
__device__ __forceinline__ v4u pack8(float a, float b, float c, float d, float e, float f, float g, float h) { v4u w; w.x = pg8::cvt_pk_bf16(a, b); w.y = pg8::cvt_pk_bf16(c, d); w.z = pg8::cvt_pk_bf16(e, f); w.w = pg8::cvt_pk_bf16(g, h); return w; }
__device__ __forceinline__ float rstd_row16(const float* ss, int r) {
    const f32x4* p = (const f32x4*)(ss + (size_t)r * 16); const f32x4 a = p[0], b = p[1], c = p[2], d = p[3];
    const float s = ((a.x + a.y) + (a.z + a.w)) + ((b.x + b.y) + (b.z + b.w)) + ((c.x + c.y) + (c.z + c.w)) + ((d.x + d.y) + (d.z + d.w));
    return 1.0f / sqrtf(s * (1.0f / DM) + EPS);
}

__device__ __forceinline__ void m1_prompt_unit(const Frame& F, int l, int u) {
    const int g = u & 1, c = (u >> 1) & 15, b = u >> 5, r0 = b * SEQ + c * 128;
    int tid = F.tid, lane = F.lane, w = F.wave;
#define M_RELAUNDER() do { LAUNDER_V(tid); lane = tid & 63; w = __builtin_amdgcn_readfirstlane(tid >> 6); } while (0)
    LAS float* rs = (LAS float*)F.lds;
    LAS float* dtl = rs + 128;
    LAS float* cuml = dtl + 1024;
    LAS float* wl = cuml + 1024;
    LAS bf16* XTp = (LAS bf16*)(F.lds + 16384);
    LAS bf16* BmT = XTp + 256 * LDT;
    LAS bf16* VT = XTp;
    LAS bf16* Wl = XTp + 128 * LDT;
    const bf16* PROJ = (const bf16*)(F.ws + WS_PROJ); bf16* YCAT = (bf16*)(F.ws + WS_YCAT); bf16* XBCB = (bf16*)(F.ws + WS_XBCB);
    __syncthreads();
    { const float* DTg = (const float*)(F.ws + WS_DT) + (size_t)r0 * 8; dtl[tid] = DTg[tid]; dtl[tid + 512] = DTg[tid + 512]; }
    __syncthreads();
    M_RELAUNDER();
    if (tid < 8) { const float A = -expf(F.inp(I_ALOG)[l * 8 + tid]); float cs = 0.f;
#pragma unroll 8
        for (int t = 0; t < 128; ++t) { cs += dtl[t * 8 + tid] * A; cuml[t * 8 + tid] = cs; } }
    __syncthreads();
    for (int i = tid; i < 1024; i += NWAVES * 64) { const int t = i >> 3, h = i & 7; const float d = dtl[i], cs = cuml[i], tot = cuml[127 * 8 + h];
        wl[i] = __expf(tot - cs) * d;
        if ((h >> 2) == g) { ((float*)(F.ws + WS_CUM))[(size_t)(r0 + t) * 8 + h] = cs;
            if (t == 127) ((float*)(F.ws + WS_CD))[(b * 8 + h) * 16 + c] = __expf(tot); } }
    __syncthreads();
    M_RELAUNDER();
    {
        const float* scw = F.inp(I_SCW) + l * 4 * 1024; const float* scb = F.inp(I_SCB) + l * 1024;
        const int co = tid & 63, tg = w, t0 = 16 * tg;
        const int ch = co < 32 ? 256 * g + 8 * co : (co < 48 ? 512 + 128 * g + 8 * (co - 32) : 768 + 128 * g + 8 * (co - 48));
        v4u xr[19];
#pragma unroll
        for (int i = 0; i < 19; ++i) { const int t = t0 - 3 + i;
            if (t >= 0 || c > 0) xr[i] = *(const v4u*)(PROJ + (size_t)(r0 + t) * DING + C_XBC + ch); else xr[i] = (v4u){0u, 0u, 0u, 0u}; }
        float wk[4][8], bias[8];
#pragma unroll
        for (int k = 0; k < 4; ++k) { const f32x4 a = *(const f32x4*)(scw + k * 1024 + ch), bq = *(const f32x4*)(scw + k * 1024 + ch + 4); wk[k][0] = a.x; wk[k][1] = a.y; wk[k][2] = a.z; wk[k][3] = a.w; wk[k][4] = bq.x; wk[k][5] = bq.y; wk[k][6] = bq.z; wk[k][7] = bq.w; }
        { const f32x4 a = *(const f32x4*)(scb + ch), bq = *(const f32x4*)(scb + ch + 4); bias[0] = a.x; bias[1] = a.y; bias[2] = a.z; bias[3] = a.w; bias[4] = bq.x; bias[5] = bq.y; bias[6] = bq.z; bias[7] = bq.w; }
        asm volatile("" ::: "memory");
        if (c == 15 && tg == 7) {
#pragma unroll
            for (int i = 16; i < 19; ++i) { float xv[8]; unpack8(xr[i], xv); float* dst = F.out + O_SCP + ((size_t)(l * NB + b) * 3 + (i - 16)) * 1024 + ch;
                *(f32x4*)dst = (f32x4){xv[0], xv[1], xv[2], xv[3]}; *(f32x4*)(dst + 4) = (f32x4){xv[4], xv[5], xv[6], xv[7]}; }
        }
#pragma unroll
        for (int q = 0; q < 4; ++q) {
            float x[7][8];
#pragma unroll
            for (int i = 0; i < 7; ++i) unpack8(xr[4 * q + i], x[i]);
            float o[4][8];
#pragma unroll
            for (int tt = 0; tt < 4; ++tt) {
#pragma unroll
                for (int j = 0; j < 8; ++j) { const float v = bias[j] + wk[0][j] * x[tt][j] + wk[1][j] * x[tt + 1][j] + wk[2][j] * x[tt + 2][j] + wk[3][j] * x[tt + 3][j]; o[tt][j] = silu_f(v); }
                *(v4u*)(XBCB + (size_t)(r0 + t0 + 4 * q + tt) * DM + ch) = pack8(o[tt][0], o[tt][1], o[tt][2], o[tt][3], o[tt][4], o[tt][5], o[tt][6], o[tt][7]); }
            if (co < 32) { const int h = 4 * g + (co >> 3); float sc[4];
#pragma unroll
                for (int tt = 0; tt < 4; ++tt) sc[tt] = wl[(t0 + 4 * q + tt) * 8 + h];
#pragma unroll
                for (int j = 0; j < 8; ++j) { v2u pw; pw.x = pg8::cvt_pk_bf16(o[0][j] * sc[0], o[1][j] * sc[1]); pw.y = pg8::cvt_pk_bf16(o[2][j] * sc[2], o[3][j] * sc[3]); *(LAS v2u*)(XTp + (8 * co + j) * LDT + t0 + 4 * q) = pw; }
            } else if (co < 48) {
#pragma unroll
                for (int j = 0; j < 8; ++j) { v2u pw; pw.x = pg8::cvt_pk_bf16(o[0][j], o[1][j]); pw.y = pg8::cvt_pk_bf16(o[2][j], o[3][j]); *(LAS v2u*)(BmT + (8 * (co - 32) + j) * LDT + t0 + 4 * q) = pw; }
            }
        }
    }
    __syncthreads();
    M_RELAUNDER();
    {
        const int pb = w >> 2, nb = w & 3; bf16* SB = (bf16*)(F.ws + WS_SBUF);
#pragma unroll 1
        for (int hl = 0; hl < 4; ++hl) {
            f32x16 acc;
#pragma unroll
            for (int i = 0; i < 16; ++i) acc[i] = 0.f;
            acc = mma32(XTp + (hl * 64 + 32 * pb) * LDT, BmT + (32 * nb) * LDT, 128, acc, lane);
            bf16* dst = SB + (((size_t)(b * 8 + 4 * g + hl) * 16 + c) * 64 + 32 * pb) * 128 + 32 * nb + (lane & 30);
            const bool odd = (lane & 1) != 0;
#pragma unroll
            for (int reg = 0; reg < 16; reg += 2) { const float a0 = acc[reg], a1 = acc[reg + 1], n0 = xswz<1>(a0), n1 = xswz<1>(a1);
                const unsigned pw = pg8::cvt_pk_bf16(odd ? n1 : a0, odd ? a1 : n0);
                *(unsigned*)(dst + (crow(reg, lane >> 5) + (odd ? 1 : 0)) * 128) = pw; }
        }
    }
    __syncthreads();
    M_RELAUNDER();
    {
        LAS bf16* Wl2 = Wl + 128 * LDT;
        { const int eo = tid & 15, tq = tid >> 4, t0 = 4 * tq, col = C_V + 128 * g + 8 * eo; float vv[4][8];
#pragma unroll
            for (int tt = 0; tt < 4; ++tt) unpack8(*(const v4u*)(PROJ + (size_t)(r0 + t0 + tt) * DING + col), vv[tt]);
            const bf16* wsrc = (const bf16*)(F.ws + WS_WMB) + (size_t)(l * 4 + 2 * g) * 128 * 128; v4u wv[8];
#pragma unroll
            for (int j = 0; j < 8; ++j) { const int i = tid + 512 * j; wv[j] = *(const v4u*)(wsrc + (size_t)i * 8); }
            asm volatile("" ::: "memory");
#pragma unroll
            for (int j = 0; j < 8; ++j) { v2u pw; pw.x = pg8::cvt_pk_bf16(vv[0][j], vv[1][j]); pw.y = pg8::cvt_pk_bf16(vv[2][j], vv[3][j]); *(LAS v2u*)(VT + (8 * eo + j) * LDT + t0) = pw; }
            if (c == 15) {
#pragma unroll
                for (int tt = 0; tt < 4; ++tt) { float* dst = F.out + O_CVP + ((size_t)(l * NB + b) * 128 + t0 + tt) * 256 + 128 * g + 8 * eo;
                    *(f32x4*)dst = (f32x4){vv[tt][0], vv[tt][1], vv[tt][2], vv[tt][3]}; *(f32x4*)(dst + 4) = (f32x4){vv[tt][4], vv[tt][5], vv[tt][6], vv[tt][7]}; } }
#pragma unroll
            for (int j = 0; j < 8; ++j) { const int i = tid + 512 * j, hh = i >> 11, row = (i >> 4) & 127, ck = i & 15; *(LAS v4u*)((hh ? Wl2 : Wl) + row * LDT + 8 * ck) = wv[j]; }
        }
        __syncthreads();
        const int tb = w & 3, eh = w >> 2;
#pragma unroll
        for (int hh = 0; hh < 2; ++hh) {
            const int ha = 2 * g + hh;
            f32x16 acc;
#pragma unroll
            for (int i = 0; i < 16; ++i) acc[i] = 0.f;
            acc = mma32((hh ? Wl2 : Wl) + (32 * tb) * LDT, VT + (hh * 64 + 32 * eh) * LDT, 32 * (tb + 1), acc, lane);
            const int e = 32 * eh + (lane & 31), col = ha * 64 + e; const float* bsv = F.inp(I_BS) + (l * 4 + ha) * 128;
            unsigned ur[16]; f32x4 bq[4];
#pragma unroll
            for (int reg = 0; reg < 16; ++reg) ur[reg] = PROJ[(size_t)(r0 + 32 * tb + crow(reg, lane >> 5)) * DING + C_U + col];
#pragma unroll
            for (int q4 = 0; q4 < 4; ++q4) bq[q4] = *(const f32x4*)(bsv + 32 * tb + 8 * q4 + 4 * (lane >> 5));
#pragma unroll
            for (int reg = 0; reg < 16; ++reg) { const int t = 32 * tb + crow(reg, lane >> 5); const float sv = acc[reg] + bq[reg >> 2][reg & 3];
                YCAT[(size_t)(r0 + t) * DM + YC_YA + col] = (bf16)f2bf(bf2f(ur[reg]) * sv); }
        }
        __syncthreads();
    }
    M_RELAUNDER();
    {
        const int co = tid & 15, tq = tid >> 4, t0 = 4 * tq, ch = 128 * g + 8 * co; const float* cw = F.inp(I_CW) + l * 3 * 256 + ch;
        v4u ra[6], rh[6], rb[4];
#pragma unroll
        for (int i = 0; i < 6; ++i) { const int t = t0 - 2 + i;
            if (t >= 0 || c > 0) { ra[i] = *(const v4u*)(PROJ + (size_t)(r0 + t) * DING + C_CG + ch); rh[i] = *(const v4u*)(PROJ + (size_t)(r0 + t) * DING + C_HB + ch); }
            else { ra[i] = (v4u){0u, 0u, 0u, 0u}; rh[i] = (v4u){0u, 0u, 0u, 0u}; } }
#pragma unroll
        for (int tt = 0; tt < 4; ++tt) rb[tt] = *(const v4u*)(PROJ + (size_t)(r0 + t0 + tt) * DING + C_BG + ch);
        asm volatile("" ::: "memory");
        float w0[8], w1[8], w2[8];
        { const f32x4 a = *(const f32x4*)cw, bq = *(const f32x4*)(cw + 4); w0[0] = a.x; w0[1] = a.y; w0[2] = a.z; w0[3] = a.w; w0[4] = bq.x; w0[5] = bq.y; w0[6] = bq.z; w0[7] = bq.w; }
        { const f32x4 a = *(const f32x4*)(cw + 256), bq = *(const f32x4*)(cw + 260); w1[0] = a.x; w1[1] = a.y; w1[2] = a.z; w1[3] = a.w; w1[4] = bq.x; w1[5] = bq.y; w1[6] = bq.z; w1[7] = bq.w; }
        { const f32x4 a = *(const f32x4*)(cw + 512), bq = *(const f32x4*)(cw + 516); w2[0] = a.x; w2[1] = a.y; w2[2] = a.z; w2[3] = a.w; w2[4] = bq.x; w2[5] = bq.y; w2[6] = bq.z; w2[7] = bq.w; }
        float cin[6][8];
#pragma unroll
        for (int i = 0; i < 6; ++i) { float a[8], hb[8]; unpack8(ra[i], a); unpack8(rh[i], hb);
#pragma unroll
            for (int j = 0; j < 8; ++j) cin[i][j] = a[j] * hb[j]; }
#pragma unroll
        for (int tt = 0; tt < 4; ++tt) { float bg[8], yb[8]; unpack8(rb[tt], bg);
#pragma unroll
            for (int j = 0; j < 8; ++j) yb[j] = bg[j] * (w0[j] * cin[tt][j] + w1[j] * cin[tt + 1][j] + w2[j] * cin[tt + 2][j]);
            *(v4u*)(YCAT + (size_t)(r0 + t0 + tt) * DM + YC_YB + ch) = pack8(yb[0], yb[1], yb[2], yb[3], yb[4], yb[5], yb[6], yb[7]); }
        if (c == 15 && tq == 31) {
#pragma unroll
            for (int tt = 2; tt < 4; ++tt) { float* dst = F.out + O_CP + ((size_t)(l * NB + b) * 2 + (tt - 2)) * 256 + ch;
                *(f32x4*)dst = (f32x4){cin[tt + 2][0], cin[tt + 2][1], cin[tt + 2][2], cin[tt + 2][3]}; *(f32x4*)(dst + 4) = (f32x4){cin[tt + 2][4], cin[tt + 2][5], cin[tt + 2][6], cin[tt + 2][7]}; } }
    }
}

__device__ __forceinline__ void m2_scan_unit(const Frame& F, int l, int u) {
    const int bh = u >> 2, pq = u & 3, tid = F.tid, p = 16 * pq + (tid >> 5), n = 4 * (tid & 31);
    const bf16* SB = (const bf16*)(F.ws + WS_SBUF) + ((size_t)bh * 16 * 64 + p) * 128 + n; const float* CD = (const float*)(F.ws + WS_CD) + bh * 16;
    bf16* HB = (bf16*)(F.ws + WS_HB) + ((size_t)bh * 16 * 64 + p) * 128 + n;
    f32x4 S[16]; float cd[16];
#pragma unroll
    for (int c = 0; c < 16; ++c) { const v2u sw = *(const v2u*)(SB + (size_t)c * 8192); S[c] = (f32x4){bflo(sw.x), bfhi(sw.x), bflo(sw.y), bfhi(sw.y)}; cd[c] = CD[c]; }
    f32x4 H = (f32x4){0.f, 0.f, 0.f, 0.f};
#pragma unroll
    for (int c = 0; c < 16; ++c) {
        if (c > 0) { v2u o; o.x = pg8::cvt_pk_bf16(H.x, H.y); o.y = pg8::cvt_pk_bf16(H.z, H.w); *(v2u*)(HB + (size_t)c * 8192) = o; }
        H = H * cd[c] + S[c];
    }
    *(f32x4*)(F.out + O_SP + ((size_t)l * 64 + bh) * 8192 + p * 128 + n) = H;
}

__device__ __forceinline__ void ssd_sample_quad(const Frame& F, int l, int u0) {
    const int tid = F.tid, gq = tid >> 7, tl = tid & 127, p = tl >> 1, nh = tl & 1, u = u0 + gq, s = u >> 3, h = u & 7, g = h >> 2, r0 = s * DSEQ;
    LAS float* base = (LAS float*)F.lds + gq * 2688;
    LAS float* Xs = base;
    LAS float* Bs = Xs + 512;
    LAS float* Cs = Bs + 1024;
    LAS float* cbs = Cs + 1024;
    LAS float* sm = cbs + 64;
    const float* XBCS = (const float*)(F.ws + WS_XBCS); const float* DT = (const float*)(F.ws + WS_DT);
    const float* h0 = F.inp(I_SSM) + ((size_t)(l * NDB + s) * 8 + h) * 8192 + p * 128 + 64 * nh;
    __syncthreads();
    f32x4 H[16];
#pragma unroll
    for (int i = 0; i < 16; ++i) H[i] = *(const f32x4*)(h0 + 4 * i);
    f32x4 xv_, bv_[2], cv_[2]; float dv_[8];
    xv_ = *(const f32x4*)(XBCS + (size_t)(r0 + (tl >> 4)) * 1024 + h * 64 + 4 * (tl & 15));
#pragma unroll
    for (int j = 0; j < 2; ++j) { const int i = tl + 128 * j, t = i >> 5, q = i & 31;
        bv_[j] = *(const f32x4*)(XBCS + (size_t)(r0 + t) * 1024 + 512 + g * 128 + 4 * q); cv_[j] = *(const f32x4*)(XBCS + (size_t)(r0 + t) * 1024 + 768 + g * 128 + 4 * q); }
#pragma unroll
    for (int t2 = 0; t2 < 8; ++t2) dv_[t2] = DT[(size_t)(MP + r0 + t2) * 8 + h];
    const float A = -expf(F.inp(I_ALOG)[l * 8 + h]);
    asm volatile("" ::: "memory");
    *(LAS f32x4*)(Xs + 4 * tl) = xv_;
#pragma unroll
    for (int j = 0; j < 2; ++j) { const int i = tl + 128 * j; *(LAS f32x4*)(Bs + 4 * i) = bv_[j]; *(LAS f32x4*)(Cs + 4 * i) = cv_[j]; }
    if (tl < 8) {
        float cs = 0.f, c7 = 0.f, d = 0.f;
#pragma unroll
        for (int t2 = 0; t2 < 8; ++t2) { const float dd = dv_[t2]; c7 += dd * A; if (t2 <= tl) cs += dd * A; if (t2 == tl) d = dd; }
        sm[tl] = d; sm[8 + tl] = cs; sm[16 + tl] = __expf(cs); sm[24 + tl] = __expf(c7 - cs) * d;
    }
    __syncthreads();
    {
        const int t = p >> 3, s2 = p & 7; float a = 0.f;
#pragma unroll
        for (int i = 0; i < 16; ++i) { const f32x4 cv = *(const LAS f32x4*)(Cs + t * 128 + 64 * nh + 4 * i), bv = *(const LAS f32x4*)(Bs + s2 * 128 + 64 * nh + 4 * i); a += (cv.x * bv.x + cv.y * bv.y) + (cv.z * bv.z + cv.w * bv.w); }
        a += xswz<1>(a);
        if (nh == 0) cbs[p] = s2 <= t ? a * __expf(sm[8 + t] - sm[8 + s2]) * sm[s2] : 0.f;
    }
    __syncthreads();
    const float dsk = F.inp(I_DSK)[l * 8 + h];
    float* Yo = (float*)(F.ws + WS_YS) + (size_t)r0 * 512 + h * 64 + p;
#pragma unroll
    for (int t = 0; t < 8; ++t) {
        float a = 0.f;
#pragma unroll
        for (int i = 0; i < 16; ++i) { const f32x4 cv = *(const LAS f32x4*)(Cs + t * 128 + 64 * nh + 4 * i); a += (H[i].x * cv.x + H[i].y * cv.y) + (H[i].z * cv.z + H[i].w * cv.w); }
        a += xswz<1>(a);
        float y = a * sm[16 + t] + dsk * Xs[t * 64 + p];
#pragma unroll
        for (int s2 = 0; s2 <= t; ++s2) y += cbs[t * 8 + s2] * Xs[s2 * 64 + p];
        if ((t & 1) == nh) Yo[(size_t)t * 512] = y;
    }
    const float e7 = sm[16 + 7];
#pragma unroll
    for (int i = 0; i < 16; ++i) H[i] = H[i] * e7;
#pragma unroll
    for (int s2 = 0; s2 < 8; ++s2) { const float cx = sm[24 + s2] * Xs[s2 * 64 + p];
#pragma unroll
        for (int i = 0; i < 16; ++i) H[i] += *(const LAS f32x4*)(Bs + s2 * 128 + 64 * nh + 4 * i) * cx; }
    float* ho = F.out + O_SS + ((size_t)(l * NDB + s) * 8 + h) * 8192 + p * 128 + 64 * nh;
#pragma unroll
    for (int i = 0; i < 16; ++i) *(f32x4*)(ho + 4 * i) = H[i];
}

__device__ __forceinline__ void m2_combined(const Frame& F, int l, int us, int u0) {
    const int tid = F.tid, gq = tid >> 7, tl = tid & 127, p = tl >> 1, nh = tl & 1, u = u0 + gq, s = u >> 3, h = u & 7, g = h >> 2, r0 = s * DSEQ;
    LAS float* base = (LAS float*)F.lds + gq * 2688;
    LAS float* Xs = base;
    LAS float* Bs = Xs + 512;
    LAS float* Cs = Bs + 1024;
    LAS float* cbs = Cs + 1024;
    LAS float* sm = cbs + 64;
    const float* XBCS = (const float*)(F.ws + WS_XBCS); const float* DT = (const float*)(F.ws + WS_DT);
    const float* h0 = F.inp(I_SSM) + ((size_t)(l * NDB + s) * 8 + h) * 8192 + p * 128 + 64 * nh;
    __syncthreads();
    f32x4 H[16];
#pragma unroll
    for (int i = 0; i < 16; ++i) H[i] = *(const f32x4*)(h0 + 4 * i);
    f32x4 xv_, bv_[2], cv_[2]; float dv_[8];
    xv_ = *(const f32x4*)(XBCS + (size_t)(r0 + (tl >> 4)) * 1024 + h * 64 + 4 * (tl & 15));
#pragma unroll
    for (int j = 0; j < 2; ++j) { const int i = tl + 128 * j, t = i >> 5, q = i & 31;
        bv_[j] = *(const f32x4*)(XBCS + (size_t)(r0 + t) * 1024 + 512 + g * 128 + 4 * q); cv_[j] = *(const f32x4*)(XBCS + (size_t)(r0 + t) * 1024 + 768 + g * 128 + 4 * q); }
#pragma unroll
    for (int t2 = 0; t2 < 8; ++t2) dv_[t2] = DT[(size_t)(MP + r0 + t2) * 8 + h];
    const int bh_ = us >> 2, ps_ = 16 * (us & 3) + (tid >> 5), ns_ = 4 * (tid & 31);
    const bf16* SB_ = (const bf16*)(F.ws + WS_SBUF) + ((size_t)bh_ * 16 * 64 + ps_) * 128 + ns_; const float* CD_ = (const float*)(F.ws + WS_CD) + bh_ * 16;
    bf16* HB_ = (bf16*)(F.ws + WS_HB) + ((size_t)bh_ * 16 * 64 + ps_) * 128 + ns_;
    v2u S_[16]; float cd_[16];
#pragma unroll
    for (int c = 0; c < 16; ++c) { S_[c] = *(const v2u*)(SB_ + (size_t)c * 8192); cd_[c] = CD_[c]; }
    const float A = -expf(F.inp(I_ALOG)[l * 8 + h]);
    asm volatile("" ::: "memory");
    {
        f32x4 Hs = (f32x4){0.f, 0.f, 0.f, 0.f};
#pragma unroll
        for (int c = 0; c < 16; ++c) {
            if (c > 0) { v2u o; o.x = pg8::cvt_pk_bf16(Hs.x, Hs.y); o.y = pg8::cvt_pk_bf16(Hs.z, Hs.w); *(v2u*)(HB_ + (size_t)c * 8192) = o; }
            Hs = Hs * cd_[c] + (f32x4){bflo(S_[c].x), bfhi(S_[c].x), bflo(S_[c].y), bfhi(S_[c].y)};
        }
        *(f32x4*)(F.out + O_SP + ((size_t)l * 64 + bh_) * 8192 + ps_ * 128 + ns_) = Hs;
    }
    *(LAS f32x4*)(Xs + 4 * tl) = xv_;
#pragma unroll
    for (int j = 0; j < 2; ++j) { const int i = tl + 128 * j; *(LAS f32x4*)(Bs + 4 * i) = bv_[j]; *(LAS f32x4*)(Cs + 4 * i) = cv_[j]; }
    if (tl < 8) {
        float cs = 0.f, c7 = 0.f, d = 0.f;
#pragma unroll
        for (int t2 = 0; t2 < 8; ++t2) { const float dd = dv_[t2]; c7 += dd * A; if (t2 <= tl) cs += dd * A; if (t2 == tl) d = dd; }
        sm[tl] = d; sm[8 + tl] = cs; sm[16 + tl] = __expf(cs); sm[24 + tl] = __expf(c7 - cs) * d;
    }
    __syncthreads();
    {
        const int t = p >> 3, s2 = p & 7; float a = 0.f;
#pragma unroll
        for (int i = 0; i < 16; ++i) { const f32x4 cv = *(const LAS f32x4*)(Cs + t * 128 + 64 * nh + 4 * i), bv = *(const LAS f32x4*)(Bs + s2 * 128 + 64 * nh + 4 * i); a += (cv.x * bv.x + cv.y * bv.y) + (cv.z * bv.z + cv.w * bv.w); }
        a += xswz<1>(a);
        if (nh == 0) cbs[p] = s2 <= t ? a * __expf(sm[8 + t] - sm[8 + s2]) * sm[s2] : 0.f;
    }
    __syncthreads();
    const float dsk = F.inp(I_DSK)[l * 8 + h];
    float* Yo = (float*)(F.ws + WS_YS) + (size_t)r0 * 512 + h * 64 + p;
#pragma unroll
    for (int t = 0; t < 8; ++t) {
        float a = 0.f;
#pragma unroll
        for (int i = 0; i < 16; ++i) { const f32x4 cv = *(const LAS f32x4*)(Cs + t * 128 + 64 * nh + 4 * i); a += (H[i].x * cv.x + H[i].y * cv.y) + (H[i].z * cv.z + H[i].w * cv.w); }
        a += xswz<1>(a);
        float y = a * sm[16 + t] + dsk * Xs[t * 64 + p];
#pragma unroll
        for (int s2 = 0; s2 <= t; ++s2) y += cbs[t * 8 + s2] * Xs[s2 * 64 + p];
        if ((t & 1) == nh) Yo[(size_t)t * 512] = y;
    }
    const float e7 = sm[16 + 7];
#pragma unroll
    for (int i = 0; i < 16; ++i) H[i] = H[i] * e7;
#pragma unroll
    for (int s2 = 0; s2 < 8; ++s2) { const float cx = sm[24 + s2] * Xs[s2 * 64 + p];
#pragma unroll
        for (int i = 0; i < 16; ++i) H[i] += *(const LAS f32x4*)(Bs + s2 * 128 + 64 * nh + 4 * i) * cx; }
    float* ho = F.out + O_SS + ((size_t)(l * NDB + s) * 8 + h) * 8192 + p * 128 + 64 * nh;
#pragma unroll
    for (int i = 0; i < 16; ++i) *(f32x4*)(ho + 4 * i) = H[i];
}

typedef float f32x2_t __attribute__((ext_vector_type(2))); typedef __bf16 bf16x2_t __attribute__((ext_vector_type(2)));
__device__ __forceinline__ unsigned cvtpk_s(float lo, float hi) { const f32x2_t v = {lo, hi}; const bf16x2_t bb = __builtin_convertvector(v, bf16x2_t); return __builtin_bit_cast(unsigned, bb); }
__device__ __forceinline__ void m3_prompt_unit(const Frame& F, int l, int u) {
    const int g = u & 1, c = (u >> 1) & 15, b = u >> 5, r0 = b * SEQ + c * 128;
    int tid = F.tid, lane = F.lane, w = F.wave;
    LAS float* cumT = (LAS float*)F.lds;
    LAS float* dtT = cumT + 512;
    LAS float* sqp = dtT + 512;
    LAS bf16* Cm = (LAS bf16*)(F.lds + 8192);
    LAS bf16* Bm = Cm + 128 * LDT;
    LAS bf16* XT = Bm + 128 * LDT;
    const bf16* PROJ = (const bf16*)(F.ws + WS_PROJ); bf16* YCAT = (bf16*)(F.ws + WS_YCAT); const bf16* XBCB = (const bf16*)(F.ws + WS_XBCB);
    __syncthreads();
    { const int t = tid >> 2, hl = tid & 3; cumT[hl * 128 + t] = ((const float*)(F.ws + WS_CUM))[(size_t)(r0 + t) * 8 + 4 * g + hl]; dtT[hl * 128 + t] = ((const float*)(F.ws + WS_DT))[(size_t)(r0 + t) * 8 + 4 * g + hl]; }
    {
        v4u cbv[8];
#pragma unroll
        for (int j = 0; j < 8; ++j) { const int i = tid + 512 * j, which = i >> 11, row = (i >> 4) & 127, ck = i & 15; cbv[j] = *(const v4u*)(XBCB + (size_t)(r0 + row) * DM + (which ? 512 : 768) + 128 * g + 8 * ck); }
        const int po = tid & 31, t0 = 8 * (tid >> 5); v4u xr[8];
#pragma unroll
        for (int tt = 0; tt < 8; ++tt) xr[tt] = *(const v4u*)(XBCB + (size_t)(r0 + t0 + tt) * DM + 256 * g + 8 * po);
        asm volatile("" ::: "memory");
#pragma unroll
        for (int j = 0; j < 8; ++j) { const int i = tid + 512 * j, which = i >> 11, row = (i >> 4) & 127, ck = i & 15; *(LAS v4u*)((which ? Bm : Cm) + row * LDT + 8 * ck) = cbv[j]; }
#pragma unroll
        for (int j = 0; j < 8; ++j) { const unsigned sel = (j & 1) ? 0x07060302u : 0x05040100u; v4u o;
            o.x = __builtin_amdgcn_perm(xr[1][j >> 1], xr[0][j >> 1], sel); o.y = __builtin_amdgcn_perm(xr[3][j >> 1], xr[2][j >> 1], sel);
            o.z = __builtin_amdgcn_perm(xr[5][j >> 1], xr[4][j >> 1], sel); o.w = __builtin_amdgcn_perm(xr[7][j >> 1], xr[6][j >> 1], sel);
            *(LAS v4u*)(XT + (8 * po + j) * LDT + t0) = o; }
    }
    __syncthreads();
    M_RELAUNDER();
    const int hl = w & 3, th = w >> 2, h = 4 * g + hl, half = lane >> 5, l31 = lane & 31;
    const LAS float* cumh = cumT + hl * 128; const LAS float* dth = dtT + hl * 128;
    f32x16 y[2][2];
#pragma unroll
    for (int a = 0; a < 2; ++a)
#pragma unroll
        for (int q = 0; q < 2; ++q)
#pragma unroll
            for (int i = 0; i < 16; ++i) y[a][q][i] = 0.f;
    if (c > 0) {
        const bf16* hsrc = (const bf16*)(F.ws + WS_HB) + ((size_t)(b * 8 + h) * 16 + c) * 8192 + l31 * 128 + 8 * half;
#pragma unroll
        for (int k = 0; k < 128; k += 16) {
            const s16x8 hb0 = *(const s16x8*)(hsrc + k), hb1 = *(const s16x8*)(hsrc + 32 * 128 + k);
#pragma unroll
            for (int tbl = 0; tbl < 2; ++tbl) { const s16x8 ca = *(const LAS s16x8*)(Cm + (32 * (2 * th + tbl) + l31) * LDT + k + 8 * half);
                y[tbl][0] = __builtin_amdgcn_mfma_f32_32x32x16_bf16(ca, hb0, y[tbl][0], 0, 0, 0); y[tbl][1] = __builtin_amdgcn_mfma_f32_32x32x16_bf16(ca, hb1, y[tbl][1], 0, 0, 0); }
        }
#pragma unroll
        for (int tbl = 0; tbl < 2; ++tbl)
#pragma unroll
            for (int q4 = 0; q4 < 4; ++q4) { const f32x4 cv = *(const LAS f32x4*)(cumh + 32 * (2 * th + tbl) + 8 * q4 + 4 * half);
#pragma unroll
                for (int i = 0; i < 4; ++i) { const float e = __expf(cv[i]); y[tbl][0][4 * q4 + i] *= e; y[tbl][1][4 * q4 + i] *= e; } }
    }
#pragma unroll
    for (int tbl = 0; tbl < 2; ++tbl) {
        const int tb = 2 * th + tbl; const int t = 32 * tb + l31; const float ct = cumh[t];
#pragma unroll 1
        for (int sb = 0; sb <= tb; ++sb) {
            f32x16 x;
#pragma unroll
            for (int i = 0; i < 16; ++i) x[i] = 0.f;
            x = mma32(Bm + (32 * sb) * LDT, Cm + (32 * tb) * LDT, 128, x, lane);
#pragma unroll
            for (int q4 = 0; q4 < 4; ++q4) { const f32x4 cs = *(const LAS f32x4*)(cumh + 32 * sb + 8 * q4 + 4 * half), ds = *(const LAS f32x4*)(dth + 32 * sb + 8 * q4 + 4 * half);
#pragma unroll
                for (int i = 0; i < 4; ++i) { const int s = 32 * sb + 8 * q4 + 4 * half + i; x[4 * q4 + i] = s <= t ? x[4 * q4 + i] * __expf(ct - cs[i]) * ds[i] : 0.f; } }
#pragma unroll
            for (int sp = 0; sp < 2; ++sp) {
                v4u pa; pa.x = cvtpk_s(x[8 * sp], x[8 * sp + 1]); pa.y = cvtpk_s(x[8 * sp + 2], x[8 * sp + 3]); pa.z = cvtpk_s(x[8 * sp + 4], x[8 * sp + 5]); pa.w = cvtpk_s(x[8 * sp + 6], x[8 * sp + 7]);
                const s16x8 xa = __builtin_bit_cast(s16x8, pa);
#pragma unroll
                for (int q = 0; q < 2; ++q) { const LAS bf16* xp = XT + (hl * 64 + 32 * q + l31) * LDT + 32 * sb + 16 * sp + 4 * half;
                    const v2u lo = *(const LAS v2u*)xp, hi = *(const LAS v2u*)(xp + 8); const v4u pb = {lo.x, lo.y, hi.x, hi.y};
                    y[tbl][q] = __builtin_amdgcn_mfma_f32_32x32x16_bf16(xa, __builtin_bit_cast(s16x8, pb), y[tbl][q], 0, 0, 0); }
            }
        }
    }
    const float dsk = F.inp(I_DSK)[l * 8 + h];
#pragma unroll
    for (int tbl = 0; tbl < 2; ++tbl) { const int tb = 2 * th + tbl; float sq[16];
#pragma unroll
        for (int i = 0; i < 16; ++i) sq[i] = 0.f;
        unsigned zr[2][16];
#pragma unroll
        for (int q = 0; q < 2; ++q)
#pragma unroll
            for (int reg = 0; reg < 16; ++reg) zr[q][reg] = PROJ[(size_t)(r0 + 32 * tb + crow(reg, half)) * DING + C_Z + h * 64 + 32 * q + l31];
#pragma unroll
        for (int q = 0; q < 2; ++q) { const int p = 32 * q + l31, col = h * 64 + p;
#pragma unroll
            for (int reg = 0; reg < 16; ++reg) { const int t = 32 * tb + crow(reg, half);
                const float xv = bf2f(XT[(hl * 64 + p) * LDT + t]); const float yv = y[tbl][q][reg] + dsk * xv;
                const float z = bf2f(zr[q][reg]); const float gv = yv * silu_f(z);
                sq[reg] += gv * gv; YCAT[(size_t)(r0 + t) * DM + YC_YC + col] = (bf16)f2bf(gv); } }
#pragma unroll
        for (int reg = 0; reg < 16; ++reg) { float v = sq[reg]; v += xswz<1>(v); v += xswz<2>(v); v += xswz<4>(v); v += xswz<8>(v); v += xswz<16>(v);
            if (l31 == 0) sqp[hl * 128 + 32 * tb + crow(reg, half)] = v; }
    }
    __syncthreads();
    if (tid < 128) ((float*)(F.ws + WS_SSG))[(size_t)(r0 + tid) * 2 + g] = (sqp[tid] + sqp[128 + tid]) + (sqp[256 + tid] + sqp[384 + tid]);
}

__device__ __forceinline__ void conv_sample_phase(const Frame& F, int l) {
    const int gw = F.vcu * NWAVES + F.wave, NGW = F.G * NWAVES, lane = F.lane;
    const bf16* PROJ = (const bf16*)(F.ws + WS_PROJ); bf16* YCAT = (bf16*)(F.ws + WS_YCAT); float* XBCS = (float*)(F.ws + WS_XBCS);
    const float* cw = F.inp(I_CW) + l * 3 * 256; const float* scw = F.inp(I_SCW) + l * 4 * 1024; const float* scb = F.inp(I_SCB) + l * 1024;
    const int wi_ = (F.vcu & 31) * NWAVES + F.wave;
    for (int r = F.G == 256 ? MP + 128 * (F.vcu >> 5) + wi_ : MP + gw; F.G == 256 ? (wi_ < 128 && r < MP + 128 * (F.vcu >> 5) + 128) : r < M; r += F.G == 256 ? 1024 : NGW) {
        const int t = (r - MP) & 7, sidx = (r - MP) >> 3;
        {
            const int ch = 4 * lane; v2u cgr[3], hbr[3]; f32x4 str[3], w3[3];
#pragma unroll
            for (int k = 0; k < 3; ++k) { const int back = 2 - k, rp = (t - back >= 0) ? r - back : r, si = (t - back >= 0) ? 0 : 2 + t - back;
                cgr[k] = *(const v2u*)(PROJ + (size_t)rp * DING + C_CG + ch); hbr[k] = *(const v2u*)(PROJ + (size_t)rp * DING + C_HB + ch);
                str[k] = *(const f32x4*)(F.inp(I_SC) + ((size_t)(l * NDB + sidx) * 2 + si) * 256 + ch); w3[k] = *(const f32x4*)(cw + k * 256 + ch); }
            const v2u bg = *(const v2u*)(PROJ + (size_t)r * DING + C_BG + ch);
            asm volatile("" ::: "memory");
            float cin[3][4];
#pragma unroll
            for (int k = 0; k < 3; ++k) { const bool own = t - (2 - k) >= 0;
                cin[k][0] = own ? bflo(cgr[k].x) * bflo(hbr[k].x) : str[k].x; cin[k][1] = own ? bfhi(cgr[k].x) * bfhi(hbr[k].x) : str[k].y;
                cin[k][2] = own ? bflo(cgr[k].y) * bflo(hbr[k].y) : str[k].z; cin[k][3] = own ? bfhi(cgr[k].y) * bfhi(hbr[k].y) : str[k].w; }
            const float bgf[4] = {bflo(bg.x), bfhi(bg.x), bflo(bg.y), bfhi(bg.y)}; float yb[4];
#pragma unroll
            for (int j = 0; j < 4; ++j) yb[j] = bgf[j] * (w3[0][j] * cin[0][j] + w3[1][j] * cin[1][j] + w3[2][j] * cin[2][j]);
            v2u wv; wv.x = pk2(yb[0], yb[1]); wv.y = pk2(yb[2], yb[3]); *(v2u*)(YCAT + (size_t)r * DM + YC_YB + ch) = wv;
            if (t >= DSEQ - 2) { float* dst = F.out + O_CS + ((size_t)(l * NDB + sidx) * 2 + (t - (DSEQ - 2))) * 256; *(f32x4*)(dst + ch) = (f32x4){cin[2][0], cin[2][1], cin[2][2], cin[2][3]}; }
        }
        {
            v2u xr[4][4]; f32x4 str[4][4], w4[4][4], bq[4];
#pragma unroll
            for (int jg = 0; jg < 4; ++jg) { const int ch = jg * 256 + 4 * lane; bq[jg] = *(const f32x4*)(scb + ch);
#pragma unroll
                for (int k = 0; k < 4; ++k) { const int back = 3 - k, rp = (t - back >= 0) ? r - back : r, si = (t - back >= 0) ? 0 : 3 + t - back;
                    xr[jg][k] = *(const v2u*)(PROJ + (size_t)rp * DING + C_XBC + ch); str[jg][k] = *(const f32x4*)(F.inp(I_SSC) + ((size_t)(l * NDB + sidx) * 3 + si) * 1024 + ch);
                    w4[jg][k] = *(const f32x4*)(scw + k * 1024 + ch); } }
            asm volatile("" ::: "memory");
#pragma unroll
            for (int jg = 0; jg < 4; ++jg) { const int ch = jg * 256 + 4 * lane; float xv[4][4];
#pragma unroll
                for (int k = 0; k < 4; ++k) { const bool own = t - (3 - k) >= 0;
                    xv[k][0] = own ? bflo(xr[jg][k].x) : str[jg][k].x; xv[k][1] = own ? bfhi(xr[jg][k].x) : str[jg][k].y; xv[k][2] = own ? bflo(xr[jg][k].y) : str[jg][k].z; xv[k][3] = own ? bfhi(xr[jg][k].y) : str[jg][k].w; }
                f32x4 o;
#pragma unroll
                for (int j = 0; j < 4; ++j) { const float v = bq[jg][j] + w4[jg][0][j] * xv[0][j] + w4[jg][1][j] * xv[1][j] + w4[jg][2][j] * xv[2][j] + w4[jg][3][j] * xv[3][j]; o[j] = silu_f(v); }
                *(f32x4*)(XBCS + (size_t)(r - MP) * 1024 + ch) = o;
                if (t >= DSEQ - 3) { float* dst = F.out + O_SCS + ((size_t)(l * NDB + sidx) * 3 + (t - (DSEQ - 3))) * 1024; *(f32x4*)(dst + ch) = (f32x4){xv[3][0], xv[3][1], xv[3][2], xv[3][3]}; } }
        }
    }
}
__device__ __forceinline__ void mixa_sample_phase(const Frame& F, int l) {
    LAS bf16* Vs = (LAS bf16*)F.lds;
    LAS float* Wsl = (LAS float*)(F.lds + 4096);
    LAS float* Bsl = Wsl + 256;
    const bf16* PROJ = (const bf16*)(F.ws + WS_PROJ); bf16* YCAT = (bf16*)(F.ws + WS_YCAT);
    const int tid = F.tid;
    for (int u = F.G == 256 ? ((F.vcu & 31) < 16 ? 16 * (F.vcu >> 5) + (F.vcu & 31) : NDB) : F.vcu; u < NDB; u += F.G) {
        const int r0 = MP + u * 8;
        __syncthreads();
        {
            v4u vv = (v4u){0u, 0u, 0u, 0u}; float wq = 0.f, bq = 0.f; unsigned ur[8];
            if (tid < 256) vv = *(const v4u*)(PROJ + (size_t)(r0 + (tid >> 5)) * DING + C_V + (tid & 31) * 8);
            else { const int i = tid - 256, hh = i >> 6, tt = (i >> 3) & 7, s2 = i & 7; wq = F.inp(I_WS)[((size_t)(l * 4 + hh) * 128 + tt) * 128 + s2]; }
            if (tid < 32) bq = F.inp(I_BS)[(l * 4 + (tid >> 3)) * 128 + (tid & 7)];
            const int col = tid & 255;
#pragma unroll
            for (int t = 0; t < 8; ++t) ur[t] = PROJ[(size_t)(r0 + t) * DING + C_U + col];
            asm volatile("" ::: "memory");
            if (tid < 256) *(LAS v4u*)(Vs + (tid >> 5) * 256 + (tid & 31) * 8) = vv; else Wsl[tid - 256] = wq;
            if (tid < 32) Bsl[tid] = bq;
            __syncthreads();
            if (tid < 256) { const int h = col >> 6; float vcol[8];
#pragma unroll
                for (int t = 0; t < 8; ++t) vcol[t] = bf2f(Vs[t * 256 + col]);
#pragma unroll
                for (int t = 0; t < 8; ++t) { float acc = Bsl[h * 8 + t];
#pragma unroll
                    for (int s2 = 0; s2 <= t; ++s2) acc += Wsl[(h * 8 + t) * 8 + s2] * vcol[s2];
                    YCAT[(size_t)(r0 + t) * DM + YC_YA + col] = (bf16)f2bf(bf2f(ur[t]) * acc); } }
        }
        float* dst = F.out + O_CVS + (size_t)(l * NDB + u) * 8 * 256; for (int i = tid; i < 8 * 256; i += NWAVES * 64) dst[i] = bf2f(Vs[i]);
    }
}
__device__ __forceinline__ void gnorm_sample_phase(const Frame& F, int l) {
    const int gw = F.vcu * NWAVES + F.wave, NGW = F.G * NWAVES, lane = F.lane;
    const bf16* PROJ = (const bf16*)(F.ws + WS_PROJ); bf16* YCAT = (bf16*)(F.ws + WS_YCAT); const float* Y = (const float*)(F.ws + WS_YS);
    const int wi_ = (F.vcu & 31) * NWAVES + F.wave;
    for (int r = F.G == 256 ? MP + 128 * (F.vcu >> 5) + wi_ : MP + gw; F.G == 256 ? (wi_ < 128 && r < MP + 128 * (F.vcu >> 5) + 128) : r < M; r += F.G == 256 ? 1024 : NGW) {
        const f32x4 y0 = *(const f32x4*)(Y + (size_t)(r - MP) * 512 + 8 * lane), y1 = *(const f32x4*)(Y + (size_t)(r - MP) * 512 + 8 * lane + 4);
        float z[8]; unpack8(*(const v4u*)(PROJ + (size_t)r * DING + C_Z + 8 * lane), z);
        float gv[8] = {y0.x * silu_f(z[0]), y0.y * silu_f(z[1]), y0.z * silu_f(z[2]), y0.w * silu_f(z[3]), y1.x * silu_f(z[4]), y1.y * silu_f(z[5]), y1.z * silu_f(z[6]), y1.w * silu_f(z[7])};
        float s = 0.f;
#pragma unroll
        for (int j = 0; j < 8; ++j) s += gv[j] * gv[j];
        s = wave_sum(s);
        *(v4u*)(YCAT + (size_t)r * DM + YC_YC + 8 * lane) = pack8(gv[0], gv[1], gv[2], gv[3], gv[4], gv[5], gv[6], gv[7]);
        if (lane < 2) ((float*)(F.ws + WS_SSG))[(size_t)r * 2 + lane] = lane == 0 ? s : 0.f;
    }
}
__device__ __forceinline__ void final_phase(const Frame& F) {
    const int gw = F.vcu * NWAVES + F.wave, NGW = F.G * NWAVES, lane = F.lane;
    const f32x4* gp = (const f32x4*)F.inp(I_FN) + 2 * lane;
    f32x4 gv[2][2];
#pragma unroll
    for (int j = 0; j < 2; ++j) { gv[j][0] = gp[128 * j]; gv[j][1] = gp[128 * j + 1]; }
    const bf16* XB = (const bf16*)(F.ws + WS_XB);
    const int wi_ = (F.vcu & 31) * NWAVES + F.wave, xs_ = F.vcu >> 5;
    for (int gi = F.G == 256 ? wi_ : gw; gi < (F.G == 256 ? 544 : M / 4); gi += F.G == 256 ? 256 : NGW) {
        const int r4 = F.G == 256 ? (gi < 512 ? 2048 * xs_ + 4 * gi : MP + 128 * xs_ + 4 * (gi - 512)) : 4 * gi;
        v4u v[4][2];
#pragma unroll
        for (int q = 0; q < 4; ++q) { const v4u* xr = (const v4u*)(XB + (size_t)(r4 + q) * DM) + lane;
#pragma unroll
            for (int j = 0; j < 2; ++j) v[q][j] = xr[64 * j]; }
#pragma unroll
        for (int q = 0; q < 4; ++q) { float s = 0.f; f32x4* yr = (f32x4*)(F.out + (size_t)(r4 + q) * DM) + 2 * lane; f32x4 x[2][2];
#pragma unroll
            for (int j = 0; j < 2; ++j) { pg8::unpk8(v[q][j], x[j][0], x[j][1]);
#pragma unroll
                for (int h = 0; h < 2; ++h) s += (x[j][h].x * x[j][h].x + x[j][h].y * x[j][h].y) + (x[j][h].z * x[j][h].z + x[j][h].w * x[j][h].w); }
            s = wave_sum(s); const float rsd = 1.0f / sqrtf(s * (1.0f / DM) + EPS);
#pragma unroll
            for (int j = 0; j < 2; ++j) { yr[128 * j] = x[j][0] * rsd * gv[j][0]; yr[128 * j + 1] = x[j][1] * rsd * gv[j][1]; } }
    }
}

constexpr int PH_PER_LAYER = 7, N_PHASES = 1 + DEPTH * PH_PER_LAYER + 1;
__global__ void __launch_bounds__(NWAVES * 64, 2) mega(Args args) {
    extern __shared__ __attribute__((aligned(16))) unsigned char lds[];
    Frame F;
    F.lds = (LAS unsigned char*)lds;
    F.tid = threadIdx.x; F.lane = F.tid & 63; F.wave = __builtin_amdgcn_readfirstlane(F.tid >> 6);
    F.G = gridDim.x; { const int bx = blockIdx.x; F.vcu = (F.G % 8 == 0) ? (bx % 8) * (F.G / 8) + bx / 8 : bx; }
    const __attribute__((address_space(4))) Args* ap0 = (const __attribute__((address_space(4))) Args*)__builtin_amdgcn_kernarg_segment_ptr();
    F.ap = ap0; F.out = args.out; F.ws = args.ws;
    volatile LAS unsigned* MISC = (volatile LAS unsigned*)(F.lds + MISC_OFF);
    for (int u = F.tid; u < (LDS_BYTES - LDSCTL_OFF) / 4; u += NWAVES * 64) ((LAS unsigned*)(F.lds + LDSCTL_OFF))[u] = 0u;
    __syncthreads();
    const int wave_s = __builtin_amdgcn_readfirstlane(threadIdx.x >> 6);
    const bool multi = args.ph_hi - args.ph_lo > 1;
    XcdBarrier bar; bar.bar = (unsigned*)(F.ws + WS_CTL) + CW_BAR; bar.x = 0; bar.st = nullptr; bool even = false; unsigned ev_s = 0u, tk_s = 0u;
    if (multi) {
        bar = xcd_barrier_post((unsigned*)(F.ws + WS_CTL) + CW_BAR, MISC + 8);
        if (threadIdx.x == 0) { unsigned nloc_, nx_, ev_; xcd_barrier_complete(bar.bar, bar.x, nloc_, nx_, ev_); bar.st[0] = nloc_; bar.st[1] = nx_; bar.st[3] = ev_; }
        __syncthreads();
        ev_s = __builtin_amdgcn_readfirstlane(MISC[11]); tk_s = __builtin_amdgcn_readfirstlane(MISC[10]);
    }

#define PH_TID() do { int wv_ = wave_s; LAUNDER_S(wv_); unsigned z_ = 0u; LAUNDER_S(z_); int t_ = wv_ * 64 + (int)__builtin_amdgcn_mbcnt_hi(~0u, __builtin_amdgcn_mbcnt_lo(~0u, z_)); LAUNDER_V(t_); F.tid = t_; F.lane = t_ & 63; F.wave = wv_; } while (0)
    for (int ph = args.ph_lo; ph < args.ph_hi; ++ph) {
        {
            const __attribute__((address_space(4))) Args* q = ap0; asm volatile("" : "+s"(q)); F.ap = q; F.out = q->out; F.ws = q->ws;
            int bx = blockIdx.x; asm volatile("" : "+s"(bx));
            even = multi && ev_s == 1u;
            if (even) bx = (int)((tk_s - 1u) * 8u + bar.x);
            F.bid = bx; F.vcu = (F.G % 8 == 0) ? (bx % 8) * (F.G / 8) + bx / 8 : bx;
            bar.bar = (unsigned*)(F.ws + WS_CTL) + CW_BAR;
        }
        if (ph == 0) {
            if (!even) { PH_TID(); p0_prologue(F, 0); }
            else {
                PH_TID(); p0_prologue(F, 3);
                xcd_barrier(bar, false);
                constexpr int I_IN_ = (DM / 64) * (DING / 32), I_ALL_ = DEPTH * ((DM / 64) * (DING / 32) + (DM / 64) * (DM / 32) + (DM / 64) * (FF / 32) + (FF / 64) * (DM / 32)), R_ = I_ALL_ - I_IN_;
                const int xx_ = (int)bar.x; int c0_ = 0, c1_ = 0, ct_ = 0;
#pragma unroll
                for (int j = 0; j < 8; ++j) { const int w_ = CVT_SHARE(j); if (j < xx_) c0_ += w_; if (j <= xx_) c1_ += w_; ct_ += w_; }
                const int blo_ = I_IN_ + (int)((long)R_ * c0_ / ct_), bhi_ = I_IN_ + (int)((long)R_ * c1_ / ct_);
                PH_TID(); p0_prologue(F, 4, blo_, bhi_);
            }
        }
        else if (ph == N_PHASES - 1) { PH_TID(); final_phase(F); }
        else {
            const int l = (ph - 1) / PH_PER_LAYER, s = (ph - 1) % PH_PER_LAYER;
#ifndef PROBE_S
#define PROBE_S -1
#endif
            for (int rep = 0; rep < ((s == PROBE_S) ? 2 : 1); ++rep) {
            bf16* XB = (bf16*)(F.ws + WS_XB); float* SS1 = (float*)(F.ws + WS_SS1); float* SS2 = (float*)(F.ws + WS_SS2); float* SSX1 = (float*)(F.ws + WS_SSX1); float* SSX2 = (float*)(F.ws + WS_SSX2);
            if (s == 0) {
                PH_TID();
                { pg8::GemmX g{XB, XB + (size_t)MP * DM, (const bf16*)(F.ws + WS_WIN) + (size_t)l * DING * DM, DM}; pg8::StaticOrder S; S.init(MP, DING, F.G, F.bid);
                  pg8::EpiScaleActX<0> E{(bf16*)(F.ws + WS_PROJ), (bf16*)(F.ws + WS_PROJ) + (size_t)MP * DING, DING, SS1, SSX1, 2};
                  pg8::gemm_phase_x<pg8::EpiScaleActX<0>, pg8::StaticOrder>(F.lds, g, S, E, F.tid); }
                PH_TID();
                { pg8::SEpiDt Ed{(float*)(F.ws + WS_DT), SS1, F.inp(I_DTB) + l * 8, (const float*)(F.ws + WS_SSX1)};
                  pg8::small_gemm_phase<64, pg8::SEpiDt>(F.lds, XB, (const bf16*)(F.ws + WS_WDTB) + (size_t)l * 64 * DM, DM, 1, MP / 64, F.vcu, F.G, Ed, F.tid);
                  if (F.G == 256) { if ((F.vcu & 31) < 2) { PH_TID(); const int us_ = MP / 64 + 2 * (F.vcu >> 5) + (F.vcu & 31);
                      pg8::small_gemm_phase<64, pg8::SEpiDt>(F.lds, XB, (const bf16*)(F.ws + WS_WDTB) + (size_t)l * 64 * DM, DM, 1, us_ + 1, us_, 1, Ed, F.tid); } }
                  else { PH_TID(); pg8::small_gemm_phase<64, pg8::SEpiDt>(F.lds, XB, (const bf16*)(F.ws + WS_WDTB) + (size_t)l * 64 * DM, DM, 1, M / 64, MP / 64 + F.vcu, F.G, Ed, F.tid); } }
            } else if (s == 1) {
                PH_TID();
                for (int u = F.vcu; u < 256; u += F.G) m1_prompt_unit(F, l, u);
                PH_TID(); conv_sample_phase(F, l); PH_TID(); mixa_sample_phase(F, l);
            } else if (s == 2) {
                PH_TID();
                if (F.G == 256) m2_combined(F, l, F.vcu, 4 * F.vcu);
                else { for (int u = F.vcu; u < 256; u += F.G) m2_scan_unit(F, l, u);
                    PH_TID();
                    for (int u = 4 * F.vcu; u < NDB * 8; u += 4 * F.G) ssd_sample_quad(F, l, u); }
            } else if (s == 3) {
                PH_TID();
                for (int u = F.vcu; u < 256; u += F.G) m3_prompt_unit(F, l, u);
                PH_TID(); gnorm_sample_phase(F, l);
            } else if (s == 4) {
                PH_TID();
                { pg8::GemmX g{(const bf16*)(F.ws + WS_YCAT), (const bf16*)(F.ws + WS_YCAT) + (size_t)MP * DM, (const bf16*)(F.ws + WS_WOUT) + (size_t)l * DM * DM, DM}; pg8::StaticOrder S; S.init(MP, DM, F.G, F.bid);
                  pg8::EpiResX<true> E{XB, SS2, SSX2, (const float*)(F.ws + WS_SSG)};
                  pg8::gemm_phase_x<pg8::EpiResX<true>, pg8::StaticOrder>(F.lds, g, S, E, F.tid); }
            } else if (s == 5) {
                PH_TID();
                { pg8::GemmX g{XB, XB + (size_t)MP * DM, (const bf16*)(F.ws + WS_W1) + (size_t)l * FF * DM, DM}; pg8::StaticOrder S; S.init(MP, FF, F.G, F.bid);
                  pg8::EpiScaleActX<1> E{(bf16*)(F.ws + WS_HID), (bf16*)(F.ws + WS_HID) + (size_t)MP * FF, FF, SS2, SSX2, 0};
                  pg8::gemm_phase_x<pg8::EpiScaleActX<1>, pg8::StaticOrder>(F.lds, g, S, E, F.tid); }
            } else {
                PH_TID();
                { pg8::GemmX g{(const bf16*)(F.ws + WS_HID), (const bf16*)(F.ws + WS_HID) + (size_t)MP * FF, (const bf16*)(F.ws + WS_W2) + (size_t)l * DM * FF, FF}; pg8::StaticOrder S; S.init(MP, DM, F.G, F.bid);
                  pg8::EpiResX<false> E{XB, SS1, SSX1, nullptr};
                  pg8::gemm_phase_x<pg8::EpiResX<false>, pg8::StaticOrder>(F.lds, g, S, E, F.tid); }
            }
            }
        }
        if (ph + 1 < args.ph_hi) {
            if (!even) xcd_barrier(bar, false);
            else xcd_barrier(bar, true, -1, bar.bar + XB_HTOP(0) + 64, ph == 4 ? 1u : 0u, ph == 0);
        }
    }
}

extern "C" void kernel_launch(void* const* d_in, const int* in_sizes, int n_in, void* d_out, int out_size, void* d_ws, size_t ws_size, hipStream_t stream) {
    static int grid = 0;
    if (grid == 0) {
        if (n_in != N_IN || (size_t)out_size != O_END || ws_size < WS_END) { fprintf(stderr, "kernel_launch: unexpected sizes n_in %d out %d ws %zu (need %zu)\n", n_in, out_size, ws_size, (size_t)WS_END); grid = -1; return; }
        int dev = 0, cus = 0;
        if (hipGetDevice(&dev) != hipSuccess || hipDeviceGetAttribute(&cus, hipDeviceAttributeMultiprocessorCount, dev) != hipSuccess) { grid = -1; return; }
        if (hipFuncSetAttribute((const void*)mega, hipFuncAttributeMaxDynamicSharedMemorySize, LDS_BYTES) != hipSuccess) { fprintf(stderr, "kernel_launch: hipFuncSetAttribute failed\n"); grid = -1; return; }
        (void)hipGetLastError();
        grid = cus;
    }
    if (grid < 0) return;
    if (hipMemsetAsync((char*)d_ws + WS_CTL, 0, CTL_ZERO_BYTES, stream) != hipSuccess) return;
    Args a{};
    for (int i = 0; i < N_IN; ++i) a.in[i] = (const float*)d_in[i];
    a.out = (float*)d_out; a.ws = (unsigned char*)d_ws;
#if MK_ONE_LAUNCH
    a.ph_lo = 0; a.ph_hi = N_PHASES;
    hipLaunchKernelGGL(mega, dim3(grid), dim3(NWAVES * 64), LDS_BYTES, stream, a);
#else
    for (int ph = 0; ph < N_PHASES; ++ph) { a.ph_lo = ph; a.ph_hi = ph + 1; hipLaunchKernelGGL(mega, dim3(grid), dim3(NWAVES * 64), LDS_BYTES, stream, a); }
#endif
}
```

```cpp
#include <hip/hip_runtime.h>
#include <cstdio>
#include <cstdint>

#ifndef MK_ONE_LAUNCH
#define MK_ONE_LAUNCH 1
#endif


template <int K> __device__ __forceinline__ float xswz(float v) { return __builtin_bit_cast(float, __builtin_amdgcn_ds_swizzle(__builtin_bit_cast(int, v), (K << 10) | 0x1f)); }
__device__ __forceinline__ float sum_halves(float v) {
    const unsigned b = __builtin_bit_cast(unsigned, v); unsigned b2 = b; asm volatile("" : "+v"(b2));
    auto r = __builtin_amdgcn_permlane32_swap(b, b2, false, false); unsigned r0 = r[0], r1 = r[1]; asm volatile("" : "+v"(r0), "+v"(r1));
    return __builtin_bit_cast(float, r0) + __builtin_bit_cast(float, r1);
}
__device__ __forceinline__ float softplus_f(float v) {
    const float e = __expf(-fabsf(v));
    const float lg = e < 0.03125f ? e * (1.0f - e * (0.5f - e * (0.33333334f - 0.25f * e))) : __logf(1.0f + e);
    return fmaxf(v, 0.f) + lg;
}

namespace pg8 {
#define PG8_LAS __attribute__((address_space(3)))
typedef unsigned short bf16_t;
typedef short bf16x8 __attribute__((ext_vector_type(8)));
typedef float f32x4 __attribute__((ext_vector_type(4)));
typedef float f32x2 __attribute__((ext_vector_type(2)));
typedef unsigned u32x4 __attribute__((ext_vector_type(4)));
constexpr int BM = 256, BK = 64, HALF = 128, HTB = HALF * BK * 2, STAGE_BYTES = 8 * HTB, NXCD = 8, WGM = 8;

__host__ __device__ __forceinline__ int lds_byte(int r, int c) { const int st = (r >> 4) * 2 + (c >> 5), rr = r & 15, cc = c & 31, ob = rr * 64 + cc * 2; return st * 1024 + (ob ^ (((ob >> 9) & 1) << 5)); }
__host__ __device__ __forceinline__ void stage_rc(int b, int& R, int& C) { const int st = b / 1024, sb = b % 1024, swz = sb ^ (((sb >> 9) & 1) << 5); R = (st >> 1) * 16 + swz / 64; C = (st & 1) * 32 + (swz % 64) / 2; }
__host__ __device__ __forceinline__ int perm32(int rho) { const int n = rho >> 4, i = rho & 15; return 8 * (i >> 2) + 4 * n + (i & 3); }

struct Unit { int pm, pn; };
struct Gemm { const bf16_t* A; const bf16_t* Bt; int M, N, K; };

struct StaticOrder {
    int nM, nN, nwg, G, c;
    __host__ __device__ void init(int M, int N, int G_, int c_) { nM = M / BM; nN = N / BM; nwg = nM * nN; G = G_; c = c_; }
    __host__ __device__ bool next(int i, Unit& u) const {
        const long L = (long)i * G + c; if (L >= nwg) return false;
        int wgid = (int)L; { const int q = nwg / NXCD, r = nwg % NXCD, xcd = wgid % NXCD, off = wgid / NXCD; wgid = (xcd < r ? xcd * (q + 1) : r * (q + 1) + (xcd - r) * q) + off; }
        const int nig = WGM * nN, gid = wgid / nig, fm = gid * WGM, gsz = (nM - fm) < WGM ? (nM - fm) : WGM;
        u.pm = fm + ((wgid % nig) % gsz); u.pn = (wgid % nig) / gsz; return true;
    }
    __device__ __forceinline__ void a_ready(const Unit&) const {}
    __device__ __forceinline__ void done(const Unit&) const {}
};

__device__ __forceinline__ unsigned cvt_pk_bf16(float lo, float hi) { unsigned r; asm volatile("v_cvt_pk_bf16_f32 %0, %1, %2" : "=v"(r) : "v"(lo), "v"(hi)); return r; }
__device__ __forceinline__ f32x2 gelu_pk(f32x2 v) {
    const f32x2 av = __builtin_elementwise_abs(v), d = av * 0.2316418882f + 1.0f;
    f32x2 t; t.x = __builtin_amdgcn_rcpf(d.x); t.y = __builtin_amdgcn_rcpf(d.y);
    f32x2 q = t * 0.5307027145f + (-0.7265760135f); q = q * t + 0.7107068705f; q = q * t + (-0.142248368f); q = q * t + 0.127414796f; q = q * t;
    const f32x2 s = (v * v) * (-0.72134752044f);
    f32x2 e; e.x = __builtin_amdgcn_exp2f(s.x); e.y = __builtin_amdgcn_exp2f(s.y);
    const f32x2 m = v * (q * e), r = v - m;
    f32x2 o; o.x = v.x < 0.f ? m.x : r.x; o.y = v.y < 0.f ? m.y : r.y; return o;
}

__device__ __forceinline__ const void* uni_ptr(const void* p) {
    const unsigned long long v = (unsigned long long)p; const unsigned lo = __builtin_amdgcn_readfirstlane((unsigned)v), hi = __builtin_amdgcn_readfirstlane((unsigned)(v >> 32));
    return (const void*)(((unsigned long long)hi << 32) | lo);
}
__device__ __forceinline__ void ld1_b128(f32x4& d, const void* sb, unsigned vo) {
    asm volatile("s_nop 4\n\tglobal_load_dwordx4 %0, %1, %2\n\ts_waitcnt vmcnt(0)" : "=&v"(d) : "v"(vo), "s"(uni_ptr(sb)) : "memory"); }
__device__ __forceinline__ void ld1_b64(f32x2& d, const void* sb, unsigned vo) {
    asm volatile("s_nop 4\n\tglobal_load_dwordx2 %0, %1, %2\n\ts_waitcnt vmcnt(0)" : "=&v"(d) : "v"(vo), "s"(uni_ptr(sb)) : "memory"); }
__device__ __forceinline__ void ld2_b128(f32x4& d0, f32x4& d1, const void* sb, unsigned vo) {
    asm volatile("s_nop 4\n\tglobal_load_dwordx4 %0, %2, %3\n\tglobal_load_dwordx4 %1, %2, %3 offset:16\n\ts_waitcnt vmcnt(0)" : "=&v"(d0), "=&v"(d1) : "v"(vo), "s"(uni_ptr(sb)) : "memory"); }
__device__ __forceinline__ void ld4_b128(f32x4 (&d)[4], const void* sb, const unsigned (&vo)[4]) {
    asm volatile("s_nop 4\n\tglobal_load_dwordx4 %0, %4, %8\n\tglobal_load_dwordx4 %1, %5, %8\n\tglobal_load_dwordx4 %2, %6, %8\n\tglobal_load_dwordx4 %3, %7, %8\n\ts_waitcnt vmcnt(0)"
        : "=&v"(d[0]), "=&v"(d[1]), "=&v"(d[2]), "=&v"(d[3]) : "v"(vo[0]), "v"(vo[1]), "v"(vo[2]), "v"(vo[3]), "s"(uni_ptr(sb)) : "memory"); }
__device__ __forceinline__ void ld8_b128(f32x4 (&d)[8], const void* sb, const unsigned (&vo)[8]) {
    asm volatile("s_nop 4\n\tglobal_load_dwordx4 %0, %8, %16\n\tglobal_load_dwordx4 %1, %9, %16\n\tglobal_load_dwordx4 %2, %10, %16\n\tglobal_load_dwordx4 %3, %11, %16\n\t"
                 "global_load_dwordx4 %4, %12, %16\n\tglobal_load_dwordx4 %5, %13, %16\n\tglobal_load_dwordx4 %6, %14, %16\n\tglobal_load_dwordx4 %7, %15, %16\n\ts_waitcnt vmcnt(0)"
        : "=&v"(d[0]), "=&v"(d[1]), "=&v"(d[2]), "=&v"(d[3]), "=&v"(d[4]), "=&v"(d[5]), "=&v"(d[6]), "=&v"(d[7])
        : "v"(vo[0]), "v"(vo[1]), "v"(vo[2]), "v"(vo[3]), "v"(vo[4]), "v"(vo[5]), "v"(vo[6]), "v"(vo[7]), "s"(uni_ptr(sb)) : "memory"); }
__device__ __forceinline__ void ld8_b64(f32x2 (&d)[8], const void* sb, const unsigned (&vo)[8]) {
    asm volatile("s_nop 4\n\tglobal_load_dwordx2 %0, %8, %16\n\tglobal_load_dwordx2 %1, %9, %16\n\tglobal_load_dwordx2 %2, %10, %16\n\tglobal_load_dwordx2 %3, %11, %16\n\t"
                 "global_load_dwordx2 %4, %12, %16\n\tglobal_load_dwordx2 %5, %13, %16\n\tglobal_load_dwordx2 %6, %14, %16\n\tglobal_load_dwordx2 %7, %15, %16\n\ts_waitcnt vmcnt(0)"
        : "=&v"(d[0]), "=&v"(d[1]), "=&v"(d[2]), "=&v"(d[3]), "=&v"(d[4]), "=&v"(d[5]), "=&v"(d[6]), "=&v"(d[7])
        : "v"(vo[0]), "v"(vo[1]), "v"(vo[2]), "v"(vo[3]), "v"(vo[4]), "v"(vo[5]), "v"(vo[6]), "v"(vo[7]), "s"(uni_ptr(sb)) : "memory"); }
__device__ __forceinline__ void ld16_res(f32x4 (&d)[16], const void* sb, const unsigned (&vo)[4]) {
    asm volatile("s_nop 4\n\t"
        "global_load_dwordx4 %0, %16, %20\n\tglobal_load_dwordx4 %1, %16, %20 offset:16\n\tglobal_load_dwordx4 %2, %16, %20 offset:512\n\tglobal_load_dwordx4 %3, %16, %20 offset:528\n\t"
        "global_load_dwordx4 %4, %17, %20\n\tglobal_load_dwordx4 %5, %17, %20 offset:16\n\tglobal_load_dwordx4 %6, %17, %20 offset:512\n\tglobal_load_dwordx4 %7, %17, %20 offset:528\n\t"
        "global_load_dwordx4 %8, %18, %20\n\tglobal_load_dwordx4 %9, %18, %20 offset:16\n\tglobal_load_dwordx4 %10, %18, %20 offset:512\n\tglobal_load_dwordx4 %11, %18, %20 offset:528\n\t"
        "global_load_dwordx4 %12, %19, %20\n\tglobal_load_dwordx4 %13, %19, %20 offset:16\n\tglobal_load_dwordx4 %14, %19, %20 offset:512\n\tglobal_load_dwordx4 %15, %19, %20 offset:528\n\t"
        "s_waitcnt vmcnt(0)"
        : "=&v"(d[0]), "=&v"(d[1]), "=&v"(d[2]), "=&v"(d[3]), "=&v"(d[4]), "=&v"(d[5]), "=&v"(d[6]), "=&v"(d[7]), "=&v"(d[8]), "=&v"(d[9]), "=&v"(d[10]), "=&v"(d[11]), "=&v"(d[12]), "=&v"(d[13]), "=&v"(d[14]), "=&v"(d[15])
        : "v"(vo[0]), "v"(vo[1]), "v"(vo[2]), "v"(vo[3]), "s"(uni_ptr(sb)) : "memory"); }
__device__ __forceinline__ void ld16_resb(u32x4 (&d)[16], const void* sb, const unsigned (&vo)[8]) {
    asm volatile("s_nop 4\n\t"
        "global_load_dwordx4 %0, %16, %24\n\tglobal_load_dwordx4 %1, %16, %24 offset:256\n\tglobal_load_dwordx4 %2, %17, %24\n\tglobal_load_dwordx4 %3, %17, %24 offset:256\n\t"
        "global_load_dwordx4 %4, %18, %24\n\tglobal_load_dwordx4 %5, %18, %24 offset:256\n\tglobal_load_dwordx4 %6, %19, %24\n\tglobal_load_dwordx4 %7, %19, %24 offset:256\n\t"
        "global_load_dwordx4 %8, %20, %24\n\tglobal_load_dwordx4 %9, %20, %24 offset:256\n\tglobal_load_dwordx4 %10, %21, %24\n\tglobal_load_dwordx4 %11, %21, %24 offset:256\n\t"
        "global_load_dwordx4 %12, %22, %24\n\tglobal_load_dwordx4 %13, %22, %24 offset:256\n\tglobal_load_dwordx4 %14, %23, %24\n\tglobal_load_dwordx4 %15, %23, %24 offset:256\n\t"
        "s_waitcnt vmcnt(0)"
        : "=&v"(d[0]), "=&v"(d[1]), "=&v"(d[2]), "=&v"(d[3]), "=&v"(d[4]), "=&v"(d[5]), "=&v"(d[6]), "=&v"(d[7]), "=&v"(d[8]), "=&v"(d[9]), "=&v"(d[10]), "=&v"(d[11]), "=&v"(d[12]), "=&v"(d[13]), "=&v"(d[14]), "=&v"(d[15])
        : "v"(vo[0]), "v"(vo[1]), "v"(vo[2]), "v"(vo[3]), "v"(vo[4]), "v"(vo[5]), "v"(vo[6]), "v"(vo[7]), "s"(uni_ptr(sb)) : "memory"); }
__device__ __forceinline__ void ld1_u128(u32x4& d, const void* sb, unsigned vo) {
    asm volatile("s_nop 4\n\tglobal_load_dwordx4 %0, %1, %2\n\ts_waitcnt vmcnt(0)" : "=&v"(d) : "v"(vo), "s"(uni_ptr(sb)) : "memory"); }
__device__ __forceinline__ void unpk8(const u32x4 w, f32x4& lo, f32x4& hi) {
    lo = (f32x4){__builtin_bit_cast(float, w.x << 16), __builtin_bit_cast(float, w.x & 0xffff0000u), __builtin_bit_cast(float, w.y << 16), __builtin_bit_cast(float, w.y & 0xffff0000u)};
    hi = (f32x4){__builtin_bit_cast(float, w.z << 16), __builtin_bit_cast(float, w.z & 0xffff0000u), __builtin_bit_cast(float, w.w << 16), __builtin_bit_cast(float, w.w & 0xffff0000u)}; }
__device__ __forceinline__ float rstd_from_slots(const f32x4 v) {
    float s = (v[0] + v[1]) + (v[2] + v[3]);
    s += xswz<16>(s); s = sum_halves(s);
    return __builtin_amdgcn_rsqf(s * (1.0f / 1024.0f) + 1e-5f);
}

__device__ __forceinline__ float rstd_from_slots32(const f32x4 a, const f32x4 b) {
    float s = ((a[0] + a[1]) + (a[2] + a[3])) + ((b[0] + b[1]) + (b[2] + b[3]));
    s += xswz<16>(s); s = sum_halves(s);
    return __builtin_amdgcn_rsqf(s * (1.0f / 1024.0f) + 1e-5f);
}

template <int ACT> struct EpiScaleAct {
    static constexpr bool PERM = true, AFTER_DRAIN = false, RESCALE = false;
    bf16_t* O; int ldc; const float* ss; int gelu_tiles;
    __device__ __forceinline__ void operator()(const f32x4 (&acc)[2][2][4][2], const Unit& u, int wr, int wc, int fr, int fq) const {
        bf16_t* Ot = O + ((size_t)u.pm * BM * ldc + (size_t)u.pn * BM); const float* sst = ss + (size_t)u.pm * BM * 16;
        unsigned rl0 = (unsigned)(wr * 64 + fr), cl0 = (unsigned)(wc * 32 + 8 * fq); const unsigned uld = (unsigned)ldc;
        asm volatile("" : "+v"(rl0), "+v"(cl0));
        const bool gl = (ACT == 0) && (u.pn < gelu_tiles);
        unsigned vo[8]; f32x4 sv[8]; float rsv[8];
#pragma unroll
        for (int i = 0; i < 8; ++i) vo[i] = ((rl0 + (unsigned)((i >> 2) * HALF + (i & 3) * 16)) * 16u + 4u * (unsigned)fq) * 4u;
        ld8_b128(sv, sst, vo);
#pragma unroll
        for (int i = 0; i < 8; ++i) rsv[i] = rstd_from_slots(sv[i]);
#pragma unroll
        for (int ai = 0; ai < 2; ++ai)
#pragma unroll
            for (int m = 0; m < 4; ++m) { const float rs = rsv[ai * 4 + m]; const unsigned off = (rl0 + (unsigned)(ai * HALF + m * 16)) * uld + cl0;
#pragma unroll
                for (int bj = 0; bj < 2; ++bj) { f32x4 v0 = acc[ai][bj][m][0] * rs, v1 = acc[ai][bj][m][1] * rs;
                    if (ACT == 0) { if (gl) { f32x2 a = gelu_pk((f32x2){v0[0], v0[1]}), b = gelu_pk((f32x2){v0[2], v0[3]}), c = gelu_pk((f32x2){v1[0], v1[1]}), d = gelu_pk((f32x2){v1[2], v1[3]});
                        v0 = (f32x4){a.x, a.y, b.x, b.y}; v1 = (f32x4){c.x, c.y, d.x, d.y}; } }
                    else { v0 = __builtin_elementwise_max(v0, (f32x4){0.f, 0.f, 0.f, 0.f}); v1 = __builtin_elementwise_max(v1, (f32x4){0.f, 0.f, 0.f, 0.f}); v0 = v0 * v0; v1 = v1 * v1; }
                    u32x4 w; w.x = cvt_pk_bf16(v0[0], v0[1]); w.y = cvt_pk_bf16(v0[2], v0[3]); w.z = cvt_pk_bf16(v1[0], v1[1]); w.w = cvt_pk_bf16(v1[2], v1[3]);
                    *(u32x4*)(Ot + (off + (unsigned)(bj * HALF))) = w; } }
    }
};
template <bool RS> struct EpiRes {
    static constexpr bool PERM = true, AFTER_DRAIN = false, RESCALE = RS;
    const float* baseP; const float* baseS; float* X; bf16_t* XB; float* ssout; const float* ssg;
    __device__ __forceinline__ void rescale(f32x4 (&acc)[2][2][4][2], const Unit& u, int wr, int fr) const {
        const float* sgt = ssg + (size_t)u.pm * BM * 2; unsigned rl0 = (unsigned)(wr * 64 + fr); asm volatile("" : "+v"(rl0));
        unsigned vo[8]; f32x2 gv[8];
#pragma unroll
        for (int i = 0; i < 8; ++i) vo[i] = (rl0 + (unsigned)((i >> 2) * HALF + (i & 3) * 16)) * 8u;
        ld8_b64(gv, sgt, vo);
#pragma unroll
        for (int ai = 0; ai < 2; ++ai)
#pragma unroll
            for (int m = 0; m < 4; ++m) { const f32x2 v = gv[ai * 4 + m];
                const float rs = __builtin_amdgcn_rsqf((v.x + v.y) * (1.0f / 512.0f) + 1e-5f);
#pragma unroll
                for (int bj = 0; bj < 2; ++bj)
#pragma unroll
                    for (int n = 0; n < 2; ++n) acc[ai][bj][m][n] = acc[ai][bj][m][n] * rs; }
    }
    __device__ __forceinline__ void operator()(const f32x4 (&acc)[2][2][4][2], const Unit& u, int wr, int wc, int fr, int fq) const {
        const size_t tb = (size_t)u.pm * BM * 1024 + (size_t)u.pn * BM;
        const float* bt = baseP + tb;
        float* Xt = X + tb; bf16_t* XBt = XB + tb; float* sot = ssout + ((size_t)u.pm * BM * 16 + (size_t)(u.pn * 4 + wc));
        unsigned rl0 = (unsigned)(wr * 64 + fr), cl0 = (unsigned)(wc * 32 + 8 * fq);
        asm volatile("" : "+v"(rl0), "+v"(cl0));
#pragma unroll
        for (int ai = 0; ai < 2; ++ai) {
            unsigned vo[4]; f32x4 bv[16];
#pragma unroll
            for (int m = 0; m < 4; ++m) vo[m] = ((rl0 + (unsigned)(ai * HALF + m * 16)) * 1024u + cl0) * 4u;
            ld16_res(bv, bt, vo);
#pragma unroll
            for (int m = 0; m < 4; ++m) { const unsigned rl = rl0 + (unsigned)(ai * HALF + m * 16), off = rl * 1024u + cl0; float sq = 0.f;
#pragma unroll
                for (int bj = 0; bj < 2; ++bj) { const unsigned o2 = off + (unsigned)(bj * HALF);
                    const f32x4 x0 = bv[4 * m + 2 * bj] + acc[ai][bj][m][0], x1 = bv[4 * m + 2 * bj + 1] + acc[ai][bj][m][1];
                    *(f32x4*)(Xt + o2) = x0; *(f32x4*)(Xt + (o2 + 4u)) = x1;
                    u32x4 w; w.x = cvt_pk_bf16(x0[0], x0[1]); w.y = cvt_pk_bf16(x0[2], x0[3]); w.z = cvt_pk_bf16(x1[0], x1[1]); w.w = cvt_pk_bf16(x1[2], x1[3]);
                    *(u32x4*)(XBt + o2) = w;
                    sq += (x0[0] * x0[0] + x0[1] * x0[1]) + (x0[2] * x0[2] + x0[3] * x0[3]) + (x1[0] * x1[0] + x1[1] * x1[1]) + (x1[2] * x1[2] + x1[3] * x1[3]); }
                sq += xswz<16>(sq); sq = sum_halves(sq);
                if (fq == 0) sot[rl * 16u] = sq; }
        }
    }
};

template <class Epi, class Sched, bool ALIGN_EPI = false, bool SP2 = false>
__device__ __forceinline__ void gemm_phase(PG8_LAS unsigned char* lds, const Gemm g, const Sched& S, const Epi& E, const int tid) {
    const int wid = __builtin_amdgcn_readfirstlane(tid >> 6), lane = tid & 63, wr = wid >> 2, wc = wid & 3, fr = lane & 15, fq = lane >> 4;
    const int K = g.K, nt = K / BK;
    unsigned voffA[2], voffB[2];
#pragma unroll
    for (int i = 0; i < 2; ++i) { int R, C; stage_rc(tid * 16 + i * 8192, R, C); const int Rb = Epi::PERM ? ((R & ~31) + perm32(R & 31)) : R;
        voffA[i] = (unsigned)(R * K + C) * 2u; voffB[i] = (unsigned)(Rb * K + C) * 2u; }
    const size_t kstep = (size_t)(BK * 2);
    const size_t hstep = (size_t)HALF * K * 2;
    const size_t tstep = 2 * hstep;
    const unsigned ldsw = (unsigned)wid * 1024u;
    const int aoff = lds_byte(wr * 64 + fr, fq * 8), boff = lds_byte(wc * 32 + fr, fq * 8);
#define PG8_SA(b, h) (((b) * 2 + (h)) * HTB)
#define PG8_SB(b, h) ((4 + (b) * 2 + (h)) * HTB)
#define PG8_STAGE(bufoff, gbase, voff) do { _Pragma("unroll") for (int _i = 0; _i < 2; ++_i) \
        __builtin_amdgcn_global_load_lds((const unsigned*)((const char*)(gbase) + (voff)[_i]), (PG8_LAS unsigned*)(lds + (bufoff) + ldsw + _i * 8192), 16, 0, 0); } while (0)
#define PG8_LDA(dst, b, h) do { _Pragma("unroll") for (int m = 0; m < 4; ++m) _Pragma("unroll") for (int k = 0; k < 2; ++k) dst[m][k] = *(const PG8_LAS bf16x8*)(lds + PG8_SA(b, h) + aoff + m * 2048 + k * 1024); } while (0)
#define PG8_LDB(dst, b, h) do { _Pragma("unroll") for (int n = 0; n < 2; ++n) _Pragma("unroll") for (int k = 0; k < 2; ++k) dst[n][k] = *(const PG8_LAS bf16x8*)(lds + PG8_SB(b, h) + boff + n * 2048 + k * 1024); } while (0)
#define PG8_MMA(ai, bj, At, Bt) do { __builtin_amdgcn_s_setprio(1); _Pragma("unroll") for (int m = 0; m < 4; ++m) _Pragma("unroll") for (int n = 0; n < 2; ++n) _Pragma("unroll") for (int k = 0; k < 2; ++k) \
        acc[ai][bj][m][n] = __builtin_amdgcn_mfma_f32_16x16x32_bf16(Bt[n][k], At[m][k], acc[ai][bj][m][n], 0, 0, 0); __builtin_amdgcn_s_setprio(0); } while (0)
#define PG8_WAIT_V(n) asm volatile("s_waitcnt vmcnt(" #n ")" ::: "memory")
#define PG8_WAIT_L(n) asm volatile("s_waitcnt lgkmcnt(" #n ")" ::: "memory")
#define PG8_BAR __builtin_amdgcn_s_barrier()
#define PG8_SCHED __builtin_amdgcn_sched_barrier(0)
    Unit cur, nxt; int ui = 0;
    if (!S.next(0, cur)) return;
    f32x4 acc[2][2][4][2];
#pragma unroll
    for (int a = 0; a < 2; ++a)
#pragma unroll
        for (int b = 0; b < 2; ++b)
#pragma unroll
            for (int m = 0; m < 4; ++m)
#pragma unroll
                for (int n = 0; n < 2; ++n) acc[a][b][m][n] = (f32x4){0.f, 0.f, 0.f, 0.f};
    bf16x8 At[4][2], B0[2][2], B1[2][2];
    const char* cA = (const char*)g.A + (size_t)cur.pm * tstep; const char* cB = (const char*)g.Bt + (size_t)cur.pn * tstep;
    S.a_ready(cur);
    if constexpr (SP2) {
        PG8_STAGE(PG8_SB(0, 0), cB, voffB); PG8_STAGE(PG8_SB(0, 1), cB + hstep, voffB); PG8_STAGE(PG8_SA(0, 0), cA, voffA); PG8_STAGE(PG8_SA(0, 1), cA + hstep, voffA);
        if (wr == 1) PG8_BAR;
        PG8_WAIT_V(2); PG8_BAR;
        PG8_STAGE(PG8_SB(1, 0), cB + kstep, voffB); PG8_STAGE(PG8_SA(1, 0), cA + kstep, voffA); PG8_STAGE(PG8_SB(1, 1), cB + hstep + kstep, voffB);
        PG8_WAIT_V(6); PG8_BAR;
    } else {
        PG8_STAGE(PG8_SB(0, 0), cB, voffB); PG8_STAGE(PG8_SA(0, 0), cA, voffA); PG8_STAGE(PG8_SB(0, 1), cB + hstep, voffB); PG8_STAGE(PG8_SA(0, 1), cA + hstep, voffA);
        if (wr == 1) PG8_BAR;
        PG8_WAIT_V(4); PG8_BAR;
        PG8_STAGE(PG8_SB(1, 0), cB + kstep, voffB); PG8_STAGE(PG8_SA(1, 0), cA + kstep, voffA); PG8_STAGE(PG8_SB(1, 1), cB + hstep + kstep, voffB);
        PG8_WAIT_V(6); PG8_BAR;
    }
    for (;;) {
        const bool has_next = S.next(ui + 1, nxt);
        const char* nA = has_next ? (const char*)g.A + (size_t)nxt.pm * tstep : cA; const char* nB = has_next ? (const char*)g.Bt + (size_t)nxt.pn * tstep : cB;
        for (int t = 0; t < nt; t += 2) {
            const bool last = (t == nt - 2);
            const char* a1 = cA + (size_t)(t + 1) * kstep;
            const char* a2 = last ? nA : cA + (size_t)(t + 2) * kstep; const char* b2 = last ? nB : cB + (size_t)(t + 2) * kstep;
            const char* a3 = a2 + kstep; const char* b3 = b2 + kstep;
            if (last && has_next) S.a_ready(nxt);
            if constexpr (Epi::RESCALE) { if (t == 8) E.rescale(acc, cur, wr, fr); }
            if constexpr (SP2) {
            PG8_LDB(B0, 0, 0); PG8_LDB(B1, 0, 1); PG8_SCHED; PG8_LDA(At, 0, 0); PG8_STAGE(PG8_SA(1, 1), a1 + hstep, voffA);
            PG8_WAIT_V(8); PG8_WAIT_L(0); PG8_BAR; PG8_MMA(0, 0, At, B0); PG8_MMA(0, 1, At, B1); PG8_BAR; PG8_SCHED;
            PG8_LDA(At, 0, 1); PG8_STAGE(PG8_SB(0, 0), b2, voffB); PG8_STAGE(PG8_SB(0, 1), b2 + hstep, voffB); PG8_STAGE(PG8_SA(0, 0), a2, voffA);
            PG8_WAIT_V(8); PG8_WAIT_L(0); PG8_BAR; PG8_MMA(1, 0, At, B0); PG8_MMA(1, 1, At, B1); PG8_BAR; PG8_SCHED;
            PG8_LDB(B0, 1, 0); PG8_LDB(B1, 1, 1); PG8_SCHED; PG8_LDA(At, 1, 0); PG8_STAGE(PG8_SA(0, 1), a2 + hstep, voffA);
            PG8_WAIT_V(8); PG8_WAIT_L(0); PG8_BAR; PG8_MMA(0, 0, At, B0); PG8_MMA(0, 1, At, B1); PG8_BAR; PG8_SCHED;
            PG8_LDA(At, 1, 1); PG8_STAGE(PG8_SB(1, 0), b3, voffB); PG8_STAGE(PG8_SB(1, 1), b3 + hstep, voffB); PG8_STAGE(PG8_SA(1, 0), a3, voffA);
            PG8_WAIT_V(8); PG8_WAIT_L(0); PG8_BAR; PG8_MMA(1, 0, At, B0); PG8_MMA(1, 1, At, B1); PG8_BAR; PG8_SCHED;
            } else {
            PG8_LDB(B0, 0, 0); PG8_SCHED; PG8_LDA(At, 0, 0); PG8_STAGE(PG8_SA(1, 1), a1 + hstep, voffA);
            PG8_WAIT_L(8); PG8_BAR; PG8_WAIT_L(0); PG8_MMA(0, 0, At, B0); PG8_BAR; PG8_SCHED;
            PG8_LDB(B1, 0, 1); PG8_STAGE(PG8_SB(0, 0), b2, voffB);
            PG8_BAR; PG8_WAIT_L(0); PG8_MMA(0, 1, At, B1); PG8_BAR;
            PG8_LDA(At, 0, 1); PG8_STAGE(PG8_SA(0, 0), a2, voffA);
            PG8_BAR; PG8_WAIT_L(0); PG8_MMA(1, 0, At, B0); PG8_BAR; PG8_SCHED;
            PG8_STAGE(PG8_SB(0, 1), b2 + hstep, voffB);
            PG8_WAIT_V(6); PG8_BAR; PG8_MMA(1, 1, At, B1); PG8_BAR;
            PG8_LDB(B0, 1, 0); PG8_SCHED; PG8_LDA(At, 1, 0); PG8_STAGE(PG8_SA(0, 1), a2 + hstep, voffA);
            PG8_WAIT_L(8); PG8_BAR; PG8_WAIT_L(0); PG8_MMA(0, 0, At, B0); PG8_BAR; PG8_SCHED;
            PG8_LDB(B1, 1, 1); PG8_STAGE(PG8_SB(1, 0), b3, voffB);
            PG8_BAR; PG8_WAIT_L(0); PG8_MMA(0, 1, At, B1); PG8_BAR;
            PG8_LDA(At, 1, 1); PG8_STAGE(PG8_SA(1, 0), a3, voffA);
            PG8_BAR; PG8_WAIT_L(0); PG8_MMA(1, 0, At, B0); PG8_BAR; PG8_SCHED;
            PG8_STAGE(PG8_SB(1, 1), b3 + hstep, voffB);
            PG8_WAIT_V(6); PG8_BAR; PG8_MMA(1, 1, At, B1); PG8_BAR;
            }
        }
        if constexpr (ALIGN_EPI) { if (wr == 0) PG8_BAR; }
        if constexpr (!Epi::AFTER_DRAIN) { E(acc, cur, wr, wc, fr, fq); S.done(cur); }
        if (!has_next) break;
#pragma unroll
        for (int a = 0; a < 2; ++a)
#pragma unroll
            for (int b = 0; b < 2; ++b)
#pragma unroll
                for (int m = 0; m < 4; ++m)
#pragma unroll
                    for (int n = 0; n < 2; ++n) acc[a][b][m][n] = (f32x4){0.f, 0.f, 0.f, 0.f};
        cur = nxt; cA = nA; cB = nB; ++ui;
        if constexpr (ALIGN_EPI) { if (wr == 1) PG8_BAR; }
    }
    PG8_WAIT_V(0);
    if constexpr (!ALIGN_EPI) { if (wr == 0) PG8_BAR; }
    PG8_BAR;
#undef PG8_SA
#undef PG8_SB
#undef PG8_STAGE
#undef PG8_LDA
#undef PG8_LDB
#undef PG8_MMA
#undef PG8_WAIT_V
#undef PG8_WAIT_L
#undef PG8_BAR
#undef PG8_SCHED
}

constexpr int EXOFF = 131072;
struct GemmX { const bf16_t* A; const bf16_t* AX; const bf16_t* Bt; int K; };
template <class Epi, class Sched>
__device__ __forceinline__ void gemm_phase_x(PG8_LAS unsigned char* lds, const GemmX g, const Sched& S, const Epi& E, const int tid) {
    const int wid = __builtin_amdgcn_readfirstlane(tid >> 6), lane = tid & 63, wr = wid >> 2, wc = wid & 3, fr = lane & 15, fq = lane >> 4;
    const int K = g.K, nt = K / BK;
    unsigned voffA[2], voffB[2];
#pragma unroll
    for (int i = 0; i < 2; ++i) { int R, C; stage_rc(tid * 16 + i * 8192, R, C); const int Rb = (R & ~31) + perm32(R & 31);
        voffA[i] = (unsigned)(R * K + C) * 2u; voffB[i] = (unsigned)(Rb * K + C) * 2u; }
    const unsigned voffX = (unsigned)((tid >> 5) * K + ((((tid & 31) >> 2) ^ ((tid >> 6) & 3)) * 4 + (tid & 3)) * 2) * 2u;
    const size_t kstep = (size_t)(BK * 2);
    const size_t hstep = (size_t)HALF * K * 2;
    const size_t tstep = 2 * hstep;
    const size_t xstep = (size_t)16 * K * 2;
    const unsigned ldsw = (unsigned)wid * 1024u;
    const int aoff = lds_byte(wr * 64 + fr, fq * 8), boff = lds_byte(wc * 32 + fr, fq * 8);
    const int xoff = EXOFF + fr * 128 + (fq ^ ((fr >> 1) & 3)) * 16;
#define PG8_SA(b, h) (((b) * 2 + (h)) * HTB)
#define PG8_SB(b, h) ((4 + (b) * 2 + (h)) * HTB)
#define PG8_STAGE(bufoff, gbase, voff) do { _Pragma("unroll") for (int _i = 0; _i < 2; ++_i) \
        __builtin_amdgcn_global_load_lds((const unsigned*)((const char*)(gbase) + (voff)[_i]), (PG8_LAS unsigned*)(lds + (bufoff) + ldsw + _i * 8192), 16, 0, 0); } while (0)
#define PG8_STAGEX(b, gbase) __builtin_amdgcn_global_load_lds((const unsigned*)((const char*)(gbase) + voffX), (PG8_LAS unsigned*)(lds + EXOFF + (b) * 2048 + wid * 256), 4, 0, 0)
#define PG8_LDA(dst, b, h) do { _Pragma("unroll") for (int m = 0; m < 4; ++m) _Pragma("unroll") for (int k = 0; k < 2; ++k) dst[m][k] = *(const PG8_LAS bf16x8*)(lds + PG8_SA(b, h) + aoff + m * 2048 + k * 1024); } while (0)
#define PG8_LDB(dst, b, h) do { _Pragma("unroll") for (int n = 0; n < 2; ++n) _Pragma("unroll") for (int k = 0; k < 2; ++k) dst[n][k] = *(const PG8_LAS bf16x8*)(lds + PG8_SB(b, h) + boff + n * 2048 + k * 1024); } while (0)
#define PG8_LDX(dst, b) do { _Pragma("unroll") for (int k = 0; k < 2; ++k) dst[k] = *(const PG8_LAS bf16x8*)(lds + (b) * 2048 + xoff + k * 64); } while (0)
#define PG8_MMA(ai, bj, At, Bt) do { __builtin_amdgcn_s_setprio(1); _Pragma("unroll") for (int m = 0; m < 4; ++m) _Pragma("unroll") for (int n = 0; n < 2; ++n) _Pragma("unroll") for (int k = 0; k < 2; ++k) \
        acc[ai][bj][m][n] = __builtin_amdgcn_mfma_f32_16x16x32_bf16(Bt[n][k], At[m][k], acc[ai][bj][m][n], 0, 0, 0); __builtin_amdgcn_s_setprio(0); } while (0)
#define PG8_MMAX(Bt) do { _Pragma("unroll") for (int n = 0; n < 2; ++n) _Pragma("unroll") for (int k = 0; k < 2; ++k) accx[n] = __builtin_amdgcn_mfma_f32_16x16x32_bf16(Bt[n][k], Ax[k], accx[n], 0, 0, 0); } while (0)
#define PG8_WAIT_V(n) asm volatile("s_waitcnt vmcnt(" #n ")" ::: "memory")
#define PG8_WAIT_L(n) asm volatile("s_waitcnt lgkmcnt(" #n ")" ::: "memory")
#define PG8_BAR __builtin_amdgcn_s_barrier()
#define PG8_SCHED __builtin_amdgcn_sched_barrier(0)
    Unit cur, nxt; int ui = 0;
    if (!S.next(0, cur)) return;
    f32x4 acc[2][2][4][2], accx[2];
#pragma unroll
    for (int a = 0; a < 2; ++a)
#pragma unroll
        for (int b = 0; b < 2; ++b)
#pragma unroll
            for (int m = 0; m < 4; ++m)
#pragma unroll
                for (int n = 0; n < 2; ++n) acc[a][b][m][n] = (f32x4){0.f, 0.f, 0.f, 0.f};
    accx[0] = (f32x4){0.f, 0.f, 0.f, 0.f}; accx[1] = (f32x4){0.f, 0.f, 0.f, 0.f};
    bf16x8 At[4][2], B0[2][2], B1[2][2], Ax[2];
    const char* cA = (const char*)g.A + (size_t)cur.pm * tstep; const char* cB = (const char*)g.Bt + (size_t)cur.pn * tstep; const char* cX = (const char*)g.AX + (size_t)cur.pm * xstep;
    PG8_STAGE(PG8_SB(0, 0), cB, voffB); PG8_STAGE(PG8_SB(0, 1), cB + hstep, voffB); PG8_STAGE(PG8_SA(0, 0), cA, voffA); PG8_STAGEX(0, cX); PG8_STAGE(PG8_SA(0, 1), cA + hstep, voffA);
    if (wr == 1) PG8_BAR;
    PG8_WAIT_V(2); PG8_BAR;
    PG8_STAGE(PG8_SB(1, 0), cB + kstep, voffB); PG8_STAGE(PG8_SA(1, 0), cA + kstep, voffA); PG8_STAGEX(1, cX + kstep); PG8_STAGE(PG8_SB(1, 1), cB + hstep + kstep, voffB);
    PG8_WAIT_V(7); PG8_BAR;
    for (;;) {
        const bool has_next = S.next(ui + 1, nxt);
        const char* nA = has_next ? (const char*)g.A + (size_t)nxt.pm * tstep : cA; const char* nB = has_next ? (const char*)g.Bt + (size_t)nxt.pn * tstep : cB;
        const char* nX = has_next ? (const char*)g.AX + (size_t)nxt.pm * xstep : cX;
        for (int t = 0; t < nt; t += 2) {
            const bool last = (t == nt - 2);
            const char* a1 = cA + (size_t)(t + 1) * kstep;
            const char* a2 = last ? nA : cA + (size_t)(t + 2) * kstep; const char* b2 = last ? nB : cB + (size_t)(t + 2) * kstep; const char* x2 = last ? nX : cX + (size_t)(t + 2) * kstep;
            const char* a3 = a2 + kstep; const char* b3 = b2 + kstep; const char* x3 = x2 + kstep;
            if constexpr (Epi::RESCALE) { if (t == 8) E.rescale(acc, accx, cur, wr, fr); }
            PG8_LDB(B0, 0, 0); PG8_LDB(B1, 0, 1); PG8_SCHED; PG8_LDA(At, 0, 0); PG8_LDX(Ax, 0); PG8_STAGE(PG8_SA(1, 1), a1 + hstep, voffA);
            PG8_WAIT_V(9); PG8_WAIT_L(0); PG8_BAR; PG8_MMA(0, 0, At, B0); PG8_MMA(0, 1, At, B1); if (wr == 0) PG8_MMAX(B0); else PG8_MMAX(B1); PG8_BAR; PG8_SCHED;
            PG8_LDA(At, 0, 1); PG8_STAGE(PG8_SB(0, 0), b2, voffB); PG8_STAGE(PG8_SB(0, 1), b2 + hstep, voffB); PG8_STAGE(PG8_SA(0, 0), a2, voffA); PG8_STAGEX(0, x2);
            PG8_WAIT_V(9); PG8_WAIT_L(0); PG8_BAR; PG8_MMA(1, 0, At, B0); PG8_MMA(1, 1, At, B1); PG8_BAR; PG8_SCHED;
            PG8_LDB(B0, 1, 0); PG8_LDB(B1, 1, 1); PG8_SCHED; PG8_LDA(At, 1, 0); PG8_LDX(Ax, 1); PG8_STAGE(PG8_SA(0, 1), a2 + hstep, voffA);
            PG8_WAIT_V(9); PG8_WAIT_L(0); PG8_BAR; PG8_MMA(0, 0, At, B0); PG8_MMA(0, 1, At, B1); if (wr == 0) PG8_MMAX(B0); else PG8_MMAX(B1); PG8_BAR; PG8_SCHED;
            PG8_LDA(At, 1, 1); PG8_STAGE(PG8_SB(1, 0), b3, voffB); PG8_STAGE(PG8_SB(1, 1), b3 + hstep, voffB); PG8_STAGE(PG8_SA(1, 0), a3, voffA); PG8_STAGEX(1, x3);
            PG8_WAIT_V(9); PG8_WAIT_L(0); PG8_BAR; PG8_MMA(1, 0, At, B0); PG8_MMA(1, 1, At, B1); PG8_BAR; PG8_SCHED;
        }
        if (wr == 0) PG8_BAR;
        E(acc, accx, cur, wr, wc, fr, fq);
        if (!has_next) break;
#pragma unroll
        for (int a = 0; a < 2; ++a)
#pragma unroll
            for (int b = 0; b < 2; ++b)
#pragma unroll
                for (int m = 0; m < 4; ++m)
#pragma unroll
                    for (int n = 0; n < 2; ++n) acc[a][b][m][n] = (f32x4){0.f, 0.f, 0.f, 0.f};
        accx[0] = (f32x4){0.f, 0.f, 0.f, 0.f}; accx[1] = (f32x4){0.f, 0.f, 0.f, 0.f};
        cur = nxt; cA = nA; cB = nB; cX = nX; ++ui;
        if (wr == 1) PG8_BAR;
    }
    PG8_WAIT_V(0);
    PG8_BAR;
#undef PG8_SA
#undef PG8_SB
#undef PG8_STAGE
#undef PG8_STAGEX
#undef PG8_LDA
#undef PG8_LDB
#undef PG8_LDX
#undef PG8_MMA
#undef PG8_MMAX
#undef PG8_WAIT_V
#undef PG8_WAIT_L
#undef PG8_BAR
#undef PG8_SCHED
}
template <int ACT> struct EpiScaleActX {
    static constexpr bool RESCALE = false;
    bf16_t* O; bf16_t* OS; int ldc; const float* ss; const float* ssx; int gelu_tiles;
    __device__ __forceinline__ void act8(f32x4& v0, f32x4& v1, bool gl) const {
        if (ACT == 0) { if (gl) { f32x2 a = gelu_pk((f32x2){v0[0], v0[1]}), b = gelu_pk((f32x2){v0[2], v0[3]}), c = gelu_pk((f32x2){v1[0], v1[1]}), d = gelu_pk((f32x2){v1[2], v1[3]});
            v0 = (f32x4){a.x, a.y, b.x, b.y}; v1 = (f32x4){c.x, c.y, d.x, d.y}; } }
        else { v0 = __builtin_elementwise_max(v0, (f32x4){0.f, 0.f, 0.f, 0.f}); v1 = __builtin_elementwise_max(v1, (f32x4){0.f, 0.f, 0.f, 0.f}); v0 = v0 * v0; v1 = v1 * v1; }
    }
    __device__ __forceinline__ void operator()(const f32x4 (&acc)[2][2][4][2], const f32x4 (&accx)[2], const Unit& u, int wr, int wc, int fr, int fq) const {
        bf16_t* Ot = O + ((size_t)u.pm * BM * ldc + (size_t)u.pn * BM); const float* sst = ss + (size_t)u.pm * BM * 16;
        unsigned rl0 = (unsigned)(wr * 64 + fr), cl0 = (unsigned)(wc * 32 + 8 * fq); const unsigned uld = (unsigned)ldc; unsigned frv = (unsigned)fr;
        asm volatile("" : "+v"(rl0), "+v"(cl0), "+v"(frv));
        const bool gl = (ACT == 0) && (u.pn < gelu_tiles);
        {
            f32x4 s0, s1; ld2_b128(s0, s1, ssx + (size_t)u.pm * 16 * 32, (frv * 32u + 8u * (unsigned)fq) * 4u); const float rs = rstd_from_slots32(s0, s1);
            f32x4 v0 = accx[0] * rs, v1 = accx[1] * rs; act8(v0, v1, gl);
            u32x4 w; w.x = cvt_pk_bf16(v0[0], v0[1]); w.y = cvt_pk_bf16(v0[2], v0[3]); w.z = cvt_pk_bf16(v1[0], v1[1]); w.w = cvt_pk_bf16(v1[2], v1[3]);
            *(u32x4*)(OS + ((size_t)u.pm * 16 * ldc + (size_t)u.pn * BM) + (frv * uld + (unsigned)(wr * HALF) + cl0)) = w; }
        unsigned vo[8]; f32x4 sv[8]; float rsv[8];
#pragma unroll
        for (int i = 0; i < 8; ++i) vo[i] = ((rl0 + (unsigned)((i >> 2) * HALF + (i & 3) * 16)) * 16u + 4u * (unsigned)fq) * 4u;
        ld8_b128(sv, sst, vo);
#pragma unroll
        for (int i = 0; i < 8; ++i) rsv[i] = rstd_from_slots(sv[i]);
#pragma unroll
        for (int ai = 0; ai < 2; ++ai)
#pragma unroll
            for (int m = 0; m < 4; ++m) { const float rs = rsv[ai * 4 + m]; const unsigned off = (rl0 + (unsigned)(ai * HALF + m * 16)) * uld + cl0;
#pragma unroll
                for (int bj = 0; bj < 2; ++bj) { f32x4 v0 = acc[ai][bj][m][0] * rs, v1 = acc[ai][bj][m][1] * rs; act8(v0, v1, gl);
                    u32x4 w; w.x = cvt_pk_bf16(v0[0], v0[1]); w.y = cvt_pk_bf16(v0[2], v0[3]); w.z = cvt_pk_bf16(v1[0], v1[1]); w.w = cvt_pk_bf16(v1[2], v1[3]);
                    *(u32x4*)(Ot + (off + (unsigned)(bj * HALF))) = w; } }
    }
};
template <bool RS> struct EpiResX {
    static constexpr bool RESCALE = RS;
    bf16_t* XB; float* ssout; float* ssxout; const float* ssg;
    __device__ __forceinline__ void rescale(f32x4 (&acc)[2][2][4][2], f32x4 (&accx)[2], const Unit& u, int wr, int fr) const {
        const float* sgt = ssg + (size_t)u.pm * BM * 2; unsigned rl0 = (unsigned)(wr * 64 + fr), frv = (unsigned)fr; asm volatile("" : "+v"(rl0), "+v"(frv));
        unsigned vo[8]; f32x2 gv[8]; f32x2 gx;
#pragma unroll
        for (int i = 0; i < 8; ++i) vo[i] = (rl0 + (unsigned)((i >> 2) * HALF + (i & 3) * 16)) * 8u;
        ld1_b64(gx, ssg + ((size_t)16384 + (size_t)u.pm * 16) * 2, frv * 8u);
        ld8_b64(gv, sgt, vo);
        { const float rs = __builtin_amdgcn_rsqf((gx.x + gx.y) * (1.0f / 512.0f) + 1e-5f); accx[0] = accx[0] * rs; accx[1] = accx[1] * rs; }
#pragma unroll
        for (int ai = 0; ai < 2; ++ai)
#pragma unroll
            for (int m = 0; m < 4; ++m) { const f32x2 v = gv[ai * 4 + m];
                const float rs = __builtin_amdgcn_rsqf((v.x + v.y) * (1.0f / 512.0f) + 1e-5f);
#pragma unroll
                for (int bj = 0; bj < 2; ++bj)
#pragma unroll
                    for (int n = 0; n < 2; ++n) acc[ai][bj][m][n] = acc[ai][bj][m][n] * rs; }
    }
    __device__ __forceinline__ void operator()(const f32x4 (&acc)[2][2][4][2], const f32x4 (&accx)[2], const Unit& u, int wr, int wc, int fr, int fq) const {
        const size_t tb = (size_t)u.pm * BM * 1024 + (size_t)u.pn * BM;
        bf16_t* XBt = XB + tb; float* sot = ssout + ((size_t)u.pm * BM * 16 + (size_t)(u.pn * 4 + wc));
        unsigned rl0 = (unsigned)(wr * 64 + fr), cl0 = (unsigned)(wc * 32 + 8 * fq), frv = (unsigned)fr;
        asm volatile("" : "+v"(rl0), "+v"(cl0), "+v"(frv));
        {
            const size_t sb = (size_t)u.pm * 16 * 1024 + (size_t)u.pn * BM; const unsigned off = frv * 1024u + (unsigned)(wr * HALF) + cl0;
            bf16_t* XBs = XB + ((size_t)16384 * 1024 + sb);
            u32x4 br; ld1_u128(br, XBs, off * 2u); f32x4 b0, b1; unpk8(br, b0, b1);
            const f32x4 x0 = b0 + accx[0], x1 = b1 + accx[1];
            u32x4 w; w.x = cvt_pk_bf16(x0[0], x0[1]); w.y = cvt_pk_bf16(x0[2], x0[3]); w.z = cvt_pk_bf16(x1[0], x1[1]); w.w = cvt_pk_bf16(x1[2], x1[3]);
            *(u32x4*)(XBs + off) = w;
            float sq = (x0[0] * x0[0] + x0[1] * x0[1]) + (x0[2] * x0[2] + x0[3] * x0[3]) + (x1[0] * x1[0] + x1[1] * x1[1]) + (x1[2] * x1[2] + x1[3] * x1[3]);
            sq += xswz<16>(sq); sq = sum_halves(sq);
            if (fq == 0) ssxout[((size_t)u.pm * 16) * 32 + (size_t)(u.pn * 8 + wr * 4 + wc) + frv * 32u] = sq; }
        unsigned vo[8]; u32x4 bv[16];
#pragma unroll
        for (int i = 0; i < 8; ++i) vo[i] = ((rl0 + (unsigned)((i >> 2) * HALF + (i & 3) * 16)) * 1024u + cl0) * 2u;
        ld16_resb(bv, XBt, vo);
#pragma unroll
        for (int ai = 0; ai < 2; ++ai) {
#pragma unroll
            for (int m = 0; m < 4; ++m) { const unsigned rl = rl0 + (unsigned)(ai * HALF + m * 16), off = rl * 1024u + cl0; float sq = 0.f;
#pragma unroll
                for (int bj = 0; bj < 2; ++bj) { const unsigned o2 = off + (unsigned)(bj * HALF);
                    f32x4 b0, b1; unpk8(bv[2 * (4 * ai + m) + bj], b0, b1);
                    const f32x4 x0 = b0 + acc[ai][bj][m][0], x1 = b1 + acc[ai][bj][m][1];
                    u32x4 w; w.x = cvt_pk_bf16(x0[0], x0[1]); w.y = cvt_pk_bf16(x0[2], x0[3]); w.z = cvt_pk_bf16(x1[0], x1[1]); w.w = cvt_pk_bf16(x1[2], x1[3]);
                    *(u32x4*)(XBt + o2) = w;
                    sq += (x0[0] * x0[0] + x0[1] * x0[1]) + (x0[2] * x0[2] + x0[3] * x0[3]) + (x1[0] * x1[0] + x1[1] * x1[1]) + (x1[2] * x1[2] + x1[3] * x1[3]); }
                sq += xswz<16>(sq); sq = sum_halves(sq);
                if (fq == 0) sot[rl * 16u] = sq; }
        }
    }
};

constexpr int SM_STAGE_BYTES = 32768, SM_SQ_OFF = 148480;
template <int TS, class EpiS>
__device__ __forceinline__ void small_gemm_phase(PG8_LAS unsigned char* lds, const bf16_t* A, const bf16_t* Bt, const int K, const int nN, const int n_units, const int first_unit, const int unit_stride, const EpiS& E, const int tid) {
    constexpr int NP = TS / 64, NM = TS == 128 ? 4 : 1, LPS = 2 * NP;
    const int wid = __builtin_amdgcn_readfirstlane(tid >> 6), lane = tid & 63, fr = lane & 15, fq = lane >> 4;
    const int wr = TS == 128 ? (wid >> 2) : 0, wc = TS == 128 ? (wid & 3) : (wid >> 2), mq = wid & 3;
    const int nt = K / BK;
    unsigned voffA[NP], voffB[NP];
#pragma unroll
    for (int i = 0; i < NP; ++i) { int R, C; stage_rc(tid * 16 + i * 8192, R, C); const int Rb = (R & ~31) + perm32(R & 31); voffA[i] = (unsigned)(R * K + C) * 2u; voffB[i] = (unsigned)(Rb * K + C) * 2u; }
    const unsigned ldsw = (unsigned)wid * 1024u;
    const int aoff = TS == 128 ? lds_byte(wr * 64 + fr, fq * 8) : lds_byte(mq * 16 + fr, fq * 8), boff = 16384 + lds_byte(wc * 32 + fr, fq * 8);
#define SM_STAGE(st, kt) do { _Pragma("unroll") for (int _i = 0; _i < NP; ++_i) { \
        __builtin_amdgcn_global_load_lds((const unsigned*)(cA + voffA[_i] + (size_t)(kt) * 128), (PG8_LAS unsigned*)(lds + (st) * SM_STAGE_BYTES + ldsw + _i * 8192), 16, 0, 0); \
        __builtin_amdgcn_global_load_lds((const unsigned*)(cB + voffB[_i] + (size_t)(kt) * 128), (PG8_LAS unsigned*)(lds + (st) * SM_STAGE_BYTES + 16384 + ldsw + _i * 8192), 16, 0, 0); } } while (0)
#define SM_WAIT_V(n) asm volatile("s_waitcnt vmcnt(%0)" :: "n"(n) : "memory")
    for (int u = first_unit; u < n_units; u += unit_stride) {
        const int pm = u / nN, pn = u % nN;
        const char* cA = (const char*)A + (size_t)pm * TS * K * 2; const char* cB = (const char*)Bt + (size_t)pn * TS * K * 2;
        f32x4 acc[NM][2];
#pragma unroll
        for (int m = 0; m < NM; ++m) { acc[m][0] = (f32x4){0.f, 0.f, 0.f, 0.f}; acc[m][1] = (f32x4){0.f, 0.f, 0.f, 0.f}; }
        E.begin(pm, pn, wr, mq, fr);
        asm volatile("s_waitcnt vmcnt(0)" ::: "memory"); __builtin_amdgcn_s_barrier();
        SM_STAGE(0, 0); SM_STAGE(1, 1); SM_STAGE(2, 2);
        f32x4 pre0 = (f32x4){0.f, 0.f, 0.f, 0.f}, pre1 = pre0, pre2 = pre0, pre3 = pre0;
        if constexpr (TS == 64) E.pre(pre0, pre1, pre2, pre3, pm, mq, fr, fq);
#pragma unroll 1
        for (int t = 0; t < nt; ++t) {
            if (t + 2 < nt) SM_WAIT_V(2 * LPS); else if (t + 1 < nt) SM_WAIT_V(LPS); else SM_WAIT_V(0);
            __builtin_amdgcn_s_barrier();
            if (t + 3 < nt) SM_STAGE((t + 3) & 3, t + 3);
            if (E.RESCALE) { if (t == 8) E.rescale(acc); }
            const PG8_LAS unsigned char* sb = lds + (t & 3) * SM_STAGE_BYTES;
            bf16x8 Af[NM][2], Bf[2][2];
#pragma unroll
            for (int m = 0; m < NM; ++m)
#pragma unroll
                for (int k = 0; k < 2; ++k) Af[m][k] = *(const PG8_LAS bf16x8*)(sb + aoff + m * 2048 + k * 1024);
#pragma unroll
            for (int n = 0; n < 2; ++n)
#pragma unroll
                for (int k = 0; k < 2; ++k) Bf[n][k] = *(const PG8_LAS bf16x8*)(sb + boff + n * 2048 + k * 1024);
#pragma unroll
            for (int m = 0; m < NM; ++m)
#pragma unroll
                for (int n = 0; n < 2; ++n)
#pragma unroll
                    for (int k = 0; k < 2; ++k) acc[m][n] = __builtin_amdgcn_mfma_f32_16x16x32_bf16(Bf[n][k], Af[m][k], acc[m][n], 0, 0, 0);
        }
        if constexpr (TS == 64) E.store_pre(acc, pre0, pre1, pre2, pre3, pm, wc, mq, fr, fq); else E.store(acc, pm, pn, wr, wc, mq, fr, fq, lds, tid);
    }
    asm volatile("s_waitcnt vmcnt(0)" ::: "memory"); __builtin_amdgcn_s_barrier();
#undef SM_STAGE
#undef SM_WAIT_V
}
struct SEpiFF1 {
    static constexpr bool RESCALE = false;
    bf16_t* O; int ldc; const float* ss; int row_base;
    __device__ __forceinline__ void begin(int, int, int, int, int) const {}
    __device__ __forceinline__ void rescale(f32x4 (&)[4][2]) const {}
    __device__ __forceinline__ void store(const f32x4 (&acc)[4][2], int pm, int pn, int wr, int wc, int, int fr, int fq, PG8_LAS unsigned char*, int) const {
        const size_t r0 = (size_t)row_base + (size_t)pm * 128; bf16_t* Ot = O + (r0 * ldc + (size_t)pn * 128); const float* sst = ss + r0 * 16;
        unsigned rl0 = (unsigned)(wr * 64 + fr), cl0 = (unsigned)(wc * 32 + 8 * fq); asm volatile("" : "+v"(rl0), "+v"(cl0));
        unsigned vo[4]; f32x4 sv[4];
#pragma unroll
        for (int m = 0; m < 4; ++m) vo[m] = ((rl0 + (unsigned)(m * 16)) * 16u + 4u * (unsigned)fq) * 4u;
        ld4_b128(sv, sst, vo);
#pragma unroll
        for (int m = 0; m < 4; ++m) { const unsigned rl = rl0 + (unsigned)(m * 16); const float rs = rstd_from_slots(sv[m]);
            f32x4 v0 = acc[m][0] * rs, v1 = acc[m][1] * rs;
            v0 = __builtin_elementwise_max(v0, (f32x4){0.f, 0.f, 0.f, 0.f}); v1 = __builtin_elementwise_max(v1, (f32x4){0.f, 0.f, 0.f, 0.f}); v0 = v0 * v0; v1 = v1 * v1;
            u32x4 w; w.x = cvt_pk_bf16(v0[0], v0[1]); w.y = cvt_pk_bf16(v0[2], v0[3]); w.z = cvt_pk_bf16(v1[0], v1[1]); w.w = cvt_pk_bf16(v1[2], v1[3]);
            *(u32x4*)(Ot + (rl * (unsigned)ldc + cl0)) = w; }
    }
};
struct SEpiDt {
    static constexpr bool RESCALE = false;
    float* DT; const float* ss; const float* bias; const float* ssx;
    __device__ __forceinline__ void begin(int, int, int, int, int) const {}
    __device__ __forceinline__ void rescale(f32x4 (&)[1][2]) const {}
    __device__ __forceinline__ void pre(f32x4& s0, f32x4& s1, f32x4& b0, f32x4& b1, int pm, int mq, int fr, int fq) const {
        b0 = *(const f32x4*)bias; b1 = *(const f32x4*)(bias + 4);
        const size_t r0 = (size_t)pm * 64; const unsigned rl = (unsigned)(mq * 16 + fr);
        if (pm < 256) s0 = *(const f32x4*)(ss + (r0 + rl) * 16 + 4 * fq);
        else { const float* q = ssx + (r0 - 16384 + rl) * 32 + 8 * fq; s0 = *(const f32x4*)q; s1 = *(const f32x4*)(q + 4); }
    }
    __device__ __forceinline__ void store_pre(const f32x4 (&acc)[1][2], const f32x4& s0, const f32x4& s1, const f32x4& b0, const f32x4& b1, int pm, int wc, int mq, int fr, int fq) const {
        const size_t r0 = (size_t)pm * 64; const unsigned rl = (unsigned)(mq * 16 + fr);
        const float rs = pm < 256 ? rstd_from_slots(s0) : rstd_from_slots32(s0, s1);
        if (wc == 0 && fq == 0) { f32x4 d0, d1;
#pragma unroll
            for (int i = 0; i < 4; ++i) { d0[i] = softplus_f(acc[0][0][i] * rs + b0[i]); d1[i] = softplus_f(acc[0][1][i] * rs + b1[i]); }
            float* dst = DT + (r0 + rl) * 8; *(f32x4*)dst = d0; *(f32x4*)(dst + 4) = d1; }
    }
    __device__ __forceinline__ void store(const f32x4 (&acc)[1][2], int pm, int, int, int wc, int mq, int fr, int fq, PG8_LAS unsigned char*, int) const {
        const size_t r0 = (size_t)pm * 64; unsigned rl = (unsigned)(mq * 16 + fr); asm volatile("" : "+v"(rl));
        float rs;
        if (pm < 256) { f32x4 sv; ld1_b128(sv, ss + r0 * 16, (rl * 16u + 4u * (unsigned)fq) * 4u); rs = rstd_from_slots(sv); }
        else { f32x4 s0, s1; ld2_b128(s0, s1, ssx + (r0 - 16384) * 32, (rl * 32u + 8u * (unsigned)fq) * 4u); rs = rstd_from_slots32(s0, s1); }
        if (wc == 0 && fq == 0) { const f32x4 b0 = *(const f32x4*)bias, b1 = *(const f32x4*)(bias + 4); f32x4 d0, d1;
#pragma unroll
            for (int i = 0; i < 4; ++i) { d0[i] = softplus_f(acc[0][0][i] * rs + b0[i]); d1[i] = softplus_f(acc[0][1][i] * rs + b1[i]); }
            float* dst = DT + (r0 + rl) * 8; *(f32x4*)dst = d0; *(f32x4*)(dst + 4) = d1; }
    }
};
template <bool RS> struct SEpiRes {
    static constexpr bool RESCALE = RS;
    const float* base; float* X; bf16_t* XB; float* ssout; const float* ssg; int row_base;
    mutable float rsl;
    __device__ __forceinline__ void begin(int pm, int, int, int mq, int fr) const {
        if (RS) { f32x2 v; ld1_b64(v, ssg + ((size_t)row_base + (size_t)pm * 64) * 2, (unsigned)(mq * 16 + fr) * 8u); rsl = __builtin_amdgcn_rsqf((v.x + v.y) * (1.0f / 512.0f) + 1e-5f); }
    }
    __device__ __forceinline__ void rescale(f32x4 (&acc)[1][2]) const { acc[0][0] = acc[0][0] * rsl; acc[0][1] = acc[0][1] * rsl; }
    __device__ __forceinline__ void store(const f32x4 (&acc)[1][2], int pm, int pn, int, int wc, int mq, int fr, int fq, PG8_LAS unsigned char* lds, int tid) const {
        const size_t r0 = (size_t)row_base + (size_t)pm * 64, tb = r0 * 1024 + (size_t)pn * 64;
        const float* bt = base + tb; float* Xt = X + tb; bf16_t* XBt = XB + tb;
        unsigned rl = (unsigned)(mq * 16 + fr), cl0 = (unsigned)(wc * 32 + 8 * fq); asm volatile("" : "+v"(rl), "+v"(cl0));
        const unsigned off = rl * 1024u + cl0;
        f32x4 b0, b1; ld2_b128(b0, b1, bt, off * 4u);
        const f32x4 x0 = b0 + acc[0][0], x1 = b1 + acc[0][1];
        *(f32x4*)(Xt + off) = x0; *(f32x4*)(Xt + (off + 4u)) = x1;
        u32x4 w; w.x = cvt_pk_bf16(x0[0], x0[1]); w.y = cvt_pk_bf16(x0[2], x0[3]); w.z = cvt_pk_bf16(x1[0], x1[1]); w.w = cvt_pk_bf16(x1[2], x1[3]);
        *(u32x4*)(XBt + off) = w;
        float sq = (x0[0] * x0[0] + x0[1] * x0[1]) + (x0[2] * x0[2] + x0[3] * x0[3]) + (x1[0] * x1[0] + x1[1] * x1[1]) + (x1[2] * x1[2] + x1[3] * x1[3]);
        sq += xswz<16>(sq); sq = sum_halves(sq);
        PG8_LAS float* sqp = (PG8_LAS float*)(lds + SM_SQ_OFF);
        if (fq == 0) sqp[rl * 2u + (unsigned)wc] = sq;
        asm volatile("s_waitcnt lgkmcnt(0)" ::: "memory"); __builtin_amdgcn_s_barrier(); asm volatile("" ::: "memory");
        if (tid < 64) ssout[(r0 + (size_t)tid) * 16 + pn] = sqp[tid * 2] + sqp[tid * 2 + 1];
    }
};
}

constexpr int NWAVES = 8;
constexpr int DM = 1024, DEPTH = 4, MP = 16384, MS = 1024, M = MP + MS, SEQ = 2048, DSEQ = 8, NB = 8, NDB = 128;
constexpr int DIN = 2824, DING = 2816, FF = 4096;
constexpr int C_U = 0, C_V = 256, C_BG = 512, C_CG = 768, C_HB = 1024, C_Z = 1280, C_XBC = 1792, C_DT = 2816;
constexpr float EPS = 1e-5f;
constexpr size_t O_YP = 0, O_YS = 16777216, O_CVP = 17825792, O_CP = 18874368, O_SCP = 18890752, O_SP = 18989056, O_CVS = 21086208, O_CS = 22134784, O_SCS = 22396928, O_SS = 23969792, O_END = 57524224;
enum { I_XP = 0, I_XS, I_SC, I_SSC, I_SSM, I_N1, I_WIN, I_WS, I_BS, I_CW, I_SCW, I_SCB, I_DTB, I_ALOG, I_DSK, I_SSN, I_WOUT, I_N2, I_W1, I_W2, I_FN, N_IN };

constexpr size_t al256(size_t x) { return (x + 255) & ~(size_t)255; }
constexpr size_t WS_CTL = 0, CTL_ZERO_BYTES = 1u << 20;
constexpr size_t WS_WIN = CTL_ZERO_BYTES;
constexpr size_t WS_WOUT = WS_WIN + (size_t)DEPTH * DING * DM * 2;
constexpr size_t WS_W1 = WS_WOUT + (size_t)DEPTH * DM * DM * 2;
constexpr size_t WS_W2 = WS_W1 + (size_t)DEPTH * FF * DM * 2;
constexpr size_t WS_WDT = WS_W2 + (size_t)DEPTH * DM * FF * 2;
constexpr size_t WS_WDTB = WS_WDT + (size_t)DEPTH * DM * 8 * 4;
constexpr size_t WS_WMB = WS_WDTB + (size_t)DEPTH * 64 * DM * 2;
constexpr size_t WS_XB = WS_WMB + (size_t)DEPTH * 4 * 128 * 128 * 2;
constexpr size_t WS_SS1 = WS_XB + (size_t)M * DM * 2;
constexpr size_t WS_SS2 = WS_SS1 + (size_t)M * 16 * 4;
constexpr size_t WS_SSX1 = WS_SS2 + (size_t)M * 16 * 4;
constexpr size_t WS_SSX2 = WS_SSX1 + (size_t)MS * 32 * 4;
constexpr size_t WS_DT = WS_SSX2 + (size_t)MS * 32 * 4;
constexpr size_t WS_CUM = WS_DT + (size_t)M * 8 * 4;
constexpr size_t WS_SSG = WS_CUM + (size_t)M * 8 * 4;
constexpr size_t WS_CD = WS_SSG + (size_t)M * 2 * 4;
constexpr size_t WS_YCAT = WS_CD + 64 * 16 * 4;
constexpr size_t WS_YS = WS_YCAT + (size_t)M * DM * 2;
constexpr size_t WS_XBCS = WS_YS + (size_t)MS * 512 * 4;
constexpr size_t WS_XBCB = WS_XBCS + (size_t)MS * DM * 4;
constexpr size_t WS_SBUF = WS_XBCB + (size_t)MP * DM * 2;
constexpr size_t WS_HB = WS_SBUF + (size_t)64 * 16 * 8192 * 4;
constexpr size_t WS_PROJ = WS_HB + (size_t)64 * 16 * 8192 * 2;
constexpr size_t WS_HID = WS_PROJ + (size_t)M * DING * 2;
constexpr size_t WS_END = WS_HID + (size_t)M * FF * 2;
static_assert(WS_PROJ + (size_t)M * DING * 2 <= WS_END, "HID overlay");
static_assert(WS_WIN % 256 == 0 && WS_XB % 256 == 0 && WS_SS1 % 256 == 0 && WS_PROJ % 256 == 0 && WS_XBCB % 256 == 0 && WS_SBUF % 256 == 0 && WS_HB % 256 == 0 && WS_YCAT % 256 == 0 && WS_WMB % 256 == 0, "align");
constexpr int CW_BAR = 4096;
#ifndef CVT_SHARES
#define CVT_SHARES 0, 0, 1, 1, 2, 2, 3, 3
#endif
__device__ __forceinline__ constexpr int CVT_SHARE(int j) { constexpr int t[8] = {CVT_SHARES}; return t[j]; }

constexpr int RING_BYTES = 131072, PHASE_LDS = 147456, LDSCTL_OFF = PHASE_LDS, MISC_OFF = LDSCTL_OFF + 320, LDS_BYTES = 151552;

#define GAS __attribute__((address_space(1)))
#define LAS __attribute__((address_space(3)))
typedef unsigned short bf16;
typedef unsigned v4u __attribute__((ext_vector_type(4)));
typedef unsigned v2u __attribute__((ext_vector_type(2)));
typedef float f32x4 __attribute__((ext_vector_type(4)));
typedef GAS unsigned gu32;
#define RLX_AGENT __ATOMIC_RELAXED, __HIP_MEMORY_SCOPE_AGENT
#define LDS_WAIT() asm volatile("s_waitcnt lgkmcnt(0)" ::: "memory")
#define LAUNDER_V(x) asm volatile("" : "+v"(x))
#define LAUNDER_S(x) asm volatile("" : "+s"(x))
__device__ __forceinline__ unsigned f2bf(float f) { unsigned u = __builtin_bit_cast(unsigned, f); return (u + 0x7fffu + ((u >> 16) & 1u)) >> 16; }
__device__ __forceinline__ unsigned pk2(float lo, float hi) { return f2bf(lo) | (f2bf(hi) << 16); }
__device__ __forceinline__ float bf2f(unsigned b) { return __builtin_bit_cast(float, b << 16); }
__device__ __forceinline__ float bflo(unsigned w) { return __builtin_bit_cast(float, w << 16); }
__device__ __forceinline__ float bfhi(unsigned w) { return __builtin_bit_cast(float, w & 0xffff0000u); }

#define XB_TMO      128
#define XB_XCNT(j)  (256  + 64 * (j))
#define XB_XSUB(j)  (1280 + 64 * (j))
#define XB_XGEN(j)  (2304 + 64 * (j))
#define XB_TOP      3328
#define XB_TOPGEN   3392
#define XB_HTOP(h)  (3456 + 128 * (h))
#define XCD_BAR_WORDS 3712
#define XB_SPIN_CAP (1u << 18)
__device__ __forceinline__ unsigned xb_ld(unsigned* p)              { return __hip_atomic_load(p, __ATOMIC_RELAXED, __HIP_MEMORY_SCOPE_AGENT); }
__device__ __forceinline__ unsigned xb_add(unsigned* p, unsigned v) { return __hip_atomic_fetch_add(p, v, __ATOMIC_RELAXED, __HIP_MEMORY_SCOPE_AGENT); }
__device__ __forceinline__ unsigned xb_xcc_id() { return (unsigned)__builtin_amdgcn_s_getreg((3 << 11) | 20) & 0xFu; }
#define XB_SPIN(cond, bar) do { unsigned _sp = 0; while (cond) { __builtin_amdgcn_s_sleep(1); \
    if ((++_sp & 255u) == 0u) { if (xb_ld(&(bar)[XB_TMO])) break; if (_sp > XB_SPIN_CAP) { atomicAdd(&(bar)[XB_TMO], 1u); break; } } } } while (0)
struct XcdBarrier { unsigned* bar; unsigned x; volatile LAS unsigned* st; };
__device__ __forceinline__ XcdBarrier xcd_barrier_post(unsigned* bar, volatile LAS unsigned* st) {
    XcdBarrier b; b.bar = bar; b.x = xb_xcc_id(); b.st = st;
    if (threadIdx.x == 0) st[2] = xb_add(&bar[XB_XCNT(b.x)], 1u) + 1u;
    return b;
}
__device__ __forceinline__ void xcd_barrier_complete(unsigned* bar, unsigned x, unsigned& nloc, unsigned& nx, unsigned& even) {
    const unsigned G = gridDim.x * gridDim.y * gridDim.z;
    asm volatile("" : "+s"(x));
    unsigned sum, cnt, mine, sp = 0u;
    for (;;) {
        sum = 0u; cnt = 0u; mine = 0u;
#pragma unroll
        for (unsigned j = 0; j < 16; ++j) { const unsigned c = xb_ld(&bar[XB_XCNT(j)]); sum += c; cnt += (c > 0u) ? 1u : 0u; mine = (j == x) ? c : mine; }
        if (sum == G) break;
        __builtin_amdgcn_s_sleep(1);
        if ((++sp & 255u) == 0u) { if (xb_ld(&bar[XB_TMO])) break; if (sp > XB_SPIN_CAP) { atomicAdd(&bar[XB_TMO], 1u); break; } }
    }
    nloc = mine > 0u ? mine : 1u; nx = cnt > 0u ? cnt : 1u;
    bool ev = (G == 256u) && (cnt == 8u);
#pragma unroll
    for (unsigned j = 0; j < 8; ++j) ev = ev && (xb_ld(&bar[XB_XCNT(j)]) == 32u);
    even = ev ? 1u : 2u;
}
__device__ __forceinline__ void xcd_barrier(const XcdBarrier& b, const bool local = false, const int half = -1, unsigned* wflag = nullptr, const unsigned wneed = 0u, const bool sig = false) {
    asm volatile("s_waitcnt vmcnt(0)" ::: "memory");
    __syncthreads();
    if (threadIdx.x == 0) {
        unsigned* bar = b.bar;
        __builtin_amdgcn_s_waitcnt(0);
        unsigned nloc = b.st[0], nx = b.st[1];
        if (nloc == 0u) { unsigned ev_; xcd_barrier_complete(bar, b.x, nloc, nx, ev_); b.st[0] = nloc; b.st[1] = nx; b.st[3] = ev_; }
        const unsigned topi = half >= 0 ? (unsigned)XB_HTOP(half) : (unsigned)XB_TOP; if (half >= 0) nx = 4u;
        const unsigned old = xb_add(&bar[XB_XSUB(b.x)], 1u);
        const unsigned gen = old / nloc;
        if (local) {
            if (old + 1u == (gen + 1u) * nloc) {
                if (sig) {
                    __builtin_amdgcn_fence(__ATOMIC_RELEASE, "agent"); asm volatile("s_waitcnt vmcnt(0)" ::: "memory");
                    const unsigned oc = xb_add(&bar[XB_HTOP(0)], 1u); if (oc + 1u == 8u) xb_add(&bar[XB_HTOP(0) + 64], 1u); }
                if (wneed) XB_SPIN(xb_ld(wflag) < wneed, bar);
                xb_add(&bar[XB_XGEN(b.x)], 1u); }
            else XB_SPIN(xb_ld(&bar[XB_XGEN(b.x)]) == gen, bar);
            __builtin_amdgcn_fence(__ATOMIC_ACQUIRE, "agent");
            asm volatile("s_waitcnt vmcnt(0)" ::: "memory");
        } else if (old + 1u == (gen + 1u) * nloc) {
            __builtin_amdgcn_fence(__ATOMIC_RELEASE, "agent");
            asm volatile("s_waitcnt vmcnt(0)" ::: "memory");
            const unsigned og = xb_add(&bar[topi], 1u);
            const unsigned tg = og / nx;
            if (og + 1u == (tg + 1u) * nx) xb_add(&bar[topi + 64u], 1u);
            else XB_SPIN(xb_ld(&bar[topi + 64u]) == tg, bar);
            if (wneed) XB_SPIN(xb_ld(wflag) < wneed, bar);
            __builtin_amdgcn_fence(__ATOMIC_ACQUIRE, "agent");
            xb_add(&bar[XB_XGEN(b.x)], 1u);
            asm volatile("s_waitcnt vmcnt(0)" ::: "memory");
        } else {
            XB_SPIN(xb_ld(&bar[XB_XGEN(b.x)]) == gen, bar);
            __builtin_amdgcn_fence(__ATOMIC_ACQUIRE, "agent");
            asm volatile("s_waitcnt vmcnt(0)" ::: "memory");
        }
    }
    __syncthreads();
}

struct Args { const float* in[N_IN]; float* out; unsigned char* ws; int ph_lo, ph_hi; };
struct Frame {
    LAS unsigned char* lds;
    int tid, lane, wave, vcu, G, bid;
    const __attribute__((address_space(4))) Args* ap; float* out; unsigned char* ws;
    __device__ __forceinline__ const float* inp(int i) const { return ap->in[i]; }
};
__device__ __forceinline__ float wave_sum(float v) {
    v += xswz<1>(v); v += xswz<2>(v); v += xswz<4>(v); v += xswz<8>(v); v += xswz<16>(v); v = sum_halves(v);
    return v;
}
__device__ __forceinline__ float silu_f(float v) { return v * __builtin_amdgcn_rcpf(1.0f + __expf(-v)); }
struct CvtItem { const float* W; const float* gain; bf16* WT; int ldw, K, gain_n, krot, k0, n0; };
struct CvtRegs { f32x4 w[8]; float g; };
__device__ __forceinline__ CvtItem cvt_item(const Frame& F, int it) {
    constexpr int I_IN = (DM / 64) * (DING / 32), I_O = (DM / 64) * (DM / 32), I_1 = (DM / 64) * (FF / 32), I_2 = (FF / 64) * (DM / 32), I_L = I_IN + I_O + I_1 + I_2;
    const int l = it / I_L; int r = it % I_L; CvtItem d; int nblk;
    if (r < I_IN) { d.W = F.inp(I_WIN) + (size_t)l * DM * DIN; d.ldw = DIN; d.K = DM; nblk = DING / 32; d.gain = F.inp(I_N1) + l * DM; d.gain_n = DM; d.krot = 0; d.WT = (bf16*)(F.ws + WS_WIN) + (size_t)l * DING * DM; }
    else if ((r -= I_IN) < I_O) { d.W = F.inp(I_WOUT) + (size_t)l * DM * DM; d.ldw = DM; d.K = DM; nblk = DM / 32; d.gain = F.inp(I_SSN) + l * 512; d.gain_n = 512; d.krot = 512; d.WT = (bf16*)(F.ws + WS_WOUT) + (size_t)l * DM * DM; }
    else if ((r -= I_O) < I_1) { d.W = F.inp(I_W1) + (size_t)l * DM * FF; d.ldw = FF; d.K = DM; nblk = FF / 32; d.gain = F.inp(I_N2) + l * DM; d.gain_n = DM; d.krot = 0; d.WT = (bf16*)(F.ws + WS_W1) + (size_t)l * FF * DM; }
    else { r -= I_1; d.W = F.inp(I_W2) + (size_t)l * FF * DM; d.ldw = DM; d.K = FF; nblk = DM / 32; d.gain = F.inp(I_N1); d.gain_n = 0; d.krot = 0; d.WT = (bf16*)(F.ws + WS_W2) + (size_t)l * DM * FF; }
    d.k0 = 64 * (r / nblk); d.n0 = 32 * (r % nblk);
    return d;
}
__device__ __forceinline__ void cvt_load(const CvtItem& d, CvtRegs& R, int lane) {
    const int gmask = d.gain_n > 0 ? d.gain_n - 1 : 0;
#pragma unroll
    for (int s8 = 0; s8 < 8; ++s8) { const int ks = (d.k0 + 8 * s8 + (lane >> 3) + d.krot) & (d.K - 1); R.w[s8] = *(const f32x4*)(d.W + (size_t)ks * d.ldw + d.n0 + 4 * (lane & 7)); }
    R.g = d.gain[(d.k0 + lane) & gmask];
}
__device__ __forceinline__ void cvt_finish(const CvtItem& d, const CvtRegs& R, LAS float* scr, int lane) {
    const float gl = (d.k0 + lane < d.gain_n) ? R.g : 1.0f;
#pragma unroll
    for (int s8 = 0; s8 < 8; ++s8) { const int kk = 8 * s8 + (lane >> 3);
        const float g = __builtin_bit_cast(float, __builtin_amdgcn_ds_bpermute(4 * kk, __builtin_bit_cast(int, gl)));
        LAS float* q = scr + kk * 33 + 4 * (lane & 7); const f32x4 v = R.w[s8] * g; q[0] = v.x; q[1] = v.y; q[2] = v.z; q[3] = v.w; }
    LDS_WAIT(); asm volatile("" ::: "memory");
    const int c = lane & 7;
#pragma unroll
    for (int j = 0; j < 4; ++j) { const int n = (lane >> 3) + 8 * j; const LAS float* sp = scr + (8 * c) * 33 + n;
        v4u o; o.x = pk2(sp[0 * 33], sp[1 * 33]); o.y = pk2(sp[2 * 33], sp[3 * 33]); o.z = pk2(sp[4 * 33], sp[5 * 33]); o.w = pk2(sp[6 * 33], sp[7 * 33]);
        *(v4u*)(d.WT + (size_t)(d.n0 + n) * d.K + d.k0 + 8 * c) = o; }
    LDS_WAIT(); asm volatile("" ::: "memory");
}
__device__ __forceinline__ const float* xin_row(const Frame& F, int l, int r) {
    if (l == 0) return r < MP ? F.inp(I_XP) + (size_t)r * DM : F.inp(I_XS) + (size_t)(r - MP) * DM;
    return F.out + (size_t)r * DM;
}
__device__ __forceinline__ void p0_prologue(const Frame& F, const int role, const int blo = 0, const int bhi = 0) {
    LAS float* scr = (LAS float*)(F.lds + F.wave * 16384);
    constexpr int I_IN = (DM / 64) * (DING / 32), I_O = (DM / 64) * (DM / 32), I_1 = (DM / 64) * (FF / 32), I_2 = (FF / 64) * (DM / 32), I_L = I_IN + I_O + I_1 + I_2;
    const int gw = role == 4 ? (F.vcu & 31) * NWAVES + F.wave : F.vcu * NWAVES + F.wave, NGW = role == 4 ? 32 * NWAVES : F.G * NWAVES;
    const int it_lo = role == 4 ? blo : 0, it_hi = role == 4 ? bhi : (role == 3 ? I_IN : DEPTH * I_L);
    {
        CvtRegs R0, R1, R2; const int j0 = it_lo + gw;
        if (j0 < it_hi) cvt_load(cvt_item(F, j0), R0, F.lane);
        if (j0 + NGW < it_hi) cvt_load(cvt_item(F, j0 + NGW), R1, F.lane);
        if (j0 + 2 * NGW < it_hi) cvt_load(cvt_item(F, j0 + 2 * NGW), R2, F.lane);
#pragma unroll 1
        for (int it = j0; it < it_hi; it += 3 * NGW) {
            cvt_finish(cvt_item(F, it), R0, scr, F.lane); if (it + 3 * NGW < it_hi) cvt_load(cvt_item(F, it + 3 * NGW), R0, F.lane);
            if (it + NGW < it_hi) { cvt_finish(cvt_item(F, it + NGW), R1, scr, F.lane); if (it + 4 * NGW < it_hi) cvt_load(cvt_item(F, it + 4 * NGW), R1, F.lane); }
            if (it + 2 * NGW < it_hi) { cvt_finish(cvt_item(F, it + 2 * NGW), R2, scr, F.lane); if (it + 5 * NGW < it_hi) cvt_load(cvt_item(F, it + 5 * NGW), R2, F.lane); }
        }
    }
    const int gt = gw * 64 + F.lane, NGT = NGW * 64;
    if (role != 4) {
    for (int i = gt; i < DEPTH * DM * 8; i += NGT) { const int l = i / (DM * 8), k = (i / 8) % DM, j = i % 8;
        ((float*)(F.ws + WS_WDT))[i] = F.inp(I_N1)[l * DM + k] * F.inp(I_WIN)[((size_t)l * DM + k) * DIN + C_DT + j]; }
    for (int i = gt; i < DEPTH * 64 * DM; i += NGT) { const int l = i / (64 * DM), n = (i / DM) % 64, k = i % DM;
        ((bf16*)(F.ws + WS_WDTB))[i] = n < 8 ? (bf16)f2bf(F.inp(I_N1)[l * DM + k] * F.inp(I_WIN)[((size_t)l * DM + k) * DIN + C_DT + n]) : (bf16)0; }
    for (int i = gt; i < DEPTH * 4 * 128 * 128; i += NGT) { const int t = (i >> 7) & 127, s = i & 127; ((bf16*)(F.ws + WS_WMB))[i] = s <= t ? (bf16)f2bf(F.inp(I_WS)[i]) : (bf16)0; }
    }
    for (int gi = gw; gi < (role == 4 ? 0 : M / 4); gi += NGW) {
        const int r4 = 4 * gi;
        f32x4 v[4][4];
#pragma unroll
        for (int q = 0; q < 4; ++q) { const f32x4* xr = (const f32x4*)xin_row(F, 0, r4 + q) + F.lane;
#pragma unroll
            for (int j = 0; j < 4; ++j) v[q][j] = xr[64 * j]; }
#pragma unroll
        for (int q = 0; q < 4; ++q) { float s = 0.f; v2u* o8 = (v2u*)((bf16*)(F.ws + WS_XB) + (size_t)(r4 + q) * DM) + F.lane;
#pragma unroll
            for (int j = 0; j < 4; ++j) { const f32x4 x = v[q][j]; s += (x.x * x.x + x.y * x.y) + (x.z * x.z + x.w * x.w); v2u w; w.x = pk2(x.x, x.y); w.y = pk2(x.z, x.w); o8[64 * j] = w; }
            s = wave_sum(s);
            if (r4 + q < MP) { if (F.lane < 16) ((float*)(F.ws + WS_SS1))[(size_t)(r4 + q) * 16 + F.lane] = F.lane == 0 ? s : 0.f; }
            else if (F.lane < 32) ((float*)(F.ws + WS_SSX1))[(size_t)(r4 + q - MP) * 32 + F.lane] = F.lane == 0 ? s : 0.f; }
    }
}

typedef float f32x16 __attribute__((ext_vector_type(16)));
typedef short s16x8 __attribute__((ext_vector_type(8)));
constexpr int LDT = 136;
constexpr int YC_YC = 0, YC_YA = 512, YC_YB = 768;
__device__ __forceinline__ f32x16 mma32(const LAS bf16* A, const LAS bf16* B, int K, f32x16 acc, int lane) {
    const LAS bf16* ap = A + (lane & 31) * LDT + 8 * (lane >> 5); const LAS bf16* bp = B + (lane & 31) * LDT + 8 * (lane >> 5);
    for (int k = 0; k < K; k += 16) { const s16x8 a = *(const LAS s16x8*)(ap + k), b = *(const LAS s16x8*)(bp + k); acc = __builtin_amdgcn_mfma_f32_32x32x16_bf16(a, b, acc, 0, 0, 0); }
    return acc;
}
__device__ __forceinline__ int crow(int reg, int half) { return (reg & 3) + 8 * (reg >> 2) + 4 * half; }
__device__ __forceinline__ void unpack8(const v4u w, float (&f)[8]) { f[0] = bflo(w.x); f[1] = bfhi(w.x); f[2] = bflo(w.y); f[3] = bfhi(w.y); f[4] = bflo(w.z); f[5] = bfhi(w.z); f[6] = bflo(w.w); f[7] = bfhi(w.w); }
__device__ __forceinline__ v4u pack8(float a, float b, float c, float d, float e, float f, float g, float h) { v4u w; w.x = pg8::cvt_pk_bf16(a, b); w.y = pg8::cvt_pk_bf16(c, d); w.z = pg8::cvt_pk_bf16(e, f); w.w = pg8::cvt_pk_bf16(g, h); return w; }
__device__ __forceinline__ float rstd_row16(const float* ss, int r) {
    const f32x4* p = (const f32x4*)(ss + (size_t)r * 16); const f32x4 a = p[0], b = p[1], c = p[2], d = p[3];
    const float s = ((a.x + a.y) + (a.z + a.w)) + ((b.x + b.y) + (b.z + b.w)) + ((c.x + c.y) + (c.z + c.w)) + ((d.x + d.y) + (d.z + d.w));
    return 1.0f / sqrtf(s * (1.0f / DM) + EPS);
}

__device__ __forceinline__ void m1_prompt_unit(const Frame& F, int l, int u) {
    const int g = u & 1, c = (u >> 1) & 15, b = u >> 5, r0 = b * SEQ + c * 128;
    int tid = F.tid, lane = F.lane, w = F.wave;
#define M_RELAUNDER() do { LAUNDER_V(tid); lane = tid & 63; w = __builtin_amdgcn_readfirstlane(tid >> 6); } while (0)
    LAS float* rs = (LAS float*)F.lds;
    LAS float* dtl = rs + 128;
    LAS float* cuml = dtl + 1024;
    LAS float* wl = cuml + 1024;
    LAS bf16* XTp = (LAS bf16*)(F.lds + 16384);
    LAS bf16* BmT = XTp + 256 * LDT;
    LAS bf16* VT = XTp;
    LAS bf16* Wl = XTp + 128 * LDT;
    const bf16* PROJ = (const bf16*)(F.ws + WS_PROJ); bf16* YCAT = (bf16*)(F.ws + WS_YCAT); bf16* XBCB = (bf16*)(F.ws + WS_XBCB);
    __syncthreads();
    { const float* DTg = (const float*)(F.ws + WS_DT) + (size_t)r0 * 8; dtl[tid] = DTg[tid]; dtl[tid + 512] = DTg[tid + 512]; }
    __syncthreads();
    M_RELAUNDER();
    if (tid < 8) { const float A = -expf(F.inp(I_ALOG)[l * 8 + tid]); float cs = 0.f;
#pragma unroll 8
        for (int t = 0; t < 128; ++t) { cs += dtl[t * 8 + tid] * A; cuml[t * 8 + tid] = cs; } }
    __syncthreads();
    for (int i = tid; i < 1024; i += NWAVES * 64) { const int t = i >> 3, h = i & 7; const float d = dtl[i], cs = cuml[i], tot = cuml[127 * 8 + h];
        wl[i] = __expf(tot - cs) * d;
        if ((h >> 2) == g) { ((float*)(F.ws + WS_CUM))[(size_t)(r0 + t) * 8 + h] = cs;
            if (t == 127) ((float*)(F.ws + WS_CD))[(b * 8 + h) * 16 + c] = __expf(tot); } }
    __syncthreads();
    M_RELAUNDER();
    {
        const float* scw = F.inp(I_SCW) + l * 4 * 1024; const float* scb = F.inp(I_SCB) + l * 1024;
        const int co = tid & 63, tg = w, t0 = 16 * tg;
        const int ch = co < 32 ? 256 * g + 8 * co : (co < 48 ? 512 + 128 * g + 8 * (co - 32) : 768 + 128 * g + 8 * (co - 48));
        v4u xr[19];
#pragma unroll
        for (int i = 0; i < 19; ++i) { const int t = t0 - 3 + i;
            if (t >= 0 || c > 0) xr[i] = *(const v4u*)(PROJ + (size_t)(r0 + t) * DING + C_XBC + ch); else xr[i] = (v4u){0u, 0u, 0u, 0u}; }
        float wk[4][8], bias[8];
#pragma unroll
        for (int k = 0; k < 4; ++k) { const f32x4 a = *(const f32x4*)(scw + k * 1024 + ch), bq = *(const f32x4*)(scw + k * 1024 + ch + 4); wk[k][0] = a.x; wk[k][1] = a.y; wk[k][2] = a.z; wk[k][3] = a.w; wk[k][4] = bq.x; wk[k][5] = bq.y; wk[k][6] = bq.z; wk[k][7] = bq.w; }
        { const f32x4 a = *(const f32x4*)(scb + ch), bq = *(const f32x4*)(scb + ch + 4); bias[0] = a.x; bias[1] = a.y; bias[2] = a.z; bias[3] = a.w; bias[4] = bq.x; bias[5] = bq.y; bias[6] = bq.z; bias[7] = bq.w; }
        asm volatile("" ::: "memory");
        if (c == 15 && tg == 7) {
#pragma unroll
            for (int i = 16; i < 19; ++i) { float xv[8]; unpack8(xr[i], xv); float* dst = F.out + O_SCP + ((size_t)(l * NB + b) * 3 + (i - 16)) * 1024 + ch;
                *(f32x4*)dst = (f32x4){xv[0], xv[1], xv[2], xv[3]}; *(f32x4*)(dst + 4) = (f32x4){xv[4], xv[5], xv[6], xv[7]}; }
        }
#pragma unroll
        for (int q = 0; q < 4; ++q) {
            float x[7][8];
#pragma unroll
            for (int i = 0; i < 7; ++i) unpack8(xr[4 * q + i], x[i]);
            float o[4][8];
#pragma unroll
            for (int tt = 0; tt < 4; ++tt) {
#pragma unroll
                for (int j = 0; j < 8; ++j) { const float v = bias[j] + wk[0][j] * x[tt][j] + wk[1][j] * x[tt + 1][j] + wk[2][j] * x[tt + 2][j] + wk[3][j] * x[tt + 3][j]; o[tt][j] = silu_f(v); }
                *(v4u*)(XBCB + (size_t)(r0 + t0 + 4 * q + tt) * DM + ch) = pack8(o[tt][0], o[tt][1], o[tt][2], o[tt][3], o[tt][4], o[tt][5], o[tt][6], o[tt][7]); }
            if (co < 32) { const int h = 4 * g + (co >> 3); float sc[4];
#pragma unroll
                for (int tt = 0; tt < 4; ++tt) sc[tt] = wl[(t0 + 4 * q + tt) * 8 + h];
#pragma unroll
                for (int j = 0; j < 8; ++j) { v2u pw; pw.x = pg8::cvt_pk_bf16(o[0][j] * sc[0], o[1][j] * sc[1]); pw.y = pg8::cvt_pk_bf16(o[2][j] * sc[2], o[3][j] * sc[3]); *(LAS v2u*)(XTp + (8 * co + j) * LDT + t0 + 4 * q) = pw; }
            } else if (co < 48) {
#pragma unroll
                for (int j = 0; j < 8; ++j) { v2u pw; pw.x = pg8::cvt_pk_bf16(o[0][j], o[1][j]); pw.y = pg8::cvt_pk_bf16(o[2][j], o[3][j]); *(LAS v2u*)(BmT + (8 * (co - 32) + j) * LDT + t0 + 4 * q) = pw; }
            }
        }
    }
    __syncthreads();
    M_RELAUNDER();
    {
        const int pb = w >> 2, nb = w & 3; bf16* SB = (bf16*)(F.ws + WS_SBUF);
#pragma unroll 1
        for (int hl = 0; hl < 4; ++hl) {
            f32x16 acc;
#pragma unroll
            for (int i = 0; i < 16; ++i) acc[i] = 0.f;
            acc = mma32(XTp + (hl * 64 + 32 * pb) * LDT, BmT + (32 * nb) * LDT, 128, acc, lane);
            bf16* dst = SB + (((size_t)(b * 8 + 4 * g + hl) * 16 + c) * 64 + 32 * pb) * 128 + 32 * nb + (lane & 30);
            const bool odd = (lane & 1) != 0;
#pragma unroll
            for (int reg = 0; reg < 16; reg += 2) { const float a0 = acc[reg], a1 = acc[reg + 1], n0 = xswz<1>(a0), n1 = xswz<1>(a1);
                const unsigned pw = pg8::cvt_pk_bf16(odd ? n1 : a0, odd ? a1 : n0);
                *(unsigned*)(dst + (crow(reg, lane >> 5) + (odd ? 1 : 0)) * 128) = pw; }
        }
    }
    __syncthreads();
    M_RELAUNDER();
    {
        LAS bf16* Wl2 = Wl + 128 * LDT;
        { const int eo = tid & 15, tq = tid >> 4, t0 = 4 * tq, col = C_V + 128 * g + 8 * eo; float vv[4][8];
#pragma unroll
            for (int tt = 0; tt < 4; ++tt) unpack8(*(const v4u*)(PROJ + (size_t)(r0 + t0 + tt) * DING + col), vv[tt]);
            const bf16* wsrc = (const bf16*)(F.ws + WS_WMB) + (size_t)(l * 4 + 2 * g) * 128 * 128; v4u wv[8];
#pragma unroll
            for (int j = 0; j < 8; ++j) { const int i = tid + 512 * j; wv[j] = *(const v4u*)(wsrc + (size_t)i * 8); }
            asm volatile("" ::: "memory");
#pragma unroll
            for (int j = 0; j < 8; ++j) { v2u pw; pw.x = pg8::cvt_pk_bf16(vv[0][j], vv[1][j]); pw.y = pg8::cvt_pk_bf16(vv[2][j], vv[3][j]); *(LAS v2u*)(VT + (8 * eo + j) * LDT + t0) = pw; }
            if (c == 15) {
#pragma unroll
                for (int tt = 0; tt < 4; ++tt) { float* dst = F.out + O_CVP + ((size_t)(l * NB + b) * 128 + t0 + tt) * 256 + 128 * g + 8 * eo;
                    *(f32x4*)dst = (f32x4){vv[tt][0], vv[tt][1], vv[tt][2], vv[tt][3]}; *(f32x4*)(dst + 4) = (f32x4){vv[tt][4], vv[tt][5], vv[tt][6], vv[tt][7]}; } }
#pragma unroll
            for (int j = 0; j < 8; ++j) { const int i = tid + 512 * j, hh = i >> 11, row = (i >> 4) & 127, ck = i & 15; *(LAS v4u*)((hh ? Wl2 : Wl) + row * LDT + 8 * ck) = wv[j]; }
        }
        __syncthreads();
        const int tb = w & 3, eh = w >> 2;
#pragma unroll
        for (int hh = 0; hh < 2; ++hh) {
            const int ha = 2 * g + hh;
            f32x16 acc;
#pragma unroll
            for (int i = 0; i < 16; ++i) acc[i] = 0.f;
            acc = mma32((hh ? Wl2 : Wl) + (32 * tb) * LDT, VT + (hh * 64 + 32 * eh) * LDT, 32 * (tb + 1), acc, lane);
            const int e = 32 * eh + (lane & 31), col = ha * 64 + e; const float* bsv = F.inp(I_BS) + (l * 4 + ha) * 128;
            unsigned ur[16]; f32x4 bq[4];
#pragma unroll
            for (int reg = 0; reg < 16; ++reg) ur[reg] = PROJ[(size_t)(r0 + 32 * tb + crow(reg, lane >> 5)) * DING + C_U + col];
#pragma unroll
            for (int q4 = 0; q4 < 4; ++q4) bq[q4] = *(const f32x4*)(bsv + 32 * tb + 8 * q4 + 4 * (lane >> 5));
#pragma unroll
            for (int reg = 0; reg < 16; ++reg) { const int t = 32 * tb + crow(reg, lane >> 5); const float sv = acc[reg] + bq[reg >> 2][reg & 3];
                YCAT[(size_t)(r0 + t) * DM + YC_YA + col] = (bf16)f2bf(bf2f(ur[reg]) * sv); }
        }
        __syncthreads();
    }
    M_RELAUNDER();
    {
        const int co = tid & 15, tq = tid >> 4, t0 = 4 * tq, ch = 128 * g + 8 * co; const float* cw = F.inp(I_CW) + l * 3 * 256 + ch;
        v4u ra[6], rh[6], rb[4];
#pragma unroll
        for (int i = 0; i < 6; ++i) { const int t = t0 - 2 + i;
            if (t >= 0 || c > 0) { ra[i] = *(const v4u*)(PROJ + (size_t)(r0 + t) * DING + C_CG + ch); rh[i] = *(const v4u*)(PROJ + (size_t)(r0 + t) * DING + C_HB + ch); }
            else { ra[i] = (v4u){0u, 0u, 0u, 0u}; rh[i] = (v4u){0u, 0u, 0u, 0u}; } }
#pragma unroll
        for (int tt = 0; tt < 4; ++tt) rb[tt] = *(const v4u*)(PROJ + (size_t)(r0 + t0 + tt) * DING + C_BG + ch);
        asm volatile("" ::: "memory");
        float w0[8], w1[8], w2[8];
        { const f32x4 a = *(const f32x4*)cw, bq = *(const f32x4*)(cw + 4); w0[0] = a.x; w0[1] = a.y; w0[2] = a.z; w0[3] = a.w; w0[4] = bq.x; w0[5] = bq.y; w0[6] = bq.z; w0[7] = bq.w; }
        { const f32x4 a = *(const f32x4*)(cw + 256), bq = *(const f32x4*)(cw + 260); w1[0] = a.x; w1[1] = a.y; w1[2] = a.z; w1[3] = a.w; w1[4] = bq.x; w1[5] = bq.y; w1[6] = bq.z; w1[7] = bq.w; }
        { const f32x4 a = *(const f32x4*)(cw + 512), bq = *(const f32x4*)(cw + 516); w2[0] = a.x; w2[1] = a.y; w2[2] = a.z; w2[3] = a.w; w2[4] = bq.x; w2[5] = bq.y; w2[6] = bq.z; w2[7] = bq.w; }
        float cin[6][8];
#pragma unroll
        for (int i = 0; i < 6; ++i) { float a[8], hb[8]; unpack8(ra[i], a); unpack8(rh[i], hb);
#pragma unroll
            for (int j = 0; j < 8; ++j) cin[i][j] = a[j] * hb[j]; }
#pragma unroll
        for (int tt = 0; tt < 4; ++tt) { float bg[8], yb[8]; unpack8(rb[tt], bg);
#pragma unroll
            for (int j = 0; j < 8; ++j) yb[j] = bg[j] * (w0[j] * cin[tt][j] + w1[j] * cin[tt + 1][j] + w2[j] * cin[tt + 2][j]);
            *(v4u*)(YCAT + (size_t)(r0 + t0 + tt) * DM + YC_YB + ch) = pack8(yb[0], yb[1], yb[2], yb[3], yb[4], yb[5], yb[6], yb[7]); }
        if (c == 15 && tq == 31) {
#pragma unroll
            for (int tt = 2; tt < 4; ++tt) { float* dst = F.out + O_CP + ((size_t)(l * NB + b) * 2 + (tt - 2)) * 256 + ch;
                *(f32x4*)dst = (f32x4){cin[tt + 2][0], cin[tt + 2][1], cin[tt + 2][2], cin[tt + 2][3]}; *(f32x4*)(dst + 4) = (f32x4){cin[tt + 2][4], cin[tt + 2][5], cin[tt + 2][6], cin[tt + 2][7]}; } }
    }
}

__device__ __forceinline__ void m2_scan_unit(const Frame& F, int l, int u) {
    const int bh = u >> 2, pq = u & 3, tid = F.tid, p = 16 * pq + (tid >> 5), n = 4 * (tid & 31);
    const bf16* SB = (const bf16*)(F.ws + WS_SBUF) + ((size_t)bh * 16 * 64 + p) * 128 + n; const float* CD = (const float*)(F.ws + WS_CD) + bh * 16;
    bf16* HB = (bf16*)(F.ws + WS_HB) + ((size_t)bh * 16 * 64 + p) * 128 + n;
    f32x4 S[16]; float cd[16];
#pragma unroll
    for (int c = 0; c < 16; ++c) { const v2u sw = *(const v2u*)(SB + (size_t)c * 8192); S[c] = (f32x4){bflo(sw.x), bfhi(sw.x), bflo(sw.y), bfhi(sw.y)}; cd[c] = CD[c]; }
    f32x4 H = (f32x4){0.f, 0.f, 0.f, 0.f};
#pragma unroll
    for (int c = 0; c < 16; ++c) {
        if (c > 0) { v2u o; o.x = pg8::cvt_pk_bf16(H.x, H.y); o.y = pg8::cvt_pk_bf16(H.z, H.w); *(v2u*)(HB + (size_t)c * 8192) = o; }
        H = H * cd[c] + S[c];
    }
    *(f32x4*)(F.out + O_SP + ((size_t)l * 64 + bh) * 8192 + p * 128 + n) = H;
}

__device__ __forceinline__ void ssd_sample_quad(const Frame& F, int l, int u0) {
    const int tid = F.tid, gq = tid >> 7, tl = tid & 127, p = tl >> 1, nh = tl & 1, u = u0 + gq, s = u >> 3, h = u & 7, g = h >> 2, r0 = s * DSEQ;
    LAS float* base = (LAS float*)F.lds + gq * 2688;
    LAS float* Xs = base;
    LAS float* Bs = Xs + 512;
    LAS float* Cs = Bs + 1024;
    LAS float* cbs = Cs + 1024;
    LAS float* sm = cbs + 64;
    const float* XBCS = (const float*)(F.ws + WS_XBCS); const float* DT = (const float*)(F.ws + WS_DT);
    const float* h0 = F.inp(I_SSM) + ((size_t)(l * NDB + s) * 8 + h) * 8192 + p * 128 + 64 * nh;
    __syncthreads();
    f32x4 H[16];
#pragma unroll
    for (int i = 0; i < 16; ++i) H[i] = *(const f32x4*)(h0 + 4 * i);
    f32x4 xv_, bv_[2], cv_[2]; float dv_[8];
    xv_ = *(const f32x4*)(XBCS + (size_t)(r0 + (tl >> 4)) * 1024 + h * 64 + 4 * (tl & 15));
#pragma unroll
    for (int j = 0; j < 2; ++j) { const int i = tl + 128 * j, t = i >> 5, q = i & 31;
        bv_[j] = *(const f32x4*)(XBCS + (size_t)(r0 + t) * 1024 + 512 + g * 128 + 4 * q); cv_[j] = *(const f32x4*)(XBCS + (size_t)(r0 + t) * 1024 + 768 + g * 128 + 4 * q); }
#pragma unroll
    for (int t2 = 0; t2 < 8; ++t2) dv_[t2] = DT[(size_t)(MP + r0 + t2) * 8 + h];
    const float A = -expf(F.inp(I_ALOG)[l * 8 + h]);
    asm volatile("" ::: "memory");
    *(LAS f32x4*)(Xs + 4 * tl) = xv_;
#pragma unroll
    for (int j = 0; j < 2; ++j) { const int i = tl + 128 * j; *(LAS f32x4*)(Bs + 4 * i) = bv_[j]; *(LAS f32x4*)(Cs + 4 * i) = cv_[j]; }
    if (tl < 8) {
        float cs = 0.f, c7 = 0.f, d = 0.f;
#pragma unroll
        for (int t2 = 0; t2 < 8; ++t2) { const float dd = dv_[t2]; c7 += dd * A; if (t2 <= tl) cs += dd * A; if (t2 == tl) d = dd; }
        sm[tl] = d; sm[8 + tl] = cs; sm[16 + tl] = __expf(cs); sm[24 + tl] = __expf(c7 - cs) * d;
    }
    __syncthreads();
    {
        const int t = p >> 3, s2 = p & 7; float a = 0.f;
#pragma unroll
        for (int i = 0; i < 16; ++i) { const f32x4 cv = *(const LAS f32x4*)(Cs + t * 128 + 64 * nh + 4 * i), bv = *(const LAS f32x4*)(Bs + s2 * 128 + 64 * nh + 4 * i); a += (cv.x * bv.x + cv.y * bv.y) + (cv.z * bv.z + cv.w * bv.w); }
        a += xswz<1>(a);
        if (nh == 0) cbs[p] = s2 <= t ? a * __expf(sm[8 + t] - sm[8 + s2]) * sm[s2] : 0.f;
    }
    __syncthreads();
    const float dsk = F.inp(I_DSK)[l * 8 + h];
    float* Yo = (float*)(F.ws + WS_YS) + (size_t)r0 * 512 + h * 64 + p;
#pragma unroll
    for (int t = 0; t < 8; ++t) {
        float a = 0.f;
#pragma unroll
        for (int i = 0; i < 16; ++i) { const f32x4 cv = *(const LAS f32x4*)(Cs + t * 128 + 64 * nh + 4 * i); a += (H[i].x * cv.x + H[i].y * cv.y) + (H[i].z * cv.z + H[i].w * cv.w); }
        a += xswz<1>(a);
        float y = a * sm[16 + t] + dsk * Xs[t * 64 + p];
#pragma unroll
        for (int s2 = 0; s2 <= t; ++s2) y += cbs[t * 8 + s2] * Xs[s2 * 64 + p];
        if ((t & 1) == nh) Yo[(size_t)t * 512] = y;
    }
    const float e7 = sm[16 + 7];
#pragma unroll
    for (int i = 0; i < 16; ++i) H[i] = H[i] * e7;
#pragma unroll
    for (int s2 = 0; s2 < 8; ++s2) { const float cx = sm[24 + s2] * Xs[s2 * 64 + p];
#pragma unroll
        for (int i = 0; i < 16; ++i) H[i] += *(const LAS f32x4*)(Bs + s2 * 128 + 64 * nh + 4 * i) * cx; }
    float* ho = F.out + O_SS + ((size_t)(l * NDB + s) * 8 + h) * 8192 + p * 128 + 64 * nh;
#pragma unroll
    for (int i = 0; i < 16; ++i) *(f32x4*)(ho + 4 * i) = H[i];
}

__device__ __forceinline__ void m2_combined(const Frame& F, int l, int us, int u0) {
    const int tid = F.tid, gq = tid >> 7, tl = tid & 127, p = tl >> 1, nh = tl & 1, u = u0 + gq, s = u >> 3, h = u & 7, g = h >> 2, r0 = s * DSEQ;
    LAS float* base = (LAS float*)F.lds + gq * 2688;
    LAS float* Xs = base;
    LAS float* Bs = Xs + 512;
    LAS float* Cs = Bs + 1024;
    LAS float* cbs = Cs + 1024;
    LAS float* sm = cbs + 64;
    const float* XBCS = (const float*)(F.ws + WS_XBCS); const float* DT = (const float*)(F.ws + WS_DT);
    const float* h0 = F.inp(I_SSM) + ((size_t)(l * NDB + s) * 8 + h) * 8192 + 4 * tl;
    LAS bf16* Hb = (LAS bf16*)(F.lds + 4 * 2688 * 4) + gq * (64 * 136);
    const int hr = tl >> 5, hc = 4 * (tl & 31);
    LAS bf16* Ct = (LAS bf16*)(F.lds + 4 * 2688 * 4 + 4 * 64 * 136 * 2) + gq * (16 * 136);
    LAS bf16* Bt = Ct + 4 * (16 * 136);
    __syncthreads();
    f32x4 H[16];
#pragma unroll
    for (int j = 0; j < 16; ++j) H[j] = *(const f32x4*)(h0 + 512 * j);
    f32x4 xv_, bv_[2], cv_[2]; float dv_[8];
    xv_ = *(const f32x4*)(XBCS + (size_t)(r0 + (tl >> 4)) * 1024 + h * 64 + 4 * (tl & 15));
#pragma unroll
    for (int j = 0; j < 2; ++j) { const int i = tl + 128 * j, t = i >> 5, q = i & 31;
        bv_[j] = *(const f32x4*)(XBCS + (size_t)(r0 + t) * 1024 + 512 + g * 128 + 4 * q); cv_[j] = *(const f32x4*)(XBCS + (size_t)(r0 + t) * 1024 + 768 + g * 128 + 4 * q); }
#pragma unroll
    for (int t2 = 0; t2 < 8; ++t2) dv_[t2] = DT[(size_t)(MP + r0 + t2) * 8 + h];
    const int bh_ = us >> 2, ps_ = 16 * (us & 3) + (tid >> 5), ns_ = 4 * (tid & 31);
    const bf16* SB_ = (const bf16*)(F.ws + WS_SBUF) + ((size_t)bh_ * 16 * 64 + ps_) * 128 + ns_; const float* CD_ = (const float*)(F.ws + WS_CD) + bh_ * 16;
    bf16* HB_ = (bf16*)(F.ws + WS_HB) + ((size_t)bh_ * 16 * 64 + ps_) * 128 + ns_;
    v2u S_[16]; float cd_[16];
#pragma unroll
    for (int c = 0; c < 16; ++c) { S_[c] = *(const v2u*)(SB_ + (size_t)c * 8192); cd_[c] = CD_[c]; }
    const float A = -expf(F.inp(I_ALOG)[l * 8 + h]);
    asm volatile("" ::: "memory");
    {
        f32x4 Hs = (f32x4){0.f, 0.f, 0.f, 0.f};
#pragma unroll
        for (int c = 0; c < 16; ++c) {
            if (c > 0) { v2u o; o.x = pg8::cvt_pk_bf16(Hs.x, Hs.y); o.y = pg8::cvt_pk_bf16(Hs.z, Hs.w); *(v2u*)(HB_ + (size_t)c * 8192) = o; }
            Hs = Hs * cd_[c] + (f32x4){bflo(S_[c].x), bfhi(S_[c].x), bflo(S_[c].y), bfhi(S_[c].y)};
        }
        *(f32x4*)(F.out + O_SP + ((size_t)l * 64 + bh_) * 8192 + ps_ * 128 + ns_) = Hs;
    }
#pragma unroll
    for (int j = 0; j < 16; ++j) { v2u o; o.x = pg8::cvt_pk_bf16(H[j].x, H[j].y); o.y = pg8::cvt_pk_bf16(H[j].z, H[j].w); *(LAS v2u*)(Hb + (4 * j + hr) * 136 + hc) = o; }
    *(LAS f32x4*)(Xs + 4 * tl) = xv_;
#pragma unroll
    for (int j = 0; j < 2; ++j) { const int i = tl + 128 * j; *(LAS f32x4*)(Bs + 4 * i) = bv_[j]; *(LAS f32x4*)(Cs + 4 * i) = cv_[j];
        v2u cw; cw.x = pg8::cvt_pk_bf16(cv_[j].x, cv_[j].y); cw.y = pg8::cvt_pk_bf16(cv_[j].z, cv_[j].w); *(LAS v2u*)(Ct + (i >> 5) * 136 + 4 * (i & 31)) = cw;
        v2u bw; bw.x = pg8::cvt_pk_bf16(bv_[j].x, bv_[j].y); bw.y = pg8::cvt_pk_bf16(bv_[j].z, bv_[j].w); *(LAS v2u*)(Bt + (i >> 5) * 136 + 4 * (i & 31)) = bw; }
    { unsigned z0_ = 0u; asm volatile("" : "+v"(z0_)); *(LAS v4u*)(Ct + (8 + (tl >> 4)) * 136 + 8 * (tl & 15)) = (v4u){z0_, z0_, z0_, z0_}; *(LAS v4u*)(Bt + (8 + (tl >> 4)) * 136 + 8 * (tl & 15)) = (v4u){z0_, z0_, z0_, z0_}; }
    if (tl < 8) {
        float cs = 0.f, c7 = 0.f, d = 0.f;
#pragma unroll
        for (int t2 = 0; t2 < 8; ++t2) { const float dd = dv_[t2]; c7 += dd * A; if (t2 <= tl) cs += dd * A; if (t2 == tl) d = dd; }
        sm[tl] = d; sm[8 + tl] = cs; sm[16 + tl] = __expf(cs); sm[24 + tl] = __expf(c7 - cs) * d;
    }
    __syncthreads();
    if (tl < 64) {
        const int fr_ = tl & 15, kq_ = tl >> 4; f32x4 d4 = (f32x4){0.f, 0.f, 0.f, 0.f};
#pragma unroll
        for (int ks = 0; ks < 4; ++ks) { const s16x8 av = *(const LAS s16x8*)(Ct + fr_ * 136 + 32 * ks + 8 * kq_), bv2 = *(const LAS s16x8*)(Bt + fr_ * 136 + 32 * ks + 8 * kq_);
            d4 = __builtin_amdgcn_mfma_f32_16x16x32_bf16(av, bv2, d4, 0, 0, 0); }
        if (kq_ < 2 && fr_ < 8) {
#pragma unroll
            for (int i = 0; i < 4; ++i) { const int t = 4 * kq_ + i, s2 = fr_; cbs[t * 8 + s2] = s2 <= t ? d4[i] * __expf(sm[8 + t] - sm[8 + s2]) * sm[s2] : 0.f; } }
    }
    __syncthreads();
    const float dsk = F.inp(I_DSK)[l * 8 + h];
    {
        const int wl = (tl >> 6) & 1, ln = tl & 63, fr_ = ln & 15, kq_ = ln >> 4;
        float* Yb = (float*)(F.ws + WS_YS) + (size_t)r0 * 512 + h * 64;
#pragma unroll
        for (int bb = 0; bb < 2; ++bb) { const int blk = 2 * wl + bb, pp = 16 * blk + fr_;
            f32x4 acc4 = (f32x4){0.f, 0.f, 0.f, 0.f};
#pragma unroll
            for (int ks = 0; ks < 4; ++ks) { const s16x8 av = *(const LAS s16x8*)(Ct + fr_ * 136 + 32 * ks + 8 * kq_), bv2 = *(const LAS s16x8*)(Hb + pp * 136 + 32 * ks + 8 * kq_);
                acc4 = __builtin_amdgcn_mfma_f32_16x16x32_bf16(av, bv2, acc4, 0, 0, 0); }
            if (kq_ < 2) {
#pragma unroll
                for (int i = 0; i < 4; ++i) { const int t = 4 * kq_ + i; float y = acc4[i] * sm[16 + t] + dsk * Xs[t * 64 + pp];
#pragma unroll
                    for (int s2 = 0; s2 < 8; ++s2) y += cbs[t * 8 + s2] * Xs[s2 * 64 + pp];
                    Yb[(size_t)t * 512 + pp] = y; } } }
    }
    const float e7 = sm[16 + 7];
#pragma unroll
    for (int j = 0; j < 16; ++j) H[j] = H[j] * e7;
#pragma unroll
    for (int s2 = 0; s2 < 8; ++s2) { const f32x4 bq = *(const LAS f32x4*)(Bs + s2 * 128 + hc); const float dq = sm[24 + s2];
#pragma unroll
        for (int j = 0; j < 16; ++j) H[j] += bq * (dq * Xs[s2 * 64 + 4 * j + hr]); }
    float* ho = F.out + O_SS + ((size_t)(l * NDB + s) * 8 + h) * 8192 + 4 * tl;
#pragma unroll
    for (int j = 0; j < 16; ++j) *(f32x4*)(ho + 512 * j) = H[j];
}

typedef float f32x2_t __attribute__((ext_vector_type(2))); typedef __bf16 bf16x2_t __attribute__((ext_vector_type(2)));
__device__ __forceinline__ unsigned cvtpk_s(float lo, float hi) { const f32x2_t v = {lo, hi}; const bf16x2_t bb = __builtin_convertvector(v, bf16x2_t); return __builtin_bit_cast(unsigned, bb); }
__device__ __forceinline__ void m3_prompt_unit(const Frame& F, int l, int u) {
    const int g = u & 1, c = (u >> 1) & 15, b = u >> 5, r0 = b * SEQ + c * 128;
    int tid = F.tid, lane = F.lane, w = F.wave;
    LAS float* cumT = (LAS float*)F.lds;
    LAS float* dtT = cumT + 512;
    LAS float* sqp = dtT + 512;
    LAS bf16* Cm = (LAS bf16*)(F.lds + 8192);
    LAS bf16* Bm = Cm + 128 * LDT;
    LAS bf16* XT = Bm + 128 * LDT;
    const bf16* PROJ = (const bf16*)(F.ws + WS_PROJ); bf16* YCAT = (bf16*)(F.ws + WS_YCAT); const bf16* XBCB = (const bf16*)(F.ws + WS_XBCB);
    s16x8 hbv[2][8];
    { const int hl0 = w & 3, half0 = lane >> 5, l310 = lane & 31;
      const bf16* hsrc0 = (const bf16*)(F.ws + WS_HB) + ((size_t)(b * 8 + 4 * g + hl0) * 16 + c) * 8192 + l310 * 128 + 8 * half0;
      if (c > 0) {
#pragma unroll
          for (int kk = 0; kk < 8; ++kk) { hbv[0][kk] = *(const s16x8*)(hsrc0 + 16 * kk); hbv[1][kk] = *(const s16x8*)(hsrc0 + 32 * 128 + 16 * kk); } } }
    __syncthreads();
    { const int t = tid >> 2, hl = tid & 3; cumT[hl * 128 + t] = ((const float*)(F.ws + WS_CUM))[(size_t)(r0 + t) * 8 + 4 * g + hl]; dtT[hl * 128 + t] = ((const float*)(F.ws + WS_DT))[(size_t)(r0 + t) * 8 + 4 * g + hl]; }
    {
        v4u cbv[8];
#pragma unroll
        for (int j = 0; j < 8; ++j) { const int i = tid + 512 * j, which = i >> 11, row = (i >> 4) & 127, ck = i & 15; cbv[j] = *(const v4u*)(XBCB + (size_t)(r0 + row) * DM + (which ? 512 : 768) + 128 * g + 8 * ck); }
        const int po = tid & 31, t0 = 8 * (tid >> 5); v4u xr[8];
#pragma unroll
        for (int tt = 0; tt < 8; ++tt) xr[tt] = *(const v4u*)(XBCB + (size_t)(r0 + t0 + tt) * DM + 256 * g + 8 * po);
        asm volatile("" ::: "memory");
#pragma unroll
        for (int j = 0; j < 8; ++j) { const int i = tid + 512 * j, which = i >> 11, row = (i >> 4) & 127, ck = i & 15; *(LAS v4u*)((which ? Bm : Cm) + row * LDT + 8 * ck) = cbv[j]; }
#pragma unroll
        for (int j = 0; j < 8; ++j) { const unsigned sel = (j & 1) ? 0x07060302u : 0x05040100u; v4u o;
            o.x = __builtin_amdgcn_perm(xr[1][j >> 1], xr[0][j >> 1], sel); o.y = __builtin_amdgcn_perm(xr[3][j >> 1], xr[2][j >> 1], sel);
            o.z = __builtin_amdgcn_perm(xr[5][j >> 1], xr[4][j >> 1], sel); o.w = __builtin_amdgcn_perm(xr[7][j >> 1], xr[6][j >> 1], sel);
            *(LAS v4u*)(XT + (8 * po + j) * LDT + t0) = o; }
    }
    __syncthreads();
    M_RELAUNDER();
    const int hl = w & 3, th = w >> 2, h = 4 * g + hl, half = lane >> 5, l31 = lane & 31;
    const LAS float* cumh = cumT + hl * 128; const LAS float* dth = dtT + hl * 128;
    f32x16 y[2][2];
#pragma unroll
    for (int a = 0; a < 2; ++a)
#pragma unroll
        for (int q = 0; q < 2; ++q)
#pragma unroll
            for (int i = 0; i < 16; ++i) y[a][q][i] = 0.f;
    if (c > 0) {
#pragma unroll
        for (int k = 0; k < 128; k += 16) {
            const s16x8 hb0 = hbv[0][k >> 4], hb1 = hbv[1][k >> 4];
#pragma unroll
            for (int tbl = 0; tbl < 2; ++tbl) { const s16x8 ca = *(const LAS s16x8*)(Cm + (32 * (2 * th + tbl) + l31) * LDT + k + 8 * half);
                y[tbl][0] = __builtin_amdgcn_mfma_f32_32x32x16_bf16(ca, hb0, y[tbl][0], 0, 0, 0); y[tbl][1] = __builtin_amdgcn_mfma_f32_32x32x16_bf16(ca, hb1, y[tbl][1], 0, 0, 0); }
        }
#pragma unroll
        for (int tbl = 0; tbl < 2; ++tbl)
#pragma unroll
            for (int q4 = 0; q4 < 4; ++q4) { const f32x4 cv = *(const LAS f32x4*)(cumh + 32 * (2 * th + tbl) + 8 * q4 + 4 * half);
#pragma unroll
                for (int i = 0; i < 4; ++i) { const float e = __expf(cv[i]); y[tbl][0][4 * q4 + i] *= e; y[tbl][1][4 * q4 + i] *= e; } }
    }
#pragma unroll
    for (int tbl = 0; tbl < 2; ++tbl) {
        const int tb = 2 * th + tbl; const int t = 32 * tb + l31; const float ct = cumh[t];
#pragma unroll 1
        for (int sb = 0; sb <= tb; ++sb) {
            f32x16 x;
#pragma unroll
            for (int i = 0; i < 16; ++i) x[i] = 0.f;
            x = mma32(Bm + (32 * sb) * LDT, Cm + (32 * tb) * LDT, 128, x, lane);
#pragma unroll
            for (int q4 = 0; q4 < 4; ++q4) { const f32x4 cs = *(const LAS f32x4*)(cumh + 32 * sb + 8 * q4 + 4 * half), ds = *(const LAS f32x4*)(dth + 32 * sb + 8 * q4 + 4 * half);
#pragma unroll
                for (int i = 0; i < 4; ++i) { const int s = 32 * sb + 8 * q4 + 4 * half + i; x[4 * q4 + i] = s <= t ? x[4 * q4 + i] * __expf(ct - cs[i]) * ds[i] : 0.f; } }
#pragma unroll
            for (int sp = 0; sp < 2; ++sp) {
                v4u pa; pa.x = cvtpk_s(x[8 * sp], x[8 * sp + 1]); pa.y = cvtpk_s(x[8 * sp + 2], x[8 * sp + 3]); pa.z = cvtpk_s(x[8 * sp + 4], x[8 * sp + 5]); pa.w = cvtpk_s(x[8 * sp + 6], x[8 * sp + 7]);
                const s16x8 xa = __builtin_bit_cast(s16x8, pa);
#pragma unroll
                for (int q = 0; q < 2; ++q) { const LAS bf16* xp = XT + (hl * 64 + 32 * q + l31) * LDT + 32 * sb + 16 * sp + 4 * half;
                    const v2u lo = *(const LAS v2u*)xp, hi = *(const LAS v2u*)(xp + 8); const v4u pb = {lo.x, lo.y, hi.x, hi.y};
                    y[tbl][q] = __builtin_amdgcn_mfma_f32_32x32x16_bf16(xa, __builtin_bit_cast(s16x8, pb), y[tbl][q], 0, 0, 0); }
            }
        }
    }
    const float dsk = F.inp(I_DSK)[l * 8 + h];
#pragma unroll
    for (int tbl = 0; tbl < 2; ++tbl) { const int tb = 2 * th + tbl; float sq[16];
#pragma unroll
        for (int i = 0; i < 16; ++i) sq[i] = 0.f;
        unsigned zr[2][16];
#pragma unroll
        for (int q = 0; q < 2; ++q)
#pragma unroll
            for (int reg = 0; reg < 16; ++reg) zr[q][reg] = PROJ[(size_t)(r0 + 32 * tb + crow(reg, half)) * DING + C_Z + h * 64 + 32 * q + l31];
#pragma unroll
        for (int q = 0; q < 2; ++q) { const int p = 32 * q + l31, col = h * 64 + p;
#pragma unroll
            for (int reg = 0; reg < 16; ++reg) { const int t = 32 * tb + crow(reg, half);
                const float xv = bf2f(XT[(hl * 64 + p) * LDT + t]); const float yv = y[tbl][q][reg] + dsk * xv;
                const float z = bf2f(zr[q][reg]); const float gv = yv * silu_f(z);
                sq[reg] += gv * gv; YCAT[(size_t)(r0 + t) * DM + YC_YC + col] = (bf16)f2bf(gv); } }
#pragma unroll
        for (int reg = 0; reg < 16; ++reg) { float v = sq[reg]; v += xswz<1>(v); v += xswz<2>(v); v += xswz<4>(v); v += xswz<8>(v); v += xswz<16>(v);
            if (l31 == 0) sqp[hl * 128 + 32 * tb + crow(reg, half)] = v; }
    }
    __syncthreads();
    if (tid < 128) ((float*)(F.ws + WS_SSG))[(size_t)(r0 + tid) * 2 + g] = (sqp[tid] + sqp[128 + tid]) + (sqp[256 + tid] + sqp[384 + tid]);
}

__device__ __forceinline__ void conv_sample_phase(const Frame& F, int l) {
    const int gw = F.vcu * NWAVES + F.wave, NGW = F.G * NWAVES, lane = F.lane;
    const bf16* PROJ = (const bf16*)(F.ws + WS_PROJ); bf16* YCAT = (bf16*)(F.ws + WS_YCAT); float* XBCS = (float*)(F.ws + WS_XBCS);
    const float* cw = F.inp(I_CW) + l * 3 * 256; const float* scw = F.inp(I_SCW) + l * 4 * 1024; const float* scb = F.inp(I_SCB) + l * 1024;
    const int wi_ = (F.vcu & 31) * NWAVES + F.wave;
    for (int r = F.G == 256 ? MP + 128 * (F.vcu >> 5) + wi_ : MP + gw; F.G == 256 ? (wi_ < 128 && r < MP + 128 * (F.vcu >> 5) + 128) : r < M; r += F.G == 256 ? 1024 : NGW) {
        const int t = (r - MP) & 7, sidx = (r - MP) >> 3;
        v2u xr[4][4];
#pragma unroll
        for (int jg = 0; jg < 4; ++jg)
#pragma unroll
            for (int k = 0; k < 4; ++k) { const int back = 3 - k, rp = (t - back >= 0) ? r - back : r; xr[jg][k] = *(const v2u*)(PROJ + (size_t)rp * DING + C_XBC + jg * 256 + 4 * lane); }
        {
            const int ch = 4 * lane; v2u cgr[3], hbr[3]; f32x4 str[3], w3[3];
#pragma unroll
            for (int k = 0; k < 3; ++k) { const int back = 2 - k, rp = (t - back >= 0) ? r - back : r, si = (t - back >= 0) ? 0 : 2 + t - back;
                cgr[k] = *(const v2u*)(PROJ + (size_t)rp * DING + C_CG + ch); hbr[k] = *(const v2u*)(PROJ + (size_t)rp * DING + C_HB + ch);
                str[k] = *(const f32x4*)(F.inp(I_SC) + ((size_t)(l * NDB + sidx) * 2 + si) * 256 + ch); w3[k] = *(const f32x4*)(cw + k * 256 + ch); }
            const v2u bg = *(const v2u*)(PROJ + (size_t)r * DING + C_BG + ch);
            asm volatile("" ::: "memory");
            float cin[3][4];
#pragma unroll
            for (int k = 0; k < 3; ++k) { const bool own = t - (2 - k) >= 0;
                cin[k][0] = own ? bflo(cgr[k].x) * bflo(hbr[k].x) : str[k].x; cin[k][1] = own ? bfhi(cgr[k].x) * bfhi(hbr[k].x) : str[k].y;
                cin[k][2] = own ? bflo(cgr[k].y) * bflo(hbr[k].y) : str[k].z; cin[k][3] = own ? bfhi(cgr[k].y) * bfhi(hbr[k].y) : str[k].w; }
            const float bgf[4] = {bflo(bg.x), bfhi(bg.x), bflo(bg.y), bfhi(bg.y)}; float yb[4];
#pragma unroll
            for (int j = 0; j < 4; ++j) yb[j] = bgf[j] * (w3[0][j] * cin[0][j] + w3[1][j] * cin[1][j] + w3[2][j] * cin[2][j]);
            v2u wv; wv.x = pk2(yb[0], yb[1]); wv.y = pk2(yb[2], yb[3]); *(v2u*)(YCAT + (size_t)r * DM + YC_YB + ch) = wv;
            if (t >= DSEQ - 2) { float* dst = F.out + O_CS + ((size_t)(l * NDB + sidx) * 2 + (t - (DSEQ - 2))) * 256; *(f32x4*)(dst + ch) = (f32x4){cin[2][0], cin[2][1], cin[2][2], cin[2][3]}; }
        }
        {
            f32x4 str[4][4], w4[4][4], bq[4];
#pragma unroll
            for (int jg = 0; jg < 4; ++jg) { const int ch = jg * 256 + 4 * lane; bq[jg] = *(const f32x4*)(scb + ch);
#pragma unroll
                for (int k = 0; k < 4; ++k) { const int back = 3 - k, rp = (t - back >= 0) ? r - back : r, si = (t - back >= 0) ? 0 : 3 + t - back;
                    str[jg][k] = *(const f32x4*)(F.inp(I_SSC) + ((size_t)(l * NDB + sidx) * 3 + si) * 1024 + ch);
                    w4[jg][k] = *(const f32x4*)(scw + k * 1024 + ch); } }
            asm volatile("" ::: "memory");
#pragma unroll
            for (int jg = 0; jg < 4; ++jg) { const int ch = jg * 256 + 4 * lane; float xv[4][4];
#pragma unroll
                for (int k = 0; k < 4; ++k) { const bool own = t - (3 - k) >= 0;
                    xv[k][0] = own ? bflo(xr[jg][k].x) : str[jg][k].x; xv[k][1] = own ? bfhi(xr[jg][k].x) : str[jg][k].y; xv[k][2] = own ? bflo(xr[jg][k].y) : str[jg][k].z; xv[k][3] = own ? bfhi(xr[jg][k].y) : str[jg][k].w; }
                f32x4 o;
#pragma unroll
                for (int j = 0; j < 4; ++j) { const float v = bq[jg][j] + w4[jg][0][j] * xv[0][j] + w4[jg][1][j] * xv[1][j] + w4[jg][2][j] * xv[2][j] + w4[jg][3][j] * xv[3][j]; o[j] = silu_f(v); }
                *(f32x4*)(XBCS + (size_t)(r - MP) * 1024 + ch) = o;
                if (t >= DSEQ - 3) { float* dst = F.out + O_SCS + ((size_t)(l * NDB + sidx) * 3 + (t - (DSEQ - 3))) * 1024; *(f32x4*)(dst + ch) = (f32x4){xv[3][0], xv[3][1], xv[3][2], xv[3][3]}; } }
        }
    }
}
__device__ __forceinline__ void mixa_sample_phase(const Frame& F, int l) {
    LAS bf16* Vs = (LAS bf16*)F.lds;
    LAS float* Wsl = (LAS float*)(F.lds + 4096);
    LAS float* Bsl = Wsl + 256;
    const bf16* PROJ = (const bf16*)(F.ws + WS_PROJ); bf16* YCAT = (bf16*)(F.ws + WS_YCAT);
    const int tid = F.tid;
    for (int u = F.G == 256 ? ((F.vcu & 31) >= 16 ? 16 * (F.vcu >> 5) + (F.vcu & 31) - 16 : NDB) : F.vcu; u < NDB; u += F.G) {
        const int r0 = MP + u * 8;
        __syncthreads();
        {
            v4u vv = (v4u){0u, 0u, 0u, 0u}; float wq = 0.f, bq = 0.f; unsigned ur[8];
            if (tid < 256) vv = *(const v4u*)(PROJ + (size_t)(r0 + (tid >> 5)) * DING + C_V + (tid & 31) * 8);
            else { const int i = tid - 256, hh = i >> 6, tt = (i >> 3) & 7, s2 = i & 7; wq = F.inp(I_WS)[((size_t)(l * 4 + hh) * 128 + tt) * 128 + s2]; }
            if (tid < 32) bq = F.inp(I_BS)[(l * 4 + (tid >> 3)) * 128 + (tid & 7)];
            const int col = tid & 255;
#pragma unroll
            for (int t = 0; t < 8; ++t) ur[t] = PROJ[(size_t)(r0 + t) * DING + C_U + col];
            asm volatile("" ::: "memory");
            if (tid < 256) *(LAS v4u*)(Vs + (tid >> 5) * 256 + (tid & 31) * 8) = vv; else Wsl[tid - 256] = wq;
            if (tid < 32) Bsl[tid] = bq;
            __syncthreads();
            if (tid < 256) { const int h = col >> 6; float vcol[8];
#pragma unroll
                for (int t = 0; t < 8; ++t) vcol[t] = bf2f(Vs[t * 256 + col]);
#pragma unroll
                for (int t = 0; t < 8; ++t) { float acc = Bsl[h * 8 + t];
#pragma unroll
                    for (int s2 = 0; s2 <= t; ++s2) acc += Wsl[(h * 8 + t) * 8 + s2] * vcol[s2];
                    YCAT[(size_t)(r0 + t) * DM + YC_YA + col] = (bf16)f2bf(bf2f(ur[t]) * acc); } }
        }
        float* dst = F.out + O_CVS + (size_t)(l * NDB + u) * 8 * 256; for (int i = tid; i < 8 * 256; i += NWAVES * 64) dst[i] = bf2f(Vs[i]);
    }
}
__device__ __forceinline__ void gnorm_sample_phase(const Frame& F, int l) {
    const int gw = F.vcu * NWAVES + F.wave, NGW = F.G * NWAVES, lane = F.lane;
    const bf16* PROJ = (const bf16*)(F.ws + WS_PROJ); bf16* YCAT = (bf16*)(F.ws + WS_YCAT); const float* Y = (const float*)(F.ws + WS_YS);
    const int wi_ = (F.vcu & 31) * NWAVES + F.wave;
    for (int r = F.G == 256 ? MP + 128 * (F.vcu >> 5) + wi_ : MP + gw; F.G == 256 ? (wi_ < 128 && r < MP + 128 * (F.vcu >> 5) + 128) : r < M; r += F.G == 256 ? 1024 : NGW) {
        const f32x4 y0 = *(const f32x4*)(Y + (size_t)(r - MP) * 512 + 8 * lane), y1 = *(const f32x4*)(Y + (size_t)(r - MP) * 512 + 8 * lane + 4);
        float z[8]; unpack8(*(const v4u*)(PROJ + (size_t)r * DING + C_Z + 8 * lane), z);
        float gv[8] = {y0.x * silu_f(z[0]), y0.y * silu_f(z[1]), y0.z * silu_f(z[2]), y0.w * silu_f(z[3]), y1.x * silu_f(z[4]), y1.y * silu_f(z[5]), y1.z * silu_f(z[6]), y1.w * silu_f(z[7])};
        float s = 0.f;
#pragma unroll
        for (int j = 0; j < 8; ++j) s += gv[j] * gv[j];
        s = wave_sum(s);
        *(v4u*)(YCAT + (size_t)r * DM + YC_YC + 8 * lane) = pack8(gv[0], gv[1], gv[2], gv[3], gv[4], gv[5], gv[6], gv[7]);
        if (lane < 2) ((float*)(F.ws + WS_SSG))[(size_t)r * 2 + lane] = lane == 0 ? s : 0.f;
    }
}
__device__ __forceinline__ void final_phase(const Frame& F) {
    const int gw = F.vcu * NWAVES + F.wave, NGW = F.G * NWAVES, lane = F.lane;
    const f32x4* gp = (const f32x4*)F.inp(I_FN) + 2 * lane;
    f32x4 gv[2][2];
#pragma unroll
    for (int j = 0; j < 2; ++j) { gv[j][0] = gp[128 * j]; gv[j][1] = gp[128 * j + 1]; }
    const bf16* XB = (const bf16*)(F.ws + WS_XB);
    const int wi_ = (F.vcu & 31) * NWAVES + F.wave, xs_ = F.vcu >> 5;
    for (int gi = F.G == 256 ? wi_ : gw; gi < (F.G == 256 ? 544 : M / 4); gi += F.G == 256 ? 256 : NGW) {
        const int r4 = F.G == 256 ? (gi < 512 ? 2048 * xs_ + 4 * gi : MP + 128 * xs_ + 4 * (gi - 512)) : 4 * gi;
        v4u v[4][2];
#pragma unroll
        for (int q = 0; q < 4; ++q) { const v4u* xr = (const v4u*)(XB + (size_t)(r4 + q) * DM) + lane;
#pragma unroll
            for (int j = 0; j < 2; ++j) v[q][j] = xr[64 * j]; }
#pragma unroll
        for (int q = 0; q < 4; ++q) { float s = 0.f; f32x4* yr = (f32x4*)(F.out + (size_t)(r4 + q) * DM) + 2 * lane; f32x4 x[2][2];
#pragma unroll
            for (int j = 0; j < 2; ++j) { pg8::unpk8(v[q][j], x[j][0], x[j][1]);
#pragma unroll
                for (int h = 0; h < 2; ++h) s += (x[j][h].x * x[j][h].x + x[j][h].y * x[j][h].y) + (x[j][h].z * x[j][h].z + x[j][h].w * x[j][h].w); }
            s = wave_sum(s); const float rsd = 1.0f / sqrtf(s * (1.0f / DM) + EPS);
#pragma unroll
            for (int j = 0; j < 2; ++j) { yr[128 * j] = x[j][0] * rsd * gv[j][0]; yr[128 * j + 1] = x[j][1] * rsd * gv[j][1]; } }
    }
}

constexpr int PH_PER_LAYER = 7, N_PHASES = 1 + DEPTH * PH_PER_LAYER + 1;
__global__ void __launch_bounds__(NWAVES * 64, 2) mega(Args args) {
    extern __shared__ __attribute__((aligned(16))) unsigned char lds[];
    Frame F;
    F.lds = (LAS unsigned char*)lds;
    F.tid = threadIdx.x; F.lane = F.tid & 63; F.wave = __builtin_amdgcn_readfirstlane(F.tid >> 6);
    F.G = gridDim.x; { const int bx = blockIdx.x; F.vcu = (F.G % 8 == 0) ? (bx % 8) * (F.G / 8) + bx / 8 : bx; }
    const __attribute__((address_space(4))) Args* ap0 = (const __attribute__((address_space(4))) Args*)__builtin_amdgcn_kernarg_segment_ptr();
    F.ap = ap0; F.out = args.out; F.ws = args.ws;
    volatile LAS unsigned* MISC = (volatile LAS unsigned*)(F.lds + MISC_OFF);
    for (int u = F.tid; u < (LDS_BYTES - LDSCTL_OFF) / 4; u += NWAVES * 64) ((LAS unsigned*)(F.lds + LDSCTL_OFF))[u] = 0u;
    __syncthreads();
    const int wave_s = __builtin_amdgcn_readfirstlane(threadIdx.x >> 6);
    const bool multi = args.ph_hi - args.ph_lo > 1;
    XcdBarrier bar; bar.bar = (unsigned*)(F.ws + WS_CTL) + CW_BAR; bar.x = 0; bar.st = nullptr; bool even = false; unsigned ev_s = 0u, tk_s = 0u;
    if (multi) {
        bar = xcd_barrier_post((unsigned*)(F.ws + WS_CTL) + CW_BAR, MISC + 8);
        if (threadIdx.x == 0) { unsigned nloc_, nx_, ev_; xcd_barrier_complete(bar.bar, bar.x, nloc_, nx_, ev_); bar.st[0] = nloc_; bar.st[1] = nx_; bar.st[3] = ev_; }
        __syncthreads();
        ev_s = __builtin_amdgcn_readfirstlane(MISC[11]); tk_s = __builtin_amdgcn_readfirstlane(MISC[10]);
    }

#define PH_TID() do { int wv_ = wave_s; LAUNDER_S(wv_); unsigned z_ = 0u; LAUNDER_S(z_); int t_ = wv_ * 64 + (int)__builtin_amdgcn_mbcnt_hi(~0u, __builtin_amdgcn_mbcnt_lo(~0u, z_)); LAUNDER_V(t_); F.tid = t_; F.lane = t_ & 63; F.wave = wv_; } while (0)
    for (int ph = args.ph_lo; ph < args.ph_hi; ++ph) {
        {
            const __attribute__((address_space(4))) Args* q = ap0; asm volatile("" : "+s"(q)); F.ap = q; F.out = q->out; F.ws = q->ws;
            int bx = blockIdx.x; asm volatile("" : "+s"(bx));
            even = multi && ev_s == 1u;
            if (even) bx = (int)((tk_s - 1u) * 8u + bar.x);
            F.bid = bx; F.vcu = (F.G % 8 == 0) ? (bx % 8) * (F.G / 8) + bx / 8 : bx;
            bar.bar = (unsigned*)(F.ws + WS_CTL) + CW_BAR;
        }
        if (ph == 0) {
            if (!even) { PH_TID(); p0_prologue(F, 0); }
            else {
                PH_TID(); p0_prologue(F, 3);
                xcd_barrier(bar, false);
                constexpr int I_IN_ = (DM / 64) * (DING / 32), I_ALL_ = DEPTH * ((DM / 64) * (DING / 32) + (DM / 64) * (DM / 32) + (DM / 64) * (FF / 32) + (FF / 64) * (DM / 32)), R_ = I_ALL_ - I_IN_;
                const int xx_ = (int)bar.x; int c0_ = 0, c1_ = 0, ct_ = 0;
#pragma unroll
                for (int j = 0; j < 8; ++j) { const int w_ = CVT_SHARE(j); if (j < xx_) c0_ += w_; if (j <= xx_) c1_ += w_; ct_ += w_; }
                const int blo_ = I_IN_ + (int)((long)R_ * c0_ / ct_), bhi_ = I_IN_ + (int)((long)R_ * c1_ / ct_);
                PH_TID(); p0_prologue(F, 4, blo_, bhi_);
            }
        }
        else if (ph == N_PHASES - 1) { PH_TID(); final_phase(F); }
        else {
            const int l = (ph - 1) / PH_PER_LAYER, s = (ph - 1) % PH_PER_LAYER;
#ifndef PROBE_S
#define PROBE_S -1
#endif
            for (int rep = 0; rep < ((s == PROBE_S) ? 2 : 1); ++rep) {
            bf16* XB = (bf16*)(F.ws + WS_XB); float* SS1 = (float*)(F.ws + WS_SS1); float* SS2 = (float*)(F.ws + WS_SS2); float* SSX1 = (float*)(F.ws + WS_SSX1); float* SSX2 = (float*)(F.ws + WS_SSX2);
            if (s == 0) {
                PH_TID();
                { pg8::GemmX g{XB, XB + (size_t)MP * DM, (const bf16*)(F.ws + WS_WIN) + (size_t)l * DING * DM, DM}; pg8::StaticOrder S; S.init(MP, DING, F.G, F.bid);
                  pg8::EpiScaleActX<0> E{(bf16*)(F.ws + WS_PROJ), (bf16*)(F.ws + WS_PROJ) + (size_t)MP * DING, DING, SS1, SSX1, 2};
                  pg8::gemm_phase_x<pg8::EpiScaleActX<0>, pg8::StaticOrder>(F.lds, g, S, E, F.tid); }
                PH_TID();
                { pg8::SEpiDt Ed{(float*)(F.ws + WS_DT), SS1, F.inp(I_DTB) + l * 8, (const float*)(F.ws + WS_SSX1)};
                  { const int rk_ = F.vcu & 31, x0_ = 32 * (F.vcu >> 5);
                    pg8::small_gemm_phase<64, pg8::SEpiDt>(F.lds, XB, (const bf16*)(F.ws + WS_WDTB) + (size_t)l * 64 * DM, DM, 1, F.G == 256 ? (rk_ >= 24 ? x0_ + 32 : 0) : MP / 64, F.G == 256 ? x0_ + rk_ - 24 : F.vcu, F.G == 256 ? 8 : F.G, Ed, F.tid); }
                  if (F.G == 256) { if ((F.vcu & 31) >= 30) { PH_TID(); const int us_ = MP / 64 + 2 * (F.vcu >> 5) + (F.vcu & 31) - 30;
                      pg8::small_gemm_phase<64, pg8::SEpiDt>(F.lds, XB, (const bf16*)(F.ws + WS_WDTB) + (size_t)l * 64 * DM, DM, 1, us_ + 1, us_, 1, Ed, F.tid); } }
                  else { PH_TID(); pg8::small_gemm_phase<64, pg8::SEpiDt>(F.lds, XB, (const bf16*)(F.ws + WS_WDTB) + (size_t)l * 64 * DM, DM, 1, M / 64, MP / 64 + F.vcu, F.G, Ed, F.tid); } }
            } else if (s == 1) {
                PH_TID();
                for (int u = F.vcu; u < 256; u += F.G) m1_prompt_unit(F, l, u);
                PH_TID(); conv_sample_phase(F, l); PH_TID(); mixa_sample_phase(F, l);
            } else if (s == 2) {
                PH_TID();
                if (F.G == 256) m2_combined(F, l, F.vcu, 4 * F.vcu);
                else { for (int u = F.vcu; u < 256; u += F.G) m2_scan_unit(F, l, u);
                    PH_TID();
                    for (int u = 4 * F.vcu; u < NDB * 8; u += 4 * F.G) ssd_sample_quad(F, l, u); }
            } else if (s == 3) {
                PH_TID();
                for (int u = F.vcu; u < 256; u += F.G) m3_prompt_unit(F, l, u);
                PH_TID(); gnorm_sample_phase(F, l);
            } else if (s == 4) {
                PH_TID();
                { pg8::GemmX g{(const bf16*)(F.ws + WS_YCAT), (const bf16*)(F.ws + WS_YCAT) + (size_t)MP * DM, (const bf16*)(F.ws + WS_WOUT) + (size_t)l * DM * DM, DM}; pg8::StaticOrder S; S.init(MP, DM, F.G, F.bid);
                  pg8::EpiResX<true> E{XB, SS2, SSX2, (const float*)(F.ws + WS_SSG)};
                  pg8::gemm_phase_x<pg8::EpiResX<true>, pg8::StaticOrder>(F.lds, g, S, E, F.tid); }
            } else if (s == 5) {
                PH_TID();
                { pg8::GemmX g{XB, XB + (size_t)MP * DM, (const bf16*)(F.ws + WS_W1) + (size_t)l * FF * DM, DM}; pg8::StaticOrder S; S.init(MP, FF, F.G, F.bid);
                  pg8::EpiScaleActX<1> E{(bf16*)(F.ws + WS_HID), (bf16*)(F.ws + WS_HID) + (size_t)MP * FF, FF, SS2, SSX2, 0};
                  pg8::gemm_phase_x<pg8::EpiScaleActX<1>, pg8::StaticOrder>(F.lds, g, S, E, F.tid); }
            } else {
                PH_TID();
                { pg8::GemmX g{(const bf16*)(F.ws + WS_HID), (const bf16*)(F.ws + WS_HID) + (size_t)MP * FF, (const bf16*)(F.ws + WS_W2) + (size_t)l * DM * FF, FF}; pg8::StaticOrder S; S.init(MP, DM, F.G, F.bid);
                  pg8::EpiResX<false> E{XB, SS1, SSX1, nullptr};
                  pg8::gemm_phase_x<pg8::EpiResX<false>, pg8::StaticOrder>(F.lds, g, S, E, F.tid); }
            }
            }
        }
        if (ph + 1 < args.ph_hi) {
            if (!even) xcd_barrier(bar, false);
            else xcd_barrier(bar, true, -1, bar.bar + XB_HTOP(0) + 64, ph == 4 ? 1u : 0u, ph == 0);
        }
    }
}

extern "C" void kernel_launch(void* const* d_in, const int* in_sizes, int n_in, void* d_out, int out_size, void* d_ws, size_t ws_size, hipStream_t stream) {
    static int grid = 0;
    if (grid == 0) {
        if (n_in != N_IN || (size_t)out_size != O_END || ws_size < WS_END) { fprintf(stderr, "kernel_launch: unexpected sizes n_in %d out %d ws %zu (need %zu)\n", n_in, out_size, ws_size, (size_t)WS_END); grid = -1; return; }
        int dev = 0, cus = 0;
        if (hipGetDevice(&dev) != hipSuccess || hipDeviceGetAttribute(&cus, hipDeviceAttributeMultiprocessorCount, dev) != hipSuccess) { grid = -1; return; }
        if (hipFuncSetAttribute((const void*)mega, hipFuncAttributeMaxDynamicSharedMemorySize, LDS_BYTES) != hipSuccess) { fprintf(stderr, "kernel_launch: hipFuncSetAttribute failed\n"); grid = -1; return; }
        (void)hipGetLastError();
        grid = cus;
    }
    if (grid < 0) return;
    if (hipMemsetAsync((char*)d_ws + WS_CTL, 0, CTL_ZERO_BYTES, stream) != hipSuccess) return;
    Args a{};
    for (int i = 0; i < N_IN; ++i) a.in[i] = (const float*)d_in[i];
    a.out = (float*)d_out; a.ws = (unsigned char*)d_ws;
#if MK_ONE_LAUNCH
    a.ph_lo = 0; a.ph_hi = N_PHASES;
    hipLaunchKernelGGL(mega, dim3(grid), dim3(NWAVES * 64), LDS_BYTES, stream, a);
#else
    for (int ph = 0; ph < N_PHASES; ++ph) { a.ph_lo = ph; a.ph_hi = ph + 1; hipLaunchKernelGGL(mega, dim3(grid), dim3(NWAVES * 64), LDS_BYTES, stream, a); }
#endif
}
```
